# Optimizing an MI355X kernel written in HIP

```python
import jax, jax.numpy as jnp
from jax import lax
import numpy as np

D_MODEL = 1024
BATCH = 8
SEQ = 4096
DEPTH = 2

N_A_LAYERS = DEPTH // 2
N_B_LAYERS = DEPTH - N_A_LAYERS
N_SUBLAYERS = 3
GLA_HEADS = 4
GLA_DK = D_MODEL // 2 // GLA_HEADS
GLA_DV = D_MODEL // GLA_HEADS
GLA_GATE_RANK = 16
GLA_TAU = 16.0
GLA_CHUNK = 64
MLA_HEADS = 8
QK_NOPE = 128
QK_ROPE = 64
V_HEAD = 128
KV_LORA = 256
Q_LORA = 384
ROPE_THETA = 10000.0
Q_BLOCK = 128
D_FF = 2816
EPS = 1e-6
MAX_POS_OFFSET = 1024

kernel_name = 'gla_mla_yoco_hybrid'


def rmsnorm(x, g):
    xf = x.astype(jnp.float32)
    y = xf * lax.rsqrt(jnp.mean(xf * xf, axis=-1, keepdims=True) + EPS)
    return (y * g.astype(jnp.float32)).astype(x.dtype)


def swiglu(h, w_gu, w_down):
    gate, up = jnp.split(h @ w_gu, 2, axis=-1)
    return (jax.nn.silu(gate) * up) @ w_down


def sublayer(x, shift, scale, gate, g_pre, g_post, fn, res_weight):
    h = rmsnorm(x, g_pre) * (1 + scale[:, None, :]) + shift[:, None, :]
    return x + res_weight * gate[:, None, :] * rmsnorm(fn(h), g_post)


def rope_tables(positions):
    inv_freq = ROPE_THETA ** (-jnp.arange(0, QK_ROPE, 2, dtype=jnp.float32) / QK_ROPE)
    ang = positions.astype(jnp.float32)[..., None] * inv_freq
    return jnp.cos(ang), jnp.sin(ang)


def apply_rope(x, cos, sin):
    cos = cos.astype(x.dtype)
    sin = sin.astype(x.dtype)
    x1, x2 = jnp.split(x, 2, axis=-1)
    return jnp.concatenate([x1 * cos - x2 * sin, x1 * sin + x2 * cos], axis=-1)


def gla_chunked(q, k, v, log_a):
    B, S, H, DK = q.shape
    C = GLA_CHUNK
    N = S // C
    f32 = jnp.float32

    def chunks(t):
        return t.astype(f32).reshape(B, N, C, H, t.shape[-1]).transpose(0, 3, 1, 2, 4)

    q, k, v, log_a = chunks(q) * DK ** -0.5, chunks(k), chunks(v), chunks(log_a)
    b = jnp.cumsum(log_a, axis=3)
    b_last = b[:, :, :, -1:, :]
    q_dec = q * jnp.exp(b)
    k_dec = k * jnp.exp(-b)
    causal = jnp.tril(jnp.ones((C, C), dtype=bool))
    att = jnp.where(causal, jnp.einsum('bhnid,bhnjd->bhnij', q_dec, k_dec), 0.0)
    o_intra = jnp.einsum('bhnij,bhnjv->bhniv', att, v)
    upd = jnp.einsum('bhncd,bhncv->bhndv', k * jnp.exp(b_last - b), v)
    decay = jnp.exp(b_last[:, :, :, 0, :])

    def step(state, inp):
        dec, u = inp
        return dec[..., None] * state + u, state

    s0 = jnp.zeros((B, H, DK, v.shape[-1]), f32)
    _, states = lax.scan(step, s0, (jnp.moveaxis(decay, 2, 0), jnp.moveaxis(upd, 2, 0)))
    states = jnp.moveaxis(states, 0, 2)
    o = o_intra + jnp.einsum('bhncd,bhndv->bhncv', q_dec, states)
    return o.transpose(0, 2, 3, 1, 4).reshape(B, S, H, v.shape[-1])


def gla_mixer(h, w_in, w_gate_up, b_gate, g_out, w_out):
    B, S, _ = h.shape
    kd = GLA_HEADS * GLA_DK
    vd = GLA_HEADS * GLA_DV
    q, k, v, g_low, r = jnp.split(h @ w_in, [kd, 2 * kd, 2 * kd + vd, 2 * kd + vd + GLA_GATE_RANK], axis=-1)
    log_a = jax.nn.log_sigmoid((g_low @ w_gate_up + b_gate).astype(jnp.float32)) / GLA_TAU
    o = gla_chunked(q.reshape(B, S, GLA_HEADS, GLA_DK), k.reshape(B, S, GLA_HEADS, GLA_DK),
                    v.reshape(B, S, GLA_HEADS, GLA_DV), log_a.reshape(B, S, GLA_HEADS, GLA_DK))
    o = rmsnorm(o, g_out).astype(h.dtype).reshape(B, S, vd)
    return (o * jax.nn.silu(r)) @ w_out


def mla_shared_kv(h, w_kv_a, g_kv, w_kv_b, cos, sin):
    B, S, _ = h.shape
    c_kv, k_pe = jnp.split(h @ w_kv_a, [KV_LORA], axis=-1)
    c_kv = rmsnorm(c_kv, g_kv)
    k_rope = apply_rope(k_pe, cos, sin)
    kv = (c_kv @ w_kv_b).reshape(B, S, MLA_HEADS, QK_NOPE + V_HEAD)
    k_nope, v = jnp.split(kv, [QK_NOPE], axis=-1)
    return k_nope, k_rope, v


def mla_mixer(h, k_nope, k_rope, v, w_dq, g_q, w_uq, w_out, cos, sin):
    B, S, _ = h.shape
    c_q = rmsnorm(h @ w_dq, g_q)
    q = (c_q @ w_uq).reshape(B, S, MLA_HEADS, QK_NOPE + QK_ROPE)
    q_nope, q_rope = jnp.split(q, [QK_NOPE], axis=-1)
    q_rope = apply_rope(q_rope, cos[:, :, None, :], sin[:, :, None, :])
    scale = (QK_NOPE + QK_ROPE) ** -0.5
    nb = S // Q_BLOCK
    qn_blocks = q_nope.reshape(B, nb, Q_BLOCK, MLA_HEADS, QK_NOPE).transpose(1, 0, 2, 3, 4)
    qr_blocks = q_rope.reshape(B, nb, Q_BLOCK, MLA_HEADS, QK_ROPE).transpose(1, 0, 2, 3, 4)
    key_pos = jnp.arange(S)
    neg = jnp.finfo(jnp.float32).min

    def attend(args):
        qn, qr, blk = args
        s = (jnp.einsum('bqhd,bkhd->bhqk', qn, k_nope) +
             jnp.einsum('bqhr,bkr->bhqk', qr, k_rope)).astype(jnp.float32) * scale
        q_pos = blk * Q_BLOCK + jnp.arange(Q_BLOCK)
        s = jnp.where(key_pos[None, :] <= q_pos[:, None], s, neg)
        p = jax.nn.softmax(s, axis=-1).astype(v.dtype)
        return jnp.einsum('bhqk,bkhv->bqhv', p, v)

    o = lax.map(attend, (qn_blocks, qr_blocks, jnp.arange(nb)))
    o = o.transpose(1, 0, 2, 3, 4).reshape(B, S, MLA_HEADS * V_HEAD)
    return o @ w_out


def setup_inputs(seed: int = 0) -> dict:
    key = jax.random.key(seed)
    ks = jax.random.split(key, 24)
    D = D_MODEL
    f32 = jnp.float32

    def w(k, shape, fan_in):
        return jax.random.normal(k, shape, f32) * fan_in ** -0.5

    def gain(k, shape):
        return 1.0 + 0.1 * jax.random.normal(k, shape, f32)

    def bias(k, shape):
        return 0.01 * jax.random.normal(k, shape, f32)

    gla_in_cols = 2 * GLA_HEADS * GLA_DK + 2 * GLA_HEADS * GLA_DV + GLA_GATE_RANK
    offsets = jax.random.randint(ks[2], (BATCH, 1), 0, MAX_POS_OFFSET, dtype=jnp.int32)
    return {
        'x': jax.random.normal(ks[0], (BATCH, SEQ, D), f32),
        'c': jax.random.normal(ks[1], (BATCH, D), f32),
        'positions': offsets + jnp.arange(SEQ, dtype=jnp.int32)[None, :],
        'cond_w': w(ks[3], (DEPTH, D, 3 * N_SUBLAYERS * D), D),
        'cond_b': bias(ks[4], (DEPTH, 3 * N_SUBLAYERS * D)),
        'norm_g': gain(ks[5], (DEPTH, N_SUBLAYERS, 2, D)),
        'ffn_w_gu': w(ks[6], (DEPTH, 2, D, 2 * D_FF), D),
        'ffn_w_down': w(ks[7], (DEPTH, 2, D_FF, D), D_FF),
        'gla_w_in': w(ks[8], (N_A_LAYERS, D, gla_in_cols), D),
        'gla_w_gate_up': w(ks[9], (N_A_LAYERS, GLA_GATE_RANK, GLA_HEADS * GLA_DK), GLA_GATE_RANK),
        'gla_b_gate': 0.1 * jax.random.normal(ks[10], (N_A_LAYERS, GLA_HEADS * GLA_DK), f32),
        'gla_g_out': gain(ks[11], (N_A_LAYERS, GLA_DV)),
        'gla_w_out': w(ks[12], (N_A_LAYERS, GLA_HEADS * GLA_DV, D), GLA_HEADS * GLA_DV),
        'kv_g_in': gain(ks[13], (D,)),
        'kv_cond_w': w(ks[14], (D, 2 * D), D),
        'kv_cond_b': bias(ks[15], (2 * D,)),
        'mla_w_kv_a': w(ks[16], (D, KV_LORA + QK_ROPE), D),
        'mla_g_kv': gain(ks[17], (KV_LORA,)),
        'mla_w_kv_b': w(ks[18], (KV_LORA, MLA_HEADS * (QK_NOPE + V_HEAD)), KV_LORA),
        'mla_w_dq': w(ks[19], (N_B_LAYERS, D, Q_LORA), D),
        'mla_g_q': gain(ks[20], (N_B_LAYERS, Q_LORA)),
        'mla_w_uq': w(ks[21], (N_B_LAYERS, Q_LORA, MLA_HEADS * (QK_NOPE + QK_ROPE)), Q_LORA),
        'mla_w_out': w(ks[22], (N_B_LAYERS, MLA_HEADS * V_HEAD, D), MLA_HEADS * V_HEAD),
    }


def reference(x, c, positions, cond_w, cond_b, norm_g, ffn_w_gu, ffn_w_down,
              gla_w_in, gla_w_gate_up, gla_b_gate, gla_g_out, gla_w_out,
              kv_g_in, kv_cond_w, kv_cond_b, mla_w_kv_a, mla_g_kv, mla_w_kv_b,
              mla_w_dq, mla_g_q, mla_w_uq, mla_w_out):
    cos, sin = rope_tables(positions)
    c_act = jax.nn.silu(c)
    k_nope = k_rope = v_shared = None
    for layer in range(DEPTH):
        mods = jnp.split(c_act @ cond_w[layer] + cond_b[layer], 3 * N_SUBLAYERS, axis=-1)
        g = norm_g[layer]
        x = sublayer(x, mods[0], mods[1], mods[2], g[0, 0], g[0, 1],
                     lambda h: swiglu(h, ffn_w_gu[layer, 0], ffn_w_down[layer, 0]), 0.5)
        if layer < N_A_LAYERS:
            i = layer
            x = sublayer(x, mods[3], mods[4], mods[5], g[1, 0], g[1, 1],
                         lambda h: gla_mixer(h, gla_w_in[i], gla_w_gate_up[i], gla_b_gate[i],
                                             gla_g_out[i], gla_w_out[i]), 1.0)
        else:
            i = layer - N_A_LAYERS
            x = sublayer(x, mods[3], mods[4], mods[5], g[1, 0], g[1, 1],
                         lambda h: mla_mixer(h, k_nope, k_rope, v_shared, mla_w_dq[i], mla_g_q[i],
                                             mla_w_uq[i], mla_w_out[i], cos, sin), 1.0)
        x = sublayer(x, mods[6], mods[7], mods[8], g[2, 0], g[2, 1],
                     lambda h: swiglu(h, ffn_w_gu[layer, 1], ffn_w_down[layer, 1]), 0.5)
        if layer == N_A_LAYERS - 1:
            kv_shift, kv_scale = jnp.split(c_act @ kv_cond_w + kv_cond_b, 2, axis=-1)
            h_kv = rmsnorm(x, kv_g_in) * (1 + kv_scale[:, None, :]) + kv_shift[:, None, :]
            k_nope, k_rope, v_shared = mla_shared_kv(h_kv, mla_w_kv_a, mla_g_kv, mla_w_kv_b, cos, sin)
    return x
```

```cpp
#include <hip/hip_runtime.h>
#include <hip/hip_cooperative_groups.h>
#include <cstdio>
namespace cg = cooperative_groups;

#define LAS __attribute__((address_space(3)))
#define DI __device__ __forceinline__
typedef unsigned short bf16_t;
typedef short bf16x8 __attribute__((ext_vector_type(8)));
typedef float f32x2 __attribute__((ext_vector_type(2)));
typedef float f32x4 __attribute__((ext_vector_type(4)));
typedef float f32x16 __attribute__((ext_vector_type(16)));
typedef unsigned u32x2 __attribute__((ext_vector_type(2)));
typedef unsigned u32x4 __attribute__((ext_vector_type(4)));
typedef __bf16 bf16v2 __attribute__((ext_vector_type(2)));

#ifndef MULTI_LAUNCH
#define MULTI_LAUNCH 0
#endif

constexpr int T = 32768, D = 1024, SEQ = 4096, NB = 8, DFF = 2816;
constexpr int NTHREADS = 512;
constexpr int LDS_BYTES = 131072;
constexpr float EPS = 1e-6f;
constexpr int NPH = 27;

constexpr size_t SZ_WGU = (size_t)5632 * 1024 * 2, SZ_WDN = (size_t)1024 * 2816 * 2, SZ_WGIN = (size_t)3328 * 1024 * 2;
constexpr size_t OFF_WGU = 0;
constexpr size_t OFF_WDN = OFF_WGU + SZ_WGU;
constexpr size_t OFF_WGIN = OFF_WDN + SZ_WDN;
constexpr size_t OFF_WGOUT = OFF_WGIN + SZ_WGIN;
constexpr size_t OFF_WKVA = OFF_WGOUT + (size_t)1024 * 1024 * 2;
constexpr size_t OFF_WKVB = OFF_WKVA + (size_t)512 * 1024 * 2;
constexpr size_t OFF_WDQ = OFF_WKVB + (size_t)2048 * 256 * 2;
constexpr size_t OFF_WUQ = OFF_WDQ + (size_t)512 * 1024 * 2;
constexpr size_t OFF_WMOUT = OFF_WUQ + (size_t)1536 * 384 * 2;
constexpr size_t OFF_MODS = OFF_WMOUT + (size_t)1024 * 1024 * 2;
constexpr size_t OFF_KVMODS = OFF_MODS + (size_t)2 * 8 * 9216 * 4;
constexpr size_t OFF_COS = OFF_KVMODS + (size_t)8 * 2048 * 4;
constexpr size_t OFF_SIN = OFF_COS + (size_t)T * 32 * 4;
constexpr size_t OFF_GLOW = OFF_SIN + (size_t)T * 32 * 4;
constexpr size_t OFF_CKVN = OFF_GLOW + (size_t)T * 16 * 4;
constexpr size_t OFF_KROPE = OFF_CKVN + (size_t)T * 256 * 2;
constexpr size_t OFF_H = OFF_KROPE + (size_t)T * 64 * 2;
constexpr size_t OFF_Y = OFF_H + (size_t)T * 1024 * 2;
constexpr size_t OFF_BIG = OFF_Y + (size_t)T * 1024 * 4;
constexpr size_t SZ_BIG = (size_t)T * 2048 * 2 + (size_t)T * 1536 * 2;
constexpr size_t WS_END = OFF_BIG + SZ_BIG;
static_assert(WS_END <= (size_t)536870912, "workspace");
static_assert(SZ_BIG >= (size_t)T * 3328 * 2 && SZ_BIG >= (size_t)T * 2816 * 2, "big");

struct Prm {
    const float* x; const float* c; const int* pos; const float* cond_w; const float* cond_b; const float* norm_g;
    const float* ffn_gu; const float* ffn_dn; const float* gla_w_in; const float* gla_w_gate_up; const float* gla_b_gate;
    const float* gla_g_out; const float* gla_w_out; const float* kv_g_in; const float* kv_cond_w; const float* kv_cond_b;
    const float* w_kv_a; const float* g_kv; const float* w_kv_b; const float* w_dq; const float* g_q; const float* w_uq; const float* w_mout;
    float* out; unsigned char* ws; int ph_lo, ph_hi;
};

DI float bf2f(unsigned short b) { return __uint_as_float(((unsigned)b) << 16); }
DI unsigned pk2(float lo, float hi) { f32x2 v = {lo, hi}; bf16v2 b = __builtin_convertvector(v, bf16v2); return __builtin_bit_cast(unsigned, b); }
DI bf16_t f2bf(float f) { return (bf16_t)(pk2(f, 0.f) & 0xffffu); }
DI float lo_f(unsigned u) { return __uint_as_float(u << 16); }
DI float hi_f(unsigned u) { return __uint_as_float(u & 0xffff0000u); }
DI float wave_sum(float v) {
#pragma unroll
    for (int o = 32; o > 0; o >>= 1) v += __shfl_xor(v, o);
    return v;
}
DI float silu_f(float v) { return v / (1.f + __expf(-v)); }
DI int crow(int reg, int hf) { return (reg & 3) + 8 * (reg >> 2) + 4 * hf; }
DI int lthread() { int t = threadIdx.x; asm volatile("" : "+v"(t)); return t; }
DI int lblock() { int t = blockIdx.x; asm volatile("" : "+s"(t)); return t; }
#define MFMA32(a, b, c) __builtin_amdgcn_mfma_f32_32x32x16_bf16((a), (b), (c), 0, 0, 0)

namespace pg8 {
constexpr int BM = 256, BK = 64, HALF = 128, HTB = HALF * BK * 2, STAGE_BYTES = 8 * HTB, NXCD = 8, WGM = 8;
DI int lds_byte(int r, int c) { const int st = (r >> 4) * 2 + (c >> 5), rr = r & 15, cc = c & 31, ob = rr * 64 + cc * 2; return st * 1024 + (ob ^ (((ob >> 9) & 1) << 5)); }
DI void stage_rc(int b, int& R, int& C) { const int st = b / 1024, sb = b % 1024, swz = sb ^ (((sb >> 9) & 1) << 5); R = (st >> 1) * 16 + swz / 64; C = (st & 1) * 32 + (swz % 64) / 2; }
DI int perm32(int rho) { const int n = rho >> 4, i = rho & 15; return 8 * (i >> 2) + 4 * n + (i & 3); }

struct Unit { int pm, pn; };
struct Gemm { const bf16_t* A; const bf16_t* Bt; int M, N, K; };

struct StaticOrder {
    int nM, nN, nwg, G, c;
    DI void init(int M, int N, int G_, int c_) { nM = M / BM; nN = N / BM; nwg = nM * nN; G = G_; c = c_; }
    DI bool next(int i, Unit& u) const {
        const long L = (long)i * G + c; if (L >= nwg) return false;
        int wgid = (int)L; { const int q = nwg / NXCD, r = nwg % NXCD, xcd = wgid % NXCD, off = wgid / NXCD; wgid = (xcd < r ? xcd * (q + 1) : r * (q + 1) + (xcd - r) * q) + off; }
        const int nig = WGM * nN, gid = wgid / nig, fm = gid * WGM, gsz = (nM - fm) < WGM ? (nM - fm) : WGM;
        u.pm = fm + ((wgid % nig) % gsz); u.pn = (wgid % nig) / gsz; return true;
    }
};

struct EpiF32 {
    static constexpr bool PERM = false;
    float* C; int ldc;
    DI void operator()(const f32x4 (&acc)[2][2][4][2], const Unit& u, int wr, int wc, int fr, int fq) const {
        const int row0 = u.pm * BM + wr * 64 + fr, col0 = u.pn * BM + wc * 32 + 4 * fq;
#pragma unroll
        for (int ai = 0; ai < 2; ++ai)
#pragma unroll
            for (int m = 0; m < 4; ++m) { float* rowp = C + (size_t)(row0 + ai * HALF + m * 16) * ldc + col0;
#pragma unroll
                for (int bj = 0; bj < 2; ++bj)
#pragma unroll
                    for (int n = 0; n < 2; ++n) *(f32x4*)(rowp + bj * HALF + n * 16) = acc[ai][bj][m][n]; }
    }
};
struct EpiBf16 {
    static constexpr bool PERM = true;
    bf16_t* O; int ldc; float* glow; int glow_pn;
    DI void operator()(const f32x4 (&acc)[2][2][4][2], const Unit& u, int wr, int wc, int fr, int fq) const {
        const int row0 = u.pm * BM + wr * 64 + fr, col0 = u.pn * BM + wc * 32 + 8 * fq;
        const bool gl = (glow != nullptr) && (u.pn == glow_pn) && (wc == 0) && (fq < 2);
#pragma unroll
        for (int ai = 0; ai < 2; ++ai)
#pragma unroll
            for (int m = 0; m < 4; ++m) { const int row = row0 + ai * HALF + m * 16; bf16_t* rowp = O + (size_t)row * ldc + col0;
#pragma unroll
                for (int bj = 0; bj < 2; ++bj) { const f32x4 v0 = acc[ai][bj][m][0], v1 = acc[ai][bj][m][1];
                    u32x4 pk; pk[0] = pk2(v0[0], v0[1]); pk[1] = pk2(v0[2], v0[3]); pk[2] = pk2(v1[0], v1[1]); pk[3] = pk2(v1[2], v1[3]);
                    *(u32x4*)(rowp + bj * HALF) = pk;
                    if (bj == 0 && gl) { *(f32x4*)(glow + (size_t)row * 16 + 8 * fq) = v0; *(f32x4*)(glow + (size_t)row * 16 + 8 * fq + 4) = v1; } } }
    }
};
struct EpiSwiglu {
    static constexpr bool PERM = true;
    bf16_t* O;
    DI void operator()(const f32x4 (&acc)[2][2][4][2], const Unit& u, int wr, int wc, int fr, int fq) const {
        const int row0 = u.pm * BM + wr * 64 + fr, col0 = u.pn * HALF + wc * 32 + 8 * fq;
#pragma unroll
        for (int ai = 0; ai < 2; ++ai)
#pragma unroll
            for (int m = 0; m < 4; ++m) { bf16_t* rowp = O + (size_t)(row0 + ai * HALF + m * 16) * DFF + col0;
                const f32x4 g0 = acc[ai][0][m][0], g1 = acc[ai][0][m][1], u0 = acc[ai][1][m][0], u1 = acc[ai][1][m][1];
                u32x4 pk;
                pk[0] = pk2(silu_f(g0[0]) * u0[0], silu_f(g0[1]) * u0[1]); pk[1] = pk2(silu_f(g0[2]) * u0[2], silu_f(g0[3]) * u0[3]);
                pk[2] = pk2(silu_f(g1[0]) * u1[0], silu_f(g1[1]) * u1[1]); pk[3] = pk2(silu_f(g1[2]) * u1[2], silu_f(g1[3]) * u1[3]);
                *(u32x4*)rowp = pk; }
    }
};

template <class Epi>
DI void gemm_phase(LAS unsigned char* lds, const Gemm g, const StaticOrder& S, const Epi& E) {
    const int tid = lthread(), wid = __builtin_amdgcn_readfirstlane(tid >> 6), lane = tid & 63, wr = wid >> 2, wc = wid & 3, fr = lane & 15, fq = lane >> 4;
    const int K = g.K, nt = K / BK;
    unsigned voffA[2], voffB[2];
#pragma unroll
    for (int i = 0; i < 2; ++i) { int R, C; stage_rc(tid * 16 + i * 8192, R, C); const int Rb = Epi::PERM ? ((R & ~31) + perm32(R & 31)) : R;
        voffA[i] = (unsigned)(R * K + C) * 2u; voffB[i] = (unsigned)(Rb * K + C) * 2u; }
    const size_t kstep = (size_t)(BK * 2);
    const size_t hstep = (size_t)HALF * K * 2;
    const size_t tstep = 2 * hstep;
    const unsigned ldsw = (unsigned)wid * 1024u;
    const int aoff = lds_byte(wr * 64 + fr, fq * 8), boff = lds_byte(wc * 32 + fr, fq * 8);
#define PG8_SA(b, h) (((b) * 2 + (h)) * HTB)
#define PG8_SB(b, h) ((4 + (b) * 2 + (h)) * HTB)
#define PG8_STAGE(bufoff, gbase, voff) do { _Pragma("unroll") for (int _i = 0; _i < 2; ++_i) \
        __builtin_amdgcn_global_load_lds((const unsigned*)((const char*)(gbase) + (voff)[_i]), (LAS unsigned*)(lds + (bufoff) + ldsw + _i * 8192), 16, 0, 0); } while (0)
#define PG8_LDA(dst, b, h) do { _Pragma("unroll") for (int m = 0; m < 4; ++m) _Pragma("unroll") for (int k = 0; k < 2; ++k) dst[m][k] = *(const LAS bf16x8*)(lds + PG8_SA(b, h) + aoff + m * 2048 + k * 1024); } while (0)
#define PG8_LDB(dst, b, h) do { _Pragma("unroll") for (int n = 0; n < 2; ++n) _Pragma("unroll") for (int k = 0; k < 2; ++k) dst[n][k] = *(const LAS bf16x8*)(lds + PG8_SB(b, h) + boff + n * 2048 + k * 1024); } while (0)
#define PG8_MMA(ai, bj, At, Bt) do { __builtin_amdgcn_s_setprio(1); _Pragma("unroll") for (int m = 0; m < 4; ++m) _Pragma("unroll") for (int n = 0; n < 2; ++n) _Pragma("unroll") for (int k = 0; k < 2; ++k) \
        acc[ai][bj][m][n] = __builtin_amdgcn_mfma_f32_16x16x32_bf16(Bt[n][k], At[m][k], acc[ai][bj][m][n], 0, 0, 0); __builtin_amdgcn_s_setprio(0); } while (0)
#define PG8_WAIT_V(n) asm volatile("s_waitcnt vmcnt(" #n ")" ::: "memory")
#define PG8_WAIT_L(n) asm volatile("s_waitcnt lgkmcnt(" #n ")" ::: "memory")
#define PG8_BAR __builtin_amdgcn_s_barrier()
#define PG8_SCHED __builtin_amdgcn_sched_barrier(0)
    Unit cur, nxt; int ui = 0;
    if (!S.next(0, cur)) return;
    f32x4 acc[2][2][4][2];
#pragma unroll
    for (int a = 0; a < 2; ++a)
#pragma unroll
        for (int b = 0; b < 2; ++b)
#pragma unroll
            for (int m = 0; m < 4; ++m)
#pragma unroll
                for (int n = 0; n < 2; ++n) acc[a][b][m][n] = (f32x4){0.f, 0.f, 0.f, 0.f};
    bf16x8 At[4][2], B0[2][2], B1[2][2];
    const char* cA = (const char*)g.A + (size_t)cur.pm * tstep; const char* cB = (const char*)g.Bt + (size_t)cur.pn * tstep;
    PG8_STAGE(PG8_SB(0, 0), cB, voffB); PG8_STAGE(PG8_SA(0, 0), cA, voffA); PG8_STAGE(PG8_SB(0, 1), cB + hstep, voffB); PG8_STAGE(PG8_SA(0, 1), cA + hstep, voffA);
    if (wr == 1) PG8_BAR;
    PG8_WAIT_V(4); PG8_BAR;
    PG8_STAGE(PG8_SB(1, 0), cB + kstep, voffB); PG8_STAGE(PG8_SA(1, 0), cA + kstep, voffA); PG8_STAGE(PG8_SB(1, 1), cB + hstep + kstep, voffB);
    PG8_WAIT_V(6); PG8_BAR;
    for (;;) {
        const bool has_next = S.next(ui + 1, nxt);
        const char* nA = has_next ? (const char*)g.A + (size_t)nxt.pm * tstep : cA; const char* nB = has_next ? (const char*)g.Bt + (size_t)nxt.pn * tstep : cB;
        for (int t = 0; t < nt; t += 2) {
            const bool last = (t == nt - 2);
            const char* a1 = cA + (size_t)(t + 1) * kstep;
            const char* a2 = last ? nA : cA + (size_t)(t + 2) * kstep; const char* b2 = last ? nB : cB + (size_t)(t + 2) * kstep;
            const char* a3 = a2 + kstep; const char* b3 = b2 + kstep;
            PG8_LDB(B0, 0, 0); PG8_SCHED; PG8_LDA(At, 0, 0); PG8_STAGE(PG8_SA(1, 1), a1 + hstep, voffA);
            PG8_WAIT_L(8); PG8_BAR; PG8_WAIT_L(0); PG8_MMA(0, 0, At, B0); PG8_BAR; PG8_SCHED;
            PG8_LDB(B1, 0, 1); PG8_STAGE(PG8_SB(0, 0), b2, voffB);
            PG8_BAR; PG8_WAIT_L(0); PG8_MMA(0, 1, At, B1); PG8_BAR;
            PG8_LDA(At, 0, 1); PG8_STAGE(PG8_SA(0, 0), a2, voffA);
            PG8_BAR; PG8_WAIT_L(0); PG8_MMA(1, 0, At, B0); PG8_BAR; PG8_SCHED;
            PG8_STAGE(PG8_SB(0, 1), b2 + hstep, voffB);
            PG8_WAIT_V(6); PG8_BAR; PG8_MMA(1, 1, At, B1); PG8_BAR;
            PG8_LDB(B0, 1, 0); PG8_SCHED; PG8_LDA(At, 1, 0); PG8_STAGE(PG8_SA(0, 1), a2 + hstep, voffA);
            PG8_WAIT_L(8); PG8_BAR; PG8_WAIT_L(0); PG8_MMA(0, 0, At, B0); PG8_BAR; PG8_SCHED;
            PG8_LDB(B1, 1, 1); PG8_STAGE(PG8_SB(1, 0), b3, voffB);
            PG8_BAR; PG8_WAIT_L(0); PG8_MMA(0, 1, At, B1); PG8_BAR;
            PG8_LDA(At, 1, 1); PG8_STAGE(PG8_SA(1, 0), a3, voffA);
            PG8_BAR; PG8_WAIT_L(0); PG8_MMA(1, 0, At, B0); PG8_BAR; PG8_SCHED;
            PG8_STAGE(PG8_SB(1, 1), b3 + hstep, voffB);
            PG8_WAIT_V(6); PG8_BAR; PG8_MMA(1, 1, At, B1); PG8_BAR;
        }
        E(acc, cur, wr, wc, fr, fq);
        if (!has_next) break;
#pragma unroll
        for (int a = 0; a < 2; ++a)
#pragma unroll
            for (int b = 0; b < 2; ++b)
#pragma unroll
                for (int m = 0; m < 4; ++m)
#pragma unroll
                    for (int n = 0; n < 2; ++n) acc[a][b][m][n] = (f32x4){0.f, 0.f, 0.f, 0.f};
        cur = nxt; cA = nA; cB = nB; ++ui;
    }
    PG8_WAIT_V(0);
    if (wr == 0) PG8_BAR;
    PG8_BAR;
#undef PG8_SA
#undef PG8_SB
#undef PG8_STAGE
#undef PG8_LDA
#undef PG8_LDB
#undef PG8_MMA
#undef PG8_WAIT_V
#undef PG8_WAIT_L
#undef PG8_BAR
#undef PG8_SCHED
}
}

enum { WM_ID = 0, WM_GU, WM_GIN, WM_LIM320, WM_LIM384 };
DI int wmap(int mode, int r) {
    switch (mode) {
        case WM_GU: { const int t = r >> 8, w = r & 255; return w < 128 ? t * 128 + w : DFF + t * 128 + (w - 128); }
        case WM_GIN: return r < 2048 ? r : (r < 3072 ? r + 16 : (r < 3088 ? r - 1024 : -1));
        case WM_LIM320: return r < 320 ? r : -1;
        case WM_LIM384: return r < 384 ? r : -1;
        default: return r;
    }
}
DI void convert_w(LAS unsigned char* lds, const float* __restrict__ src, int K, int N, bf16_t* __restrict__ dst, int Nd, int mode) {
    LAS float* tile = (LAS float*)lds;
    const int tid = lthread(), ntk = K >> 6, ntiles = (Nd >> 6) * ntk;
    for (int t = lblock(); t < ntiles; t += gridDim.x) {
        const int r0 = (t / ntk) << 6, k0 = (t % ntk) << 6;
        { const int j = tid & 63, i0 = tid >> 6; const int n = wmap(mode, r0 + j);
#pragma unroll
          for (int ii = 0; ii < 8; ++ii) { const int i = i0 + ii * 8; tile[i * 65 + j] = (n >= 0) ? src[(size_t)(k0 + i) * N + n] : 0.f; } }
        __syncthreads();
        { const int i = tid & 63, j0 = tid >> 6;
#pragma unroll
          for (int jj = 0; jj < 8; ++jj) { const int j = j0 + jj * 8; dst[(size_t)(r0 + j) * K + k0 + i] = f2bf(tile[i * 65 + j]); } }
        __syncthreads();
    }
}
DI void convert_ffn(LAS unsigned char* lds, const Prm& p, int l, int f) {
    const int idx = l * 2 + f;
    convert_w(lds, p.ffn_gu + (size_t)idx * 1024 * 5632, 1024, 5632, (bf16_t*)(p.ws + OFF_WGU), 5632, WM_GU);
    convert_w(lds, p.ffn_dn + (size_t)idx * 2816 * 1024, 2816, 1024, (bf16_t*)(p.ws + OFF_WDN), 1024, WM_ID);
}

DI void mods_phase(LAS unsigned char* lds, const Prm& p) {
    LAS float* cact = (LAS float*)lds;
    LAS float* red = (LAS float*)(lds + 32768);
    const int tid = lthread();
    for (int i = tid; i < 8192; i += NTHREADS) cact[i] = silu_f(p.c[i]);
    __syncthreads();
    float* mods = (float*)(p.ws + OFF_MODS); float* kvm = (float*)(p.ws + OFF_KVMODS);
    for (int item = lblock(); item < 320; item += gridDim.x) {
        const int col0 = item * 64;
        const float* W; int N, cc; const float* bias; float* out; int obs;
        if (col0 < 18432) { const int l = col0 / 9216; cc = col0 - l * 9216; W = p.cond_w + (size_t)l * 1024 * 9216; N = 9216; bias = p.cond_b + l * 9216; out = mods + (size_t)l * 8 * 9216; obs = 9216; }
        else { cc = col0 - 18432; W = p.kv_cond_w; N = 2048; bias = p.kv_cond_b; out = kvm; obs = 2048; }
        const int j = tid & 63, kg = tid >> 6;
        float a0 = 0.f, a1 = 0.f, a2 = 0.f, a3 = 0.f, a4 = 0.f, a5 = 0.f, a6 = 0.f, a7 = 0.f;
        const float* wp = W + (size_t)(kg * 128) * N + cc + j;
#pragma unroll 4
        for (int k = 0; k < 128; ++k) { const float w = wp[(size_t)k * N]; const int kk = kg * 128 + k;
            a0 += cact[kk] * w; a1 += cact[1024 + kk] * w; a2 += cact[2048 + kk] * w; a3 += cact[3072 + kk] * w;
            a4 += cact[4096 + kk] * w; a5 += cact[5120 + kk] * w; a6 += cact[6144 + kk] * w; a7 += cact[7168 + kk] * w; }
        red[(kg * 8 + 0) * 64 + j] = a0; red[(kg * 8 + 1) * 64 + j] = a1; red[(kg * 8 + 2) * 64 + j] = a2; red[(kg * 8 + 3) * 64 + j] = a3;
        red[(kg * 8 + 4) * 64 + j] = a4; red[(kg * 8 + 5) * 64 + j] = a5; red[(kg * 8 + 6) * 64 + j] = a6; red[(kg * 8 + 7) * 64 + j] = a7;
        __syncthreads();
        { const int b = tid >> 6; float s = bias[cc + j];
#pragma unroll
          for (int q = 0; q < 8; ++q) s += red[(q * 8 + b) * 64 + j];
          out[(size_t)b * obs + cc + j] = s; }
        __syncthreads();
    }
}
DI void rope_tables(const Prm& p) {
    float* COS = (float*)(p.ws + OFF_COS); float* SIN = (float*)(p.ws + OFF_SIN);
    const int gt = lblock() * NTHREADS + lthread(), nth = gridDim.x * NTHREADS;
    for (int idx = gt; idx < T * 32; idx += nth) {
        const int t = idx >> 5, i = idx & 31;
        const float inv = powf(10000.f, -(float)(2 * i) / 64.f);
        const float ang = (float)p.pos[t] * inv;
        COS[idx] = cosf(ang); SIN[idx] = sinf(ang);
    }
}

struct RowP {
    const float* xin; const float* y; float* xout; float rw; const float* gate; int gate_bs; const float* g_post;
    const float* g1; const float* sh1; const float* sc1; int bs1; bf16_t* h1;
    const float* g2; const float* sh2; const float* sc2; int bs2; bf16_t* h2;
};
DI void rowwise_phase(const RowP& a) {
    const int tidx_ = lthread(); const int lane = tidx_ & 63, gw = lblock() * 8 + (tidx_ >> 6), nw = gridDim.x * 8;
    for (int row = gw; row < T; row += nw) {
        const int b = row >> 12;
        f32x4 xv[4];
#pragma unroll
        for (int i = 0; i < 4; ++i) xv[i] = *(const f32x4*)(a.xin + (size_t)row * D + i * 256 + lane * 4);
        if (a.y) {
            f32x4 yv[4]; float ss = 0.f;
#pragma unroll
            for (int i = 0; i < 4; ++i) { yv[i] = *(const f32x4*)(a.y + (size_t)row * D + i * 256 + lane * 4);
                ss += yv[i][0] * yv[i][0] + yv[i][1] * yv[i][1] + yv[i][2] * yv[i][2] + yv[i][3] * yv[i][3]; }
            ss = wave_sum(ss);
            const float rstd = rsqrtf(ss * (1.f / D) + EPS) * a.rw;
#pragma unroll
            for (int i = 0; i < 4; ++i) { const int col = i * 256 + lane * 4;
                const f32x4 gt = *(const f32x4*)(a.gate + (size_t)b * a.gate_bs + col), gp = *(const f32x4*)(a.g_post + col);
                xv[i] = xv[i] + gt * (yv[i] * rstd) * gp;
                *(f32x4*)(a.xout + (size_t)row * D + col) = xv[i]; }
        }
        if (a.h1) {
            float ss = 0.f;
#pragma unroll
            for (int i = 0; i < 4; ++i) ss += xv[i][0] * xv[i][0] + xv[i][1] * xv[i][1] + xv[i][2] * xv[i][2] + xv[i][3] * xv[i][3];
            ss = wave_sum(ss);
            const float rstd = rsqrtf(ss * (1.f / D) + EPS);
#pragma unroll
            for (int i = 0; i < 4; ++i) { const int col = i * 256 + lane * 4;
                const f32x4 g = *(const f32x4*)(a.g1 + col), sc = *(const f32x4*)(a.sc1 + (size_t)b * a.bs1 + col), sh = *(const f32x4*)(a.sh1 + (size_t)b * a.bs1 + col);
                const f32x4 hv = (xv[i] * rstd) * g * (sc + 1.f) + sh;
                u32x2 pk; pk[0] = pk2(hv[0], hv[1]); pk[1] = pk2(hv[2], hv[3]);
                *(u32x2*)(a.h1 + (size_t)row * D + col) = pk; }
            if (a.h2) {
#pragma unroll
                for (int i = 0; i < 4; ++i) { const int col = i * 256 + lane * 4;
                    const f32x4 g = *(const f32x4*)(a.g2 + col), sc = *(const f32x4*)(a.sc2 + (size_t)b * a.bs2 + col), sh = *(const f32x4*)(a.sh2 + (size_t)b * a.bs2 + col);
                    const f32x4 hv = (xv[i] * rstd) * g * (sc + 1.f) + sh;
                    u32x2 pk; pk[0] = pk2(hv[0], hv[1]); pk[1] = pk2(hv[2], hv[3]);
                    *(u32x2*)(a.h2 + (size_t)row * D + col) = pk; }
            }
        }
    }
}

DI void ckv_phase(const Prm& p) {
    const float* raw = (const float*)(p.ws + OFF_Y); bf16_t* ckvn = (bf16_t*)(p.ws + OFF_CKVN); bf16_t* krope = (bf16_t*)(p.ws + OFF_KROPE);
    const float* COS = (const float*)(p.ws + OFF_COS); const float* SIN = (const float*)(p.ws + OFF_SIN);
    const int tidx_ = lthread(); const int lane = tidx_ & 63, gw = lblock() * 8 + (tidx_ >> 6), nw = gridDim.x * 8;
    for (int row = gw; row < T; row += nw) {
        const f32x4 v = *(const f32x4*)(raw + (size_t)row * 512 + lane * 4);
        float ss = wave_sum(v[0] * v[0] + v[1] * v[1] + v[2] * v[2] + v[3] * v[3]);
        const float rstd = rsqrtf(ss * (1.f / 256.f) + EPS);
        const f32x4 g = *(const f32x4*)(p.g_kv + lane * 4);
        u32x2 pk; pk[0] = pk2(v[0] * rstd * g[0], v[1] * rstd * g[1]); pk[1] = pk2(v[2] * rstd * g[2], v[3] * rstd * g[3]);
        *(u32x2*)(ckvn + (size_t)row * 256 + lane * 4) = pk;
        if (lane < 32) {
            const float x1 = raw[(size_t)row * 512 + 256 + lane], x2 = raw[(size_t)row * 512 + 288 + lane];
            const float c = COS[(size_t)row * 32 + lane], s = SIN[(size_t)row * 32 + lane];
            krope[(size_t)row * 64 + lane] = f2bf(x1 * c - x2 * s);
            krope[(size_t)row * 64 + 32 + lane] = f2bf(x1 * s + x2 * c);
        }
    }
}
DI void cq_phase(const Prm& p) {
    const float* raw = (const float*)(p.ws + OFF_Y); bf16_t* cqn = (bf16_t*)(p.ws + OFF_Y + (size_t)T * 512 * 4);
    const int tidx_ = lthread(); const int lane = tidx_ & 63, gw = lblock() * 8 + (tidx_ >> 6), nw = gridDim.x * 8;
    for (int row = gw; row < T; row += nw) {
        f32x2 v[3]; float ss = 0.f;
#pragma unroll
        for (int i = 0; i < 3; ++i) { v[i] = *(const f32x2*)(raw + (size_t)row * 512 + i * 128 + lane * 2); ss += v[i][0] * v[i][0] + v[i][1] * v[i][1]; }
        ss = wave_sum(ss);
        const float rstd = rsqrtf(ss * (1.f / 384.f) + EPS);
#pragma unroll
        for (int i = 0; i < 3; ++i) { const f32x2 g = *(const f32x2*)(p.g_q + i * 128 + lane * 2);
            *(unsigned*)(cqn + (size_t)row * 384 + i * 128 + lane * 2) = pk2(v[i][0] * rstd * g[0], v[i][1] * rstd * g[1]); }
    }
}
DI void gla_gate_phase(const Prm& p) {
    const float* og = (const float*)(p.ws + OFF_Y); const bf16_t* proj = (const bf16_t*)(p.ws + OFF_BIG); bf16_t* hout = (bf16_t*)(p.ws + OFF_H);
    const int tidx_ = lthread(); const int lane = tidx_ & 63, gw = lblock() * 8 + (tidx_ >> 6), nw = gridDim.x * 8;
    for (int row = gw; row < T; row += nw) {
        f32x4 v[4]; float ss = 0.f;
#pragma unroll
        for (int i = 0; i < 4; ++i) { v[i] = *(const f32x4*)(og + (size_t)row * D + lane * 16 + i * 4); ss += v[i][0] * v[i][0] + v[i][1] * v[i][1] + v[i][2] * v[i][2] + v[i][3] * v[i][3]; }
#pragma unroll
        for (int o = 8; o > 0; o >>= 1) ss += __shfl_xor(ss, o);
        const float rstd = rsqrtf(ss * (1.f / 256.f) + EPS);
        const u32x4 r0 = *(const u32x4*)(proj + (size_t)row * 3328 + 2048 + lane * 16), r1 = *(const u32x4*)(proj + (size_t)row * 3328 + 2048 + lane * 16 + 8);
        const int gc = (lane & 15) * 16;
        u32x4 o0, o1;
#pragma unroll
        for (int i = 0; i < 4; ++i) {
            const f32x4 g = *(const f32x4*)(p.gla_g_out + gc + i * 4);
            const unsigned ra = (i < 2) ? r0[2 * i] : r1[2 * (i - 2)], rb = (i < 2) ? r0[2 * i + 1] : r1[2 * (i - 2) + 1];
            const float e0 = v[i][0] * rstd * g[0] * silu_f(lo_f(ra)), e1 = v[i][1] * rstd * g[1] * silu_f(hi_f(ra));
            const float e2 = v[i][2] * rstd * g[2] * silu_f(lo_f(rb)), e3 = v[i][3] * rstd * g[3] * silu_f(hi_f(rb));
            if (i < 2) { o0[2 * i] = pk2(e0, e1); o0[2 * i + 1] = pk2(e2, e3); } else { o1[2 * (i - 2)] = pk2(e0, e1); o1[2 * (i - 2) + 1] = pk2(e2, e3); }
        }
        *(u32x4*)(hout + (size_t)row * D + lane * 16) = o0; *(u32x4*)(hout + (size_t)row * D + lane * 16 + 8) = o1;
    }
}

DI void gla_phase(LAS unsigned char* lds, const Prm& p) {
    const int tid = lthread(), wid = __builtin_amdgcn_readfirstlane(tid >> 6), lane = tid & 63, r = lane & 31, hf = lane >> 5;
    LAS float* GL = (LAS float*)(lds);
    LAS float* LA = (LAS float*)(lds + 4096);
    LAS float* SEG = (LAS float*)(lds + 36864);
    LAS float* BL = (LAS float*)(lds + 38912);
    LAS unsigned char* QD = lds + 39424;
    LAS unsigned char* KD = lds + 56832;
    LAS unsigned char* KUT = lds + 74240;
    LAS unsigned char* VTs = lds + 92672;
    LAS unsigned char* ATT = lds + 97280;
    LAS unsigned char* ST = lds + 106496;
    const bf16_t* proj = (const bf16_t*)(p.ws + OFF_BIG); const float* glow = (const float*)(p.ws + OFF_GLOW); float* og = (float*)(p.ws + OFF_Y);
    const float qscale = 0.08838834764831845f;
    for (int item = lblock(); item < 256; item += gridDim.x) {
        const int b = item >> 5, h = (item >> 3) & 3, sl = item & 7;
        const int seg = tid >> 7, c = tid & 127;
        float wg[16];
#pragma unroll
        for (int q = 0; q < 16; ++q) wg[q] = p.gla_w_gate_up[q * 512 + h * 128 + c];
        const float bg = p.gla_b_gate[h * 128 + c];
        for (int i = tid; i < 32 * 136 / 2; i += NTHREADS) ((LAS unsigned*)ST)[i] = 0u;
        f32x16 Sacc;
#pragma unroll
        for (int q = 0; q < 16; ++q) Sacc[q] = 0.f;
        __syncthreads();
        const size_t tok0 = (size_t)b * SEQ;
        u32x4 qraw[2], kraw[2], vraw; f32x4 glraw;
        const int qrow0 = tid >> 4, qc8 = tid & 15;
        const int vrow = tid >> 2, vc8 = tid & 3;
#define GLA_LOAD(n_) do { const size_t t0_ = tok0 + (size_t)(n_) * 64; \
        _Pragma("unroll") for (int it = 0; it < 2; ++it) { const bf16_t* rp = proj + (t0_ + qrow0 + 32 * it) * 3328 + h * 128 + qc8 * 8; qraw[it] = *(const u32x4*)rp; kraw[it] = *(const u32x4*)(rp + 512); } \
        if (tid < 256) { vraw = *(const u32x4*)(proj + (t0_ + vrow) * 3328 + 1024 + h * 256 + sl * 32 + vc8 * 8); glraw = *(const f32x4*)(glow + (t0_ + vrow) * 16 + vc8 * 4); } } while (0)
        GLA_LOAD(0);
        for (int n = 0; n < 64; ++n) {
            const size_t t0 = tok0 + (size_t)n * 64;
            if (tid < 256) *(LAS f32x4*)(GL + vrow * 16 + vc8 * 4) = glraw;
            __syncthreads();
            float bs[16]; float run = 0.f;
#pragma unroll
            for (int i = 0; i < 16; ++i) { const int row = seg * 16 + i; float z = bg;
                const f32x4 g0 = *(const LAS f32x4*)(GL + row * 16), g1 = *(const LAS f32x4*)(GL + row * 16 + 4), g2 = *(const LAS f32x4*)(GL + row * 16 + 8), g3 = *(const LAS f32x4*)(GL + row * 16 + 12);
                z += g0[0] * wg[0] + g0[1] * wg[1] + g0[2] * wg[2] + g0[3] * wg[3] + g1[0] * wg[4] + g1[1] * wg[5] + g1[2] * wg[6] + g1[3] * wg[7]
                   + g2[0] * wg[8] + g2[1] * wg[9] + g2[2] * wg[10] + g2[3] * wg[11] + g3[0] * wg[12] + g3[1] * wg[13] + g3[2] * wg[14] + g3[3] * wg[15];
                const float ls = fminf(z, 0.f) - log1pf(expf(-fabsf(z)));
                run += ls * 0.0625f; bs[i] = run; }
            SEG[seg * 128 + c] = run;
            __syncthreads();
            { float off = 0.f;
#pragma unroll
              for (int s = 0; s < 3; ++s) off += (s < seg) ? SEG[s * 128 + c] : 0.f;
#pragma unroll
              for (int i = 0; i < 16; ++i) LA[(seg * 16 + i) * 128 + c] = bs[i] + off;
              if (seg == 3) BL[c] = bs[15] + off; }
            __syncthreads();
#pragma unroll
            for (int it = 0; it < 2; ++it) { const int row = qrow0 + 32 * it;
                const f32x4 b0 = *(const LAS f32x4*)(LA + row * 128 + qc8 * 8), b1 = *(const LAS f32x4*)(LA + row * 128 + qc8 * 8 + 4);
                const f32x4 l0 = *(const LAS f32x4*)(BL + qc8 * 8), l1 = *(const LAS f32x4*)(BL + qc8 * 8 + 4);
                u32x4 qd, kd;
#pragma unroll
                for (int j2 = 0; j2 < 4; ++j2) {
                    const float ba = (j2 < 2) ? b0[2 * j2] : b1[2 * (j2 - 2)], bb = (j2 < 2) ? b0[2 * j2 + 1] : b1[2 * (j2 - 2) + 1];
                    const float la_ = (j2 < 2) ? l0[2 * j2] : l1[2 * (j2 - 2)], lb_ = (j2 < 2) ? l0[2 * j2 + 1] : l1[2 * (j2 - 2) + 1];
                    const float qa = lo_f(qraw[it][j2]), qb = hi_f(qraw[it][j2]), ka = lo_f(kraw[it][j2]), kb = hi_f(kraw[it][j2]);
                    qd[j2] = pk2(qa * qscale * __expf(ba), qb * qscale * __expf(bb));
                    kd[j2] = pk2(ka * __expf(-ba), kb * __expf(-bb));
                    *(LAS bf16_t*)(KUT + ((qc8 * 8 + 2 * j2) * 72 + row) * 2) = f2bf(ka * __expf(la_ - ba));
                    *(LAS bf16_t*)(KUT + ((qc8 * 8 + 2 * j2 + 1) * 72 + row) * 2) = f2bf(kb * __expf(lb_ - bb));
                }
                *(LAS u32x4*)(QD + (row * 136 + qc8 * 8) * 2) = qd; *(LAS u32x4*)(KD + (row * 136 + qc8 * 8) * 2) = kd; }
            if (tid < 256) {
#pragma unroll
                for (int j2 = 0; j2 < 4; ++j2) {
                    *(LAS bf16_t*)(VTs + ((vc8 * 8 + 2 * j2) * 72 + vrow) * 2) = (bf16_t)(vraw[j2] & 0xffffu);
                    *(LAS bf16_t*)(VTs + ((vc8 * 8 + 2 * j2 + 1) * 72 + vrow) * 2) = (bf16_t)(vraw[j2] >> 16); }
            }
            if (n < 63) GLA_LOAD(n + 1);
            __syncthreads();
            if (wid < 4) {
                const int ti = wid >> 1, tj = wid & 1;
                f32x16 acc;
#pragma unroll
                for (int q = 0; q < 16; ++q) acc[q] = 0.f;
                if (tj <= ti) {
#pragma unroll
                    for (int ks = 0; ks < 8; ++ks) {
                        const bf16x8 a = *(const LAS bf16x8*)(QD + ((32 * ti + r) * 136 + ks * 16 + 8 * hf) * 2);
                        const bf16x8 bb = *(const LAS bf16x8*)(KD + ((32 * tj + r) * 136 + ks * 16 + 8 * hf) * 2);
                        acc = MFMA32(a, bb, acc); }
                }
#pragma unroll
                for (int q = 0; q < 16; ++q) { const int i = 32 * ti + crow(q, hf), j = 32 * tj + r;
                    const float v = (j <= i) ? acc[q] : 0.f;
                    *(LAS bf16_t*)(ATT + (i * 72 + j) * 2) = f2bf(v); }
            } else {
                const int dt = wid - 4;
#pragma unroll
                for (int q = 0; q < 16; ++q) Sacc[q] *= __expf(BL[32 * dt + crow(q, hf)]);
#pragma unroll
                for (int ks = 0; ks < 4; ++ks) {
                    const bf16x8 a = *(const LAS bf16x8*)(KUT + ((32 * dt + r) * 72 + ks * 16 + 8 * hf) * 2);
                    const bf16x8 bb = *(const LAS bf16x8*)(VTs + (r * 72 + ks * 16 + 8 * hf) * 2);
                    Sacc = MFMA32(a, bb, Sacc); }
            }
            __syncthreads();
            if (wid < 2) {
                const int ti = wid;
                f32x16 acc;
#pragma unroll
                for (int q = 0; q < 16; ++q) acc[q] = 0.f;
#pragma unroll
                for (int ks = 0; ks < 4; ++ks) {
                    const bf16x8 a = *(const LAS bf16x8*)(ATT + ((32 * ti + r) * 72 + ks * 16 + 8 * hf) * 2);
                    const bf16x8 bb = *(const LAS bf16x8*)(VTs + (r * 72 + ks * 16 + 8 * hf) * 2);
                    acc = MFMA32(a, bb, acc); }
#pragma unroll
                for (int ks = 0; ks < 8; ++ks) {
                    const bf16x8 a = *(const LAS bf16x8*)(QD + ((32 * ti + r) * 136 + ks * 16 + 8 * hf) * 2);
                    const bf16x8 bb = *(const LAS bf16x8*)(ST + (r * 136 + ks * 16 + 8 * hf) * 2);
                    acc = MFMA32(a, bb, acc); }
#pragma unroll
                for (int q = 0; q < 16; ++q) og[(t0 + 32 * ti + crow(q, hf)) * D + h * 256 + sl * 32 + r] = acc[q];
            }
            __syncthreads();
            if (wid >= 4) {
                const int dt = wid - 4;
#pragma unroll
                for (int g = 0; g < 4; ++g) { u32x2 pk; pk[0] = pk2(Sacc[4 * g], Sacc[4 * g + 1]); pk[1] = pk2(Sacc[4 * g + 2], Sacc[4 * g + 3]);
                    *(LAS u32x2*)(ST + (r * 136 + 32 * dt + 8 * g + 4 * hf) * 2) = pk; }
            }
        }
#undef GLA_LOAD
        __syncthreads();
    }
}

DI void attn_phase(LAS unsigned char* lds, const Prm& p) {
    const int tid = lthread(), wid = __builtin_amdgcn_readfirstlane(tid >> 6), lane = tid & 63, r = lane & 31, hf = lane >> 5;
    constexpr int KT_STRIDE = 400, KT_BYTES = 64 * KT_STRIDE, VT_STRIDE = 144, VT_BYTES = 128 * VT_STRIDE;
    LAS unsigned char* KT = lds;
    LAS unsigned char* VT = lds + 2 * KT_BYTES;
    const bf16_t* Q = (const bf16_t*)(p.ws + OFF_BIG + (size_t)T * 2048 * 2); const bf16_t* KV = (const bf16_t*)(p.ws + OFF_BIG);
    const bf16_t* KR = (const bf16_t*)(p.ws + OFF_KROPE); bf16_t* AO = (bf16_t*)(p.ws + OFF_H);
    const float* COS = (const float*)(p.ws + OFF_COS); const float* SIN = (const float*)(p.ws + OFF_SIN);
    const float SC = 0.07216878364870322f * 1.4426950408889634f;
    for (int it = lblock(); it < 1024; it += gridDim.x) {
        const int pass = it >> 8, blk = it & 255, bh = blk & 63, g = blk >> 6;
        const int qt = (pass == 0) ? g : (pass == 1) ? 7 - g : (pass == 2) ? 8 + g : 15 - g;
        const int b = bh >> 3, h = bh & 7, q0 = qt * 256;
        const size_t tok0 = (size_t)b * SEQ;
        const int qpos = q0 + 32 * wid + r;
        const size_t qrow = tok0 + qpos;
        bf16x8 qf[12];
        { const bf16_t* qp = Q + qrow * 1536 + h * 192 + 8 * hf;
#pragma unroll
          for (int ks = 0; ks < 12; ++ks) qf[ks] = *(const bf16x8*)(qp + ks * 16);
#pragma unroll
          for (int pr = 0; pr < 2; ++pr) {
              const int i0 = 16 * pr + 8 * hf;
              const f32x4 c0 = *(const f32x4*)(COS + qrow * 32 + i0), c1 = *(const f32x4*)(COS + qrow * 32 + i0 + 4);
              const f32x4 s0 = *(const f32x4*)(SIN + qrow * 32 + i0), s1 = *(const f32x4*)(SIN + qrow * 32 + i0 + 4);
              bf16x8 x1v = qf[8 + pr], x2v = qf[10 + pr], o1, o2;
#pragma unroll
              for (int j = 0; j < 8; ++j) { const float cc = (j < 4) ? c0[j & 3] : c1[j & 3], ss = (j < 4) ? s0[j & 3] : s1[j & 3];
                  const float x1 = bf2f((unsigned short)x1v[j]), x2 = bf2f((unsigned short)x2v[j]);
                  o1[j] = (short)f2bf(x1 * cc - x2 * ss); o2[j] = (short)f2bf(x1 * ss + x2 * cc); }
              qf[8 + pr] = o1; qf[10 + pr] = o2; } }
        float m = -1e30f, l = 0.f;
        f32x16 O[4];
#pragma unroll
        for (int d = 0; d < 4; ++d)
#pragma unroll
            for (int q = 0; q < 16; ++q) O[d][q] = 0.f;
        const int nkt = 4 * (qt + 1);
        u32x4 kraw[3], vraw[2];
        const int kkey = tid >> 4, kc8 = tid & 15;
        const int rkey = tid >> 3, rc8 = tid & 7;
        const int vp = tid >> 4, vc8 = tid & 15;
        const int vrd0 = r * VT_STRIDE + 8 * ((hf) ^ (r >> 3)), vrd1 = r * VT_STRIDE + 8 * ((2 + hf) ^ (r >> 3));
const unsigned offk0 = (unsigned)(kkey * 2048 + kc8 * 8), offk1 = offk0 + 32u * 2048u, offr = (unsigned)(rkey * 64 + rc8 * 8);
        const unsigned offv0 = (unsigned)(2 * vp * 2048 + 128 + vc8 * 8), offv1 = offv0 + 2048u;
        const bf16_t* kvb0 = KV + tok0 * 2048 + h * 256; const bf16_t* krb0 = KR + tok0 * 64;
#define ATT_LOAD(kt_) do { const bf16_t* kvb_ = kvb0 + (size_t)(kt_) * 64 * 2048; const bf16_t* krb_ = krb0 + (size_t)(kt_) * 64 * 64; \
        kraw[0] = *(const u32x4*)(kvb_ + offk0); kraw[1] = *(const u32x4*)(kvb_ + offk1); \
        kraw[2] = *(const u32x4*)(krb_ + offr); \
        vraw[0] = *(const u32x4*)(kvb_ + offv0); vraw[1] = *(const u32x4*)(kvb_ + offv1); } while (0)
#define ATT_STORE(buf_) do { LAS unsigned char* kt_ = KT + (buf_) * KT_BYTES; LAS unsigned char* vt_ = VT + (buf_) * VT_BYTES; \
        *(LAS u32x4*)(kt_ + kkey * KT_STRIDE + kc8 * 16) = kraw[0]; *(LAS u32x4*)(kt_ + (kkey + 32) * KT_STRIDE + kc8 * 16) = kraw[1]; \
        *(LAS u32x4*)(kt_ + rkey * KT_STRIDE + 256 + rc8 * 16) = kraw[2]; \
        _Pragma("unroll") for (int j2 = 0; j2 < 4; ++j2) { \
            const unsigned lo_ = (vraw[0][j2] & 0xffffu) | (vraw[1][j2] << 16), hi_ = (vraw[0][j2] >> 16) | (vraw[1][j2] & 0xffff0000u); \
            *(LAS unsigned*)(vt_ + (vc8 * 8 + 2 * j2) * VT_STRIDE + 4 * (vp ^ (2 * vc8))) = lo_; \
            *(LAS unsigned*)(vt_ + (vc8 * 8 + 2 * j2 + 1) * VT_STRIDE + 4 * (vp ^ (2 * vc8))) = hi_; } } while (0)
        ATT_LOAD(0); ATT_STORE(0);
        __syncthreads();
        for (int kt = 0; kt < nkt; ++kt) {
            const int cur = kt & 1;
            const bool more = (kt + 1 < nkt);
            if (more) ATT_LOAD(kt + 1);
            const int kbase = kt * 64;
            if (kbase <= q0 + 32 * wid + 31) {
                const LAS unsigned char* ktb = KT + cur * KT_BYTES; const LAS unsigned char* vtb = VT + cur * VT_BYTES;
                f32x16 s0, s1;
#pragma unroll
                for (int q = 0; q < 16; ++q) { s0[q] = 0.f; s1[q] = 0.f; }
#pragma unroll
                for (int ks = 0; ks < 12; ++ks) {
                    const bf16x8 a0 = *(const LAS bf16x8*)(ktb + r * KT_STRIDE + ks * 32 + 16 * hf);
                    const bf16x8 a1 = *(const LAS bf16x8*)(ktb + (32 + r) * KT_STRIDE + ks * 32 + 16 * hf);
                    s0 = MFMA32(a0, qf[ks], s0); s1 = MFMA32(a1, qf[ks], s1);
                    }
                const bool diag = (kbase + 63 > q0 + 32 * wid);
                float mx = -1e30f;
#pragma unroll
                for (int q = 0; q < 16; ++q) {
                    float v0 = s0[q] * SC, v1 = s1[q] * SC;
                    if (diag) { const int key = kbase + crow(q, hf); if (key > qpos) v0 = -1e30f; if (key + 32 > qpos) v1 = -1e30f; }
                    s0[q] = v0; s1[q] = v1; mx = fmaxf(mx, fmaxf(v0, v1)); }
                mx = fmaxf(mx, __shfl_xor(mx, 32));
                const float mn = fmaxf(m, mx), alpha = __builtin_amdgcn_exp2f(m - mn);
                m = mn;
                float ls = 0.f;
#pragma unroll
                for (int q = 0; q < 16; ++q) { s0[q] = __builtin_amdgcn_exp2f(s0[q] - mn); s1[q] = __builtin_amdgcn_exp2f(s1[q] - mn); ls += s0[q] + s1[q]; }
                l = l * alpha + ls;
#pragma unroll
                for (int d = 0; d < 4; ++d)
#pragma unroll
                    for (int q = 0; q < 16; ++q) O[d][q] *= alpha;
                bf16x8 pb[2][2];
#pragma unroll
                for (int s = 0; s < 2; ++s) {
                    u32x4 t0, t1;
#pragma unroll
                    for (int j2 = 0; j2 < 4; ++j2) { t0[j2] = pk2(s0[8 * s + 2 * j2], s0[8 * s + 2 * j2 + 1]); t1[j2] = pk2(s1[8 * s + 2 * j2], s1[8 * s + 2 * j2 + 1]); }
                    pb[0][s] = __builtin_bit_cast(bf16x8, t0); pb[1][s] = __builtin_bit_cast(bf16x8, t1); }
#pragma unroll
                for (int d = 0; d < 4; ++d) {
#pragma unroll
                    for (int ksub = 0; ksub < 2; ++ksub)
#pragma unroll
                        for (int s = 0; s < 2; ++s) {
                            const int imm = d * 32 * VT_STRIDE + 32 * (((2 * ksub + s) ^ d) & 3);
                            const u32x2 lo = *(const LAS u32x2*)(vtb + vrd0 + imm);
                            const u32x2 hi = *(const LAS u32x2*)(vtb + vrd1 + imm);
                            u32x4 av; av[0] = lo[0]; av[1] = lo[1]; av[2] = hi[0]; av[3] = hi[1];
                            O[d] = MFMA32(__builtin_bit_cast(bf16x8, av), pb[ksub][s], O[d]); }
                }
            }
            if (more) ATT_STORE(cur ^ 1);
            __syncthreads();
        }
#undef ATT_LOAD
#undef ATT_STORE
        l += __shfl_xor(l, 32);
        const float inv = 1.f / l;
#pragma unroll
        for (int d = 0; d < 4; ++d)
#pragma unroll
            for (int g4 = 0; g4 < 4; ++g4) { u32x2 pk; pk[0] = pk2(O[d][4 * g4] * inv, O[d][4 * g4 + 1] * inv); pk[1] = pk2(O[d][4 * g4 + 2] * inv, O[d][4 * g4 + 3] * inv);
                *(u32x2*)(AO + qrow * D + h * 128 + 32 * d + 8 * g4 + 4 * hf) = pk; }
    }
}

__global__ void __launch_bounds__(NTHREADS) fwd_megakernel(Prm p) {
    extern __shared__ __attribute__((aligned(16))) unsigned char lds_raw[];
    LAS unsigned char* lds = (LAS unsigned char*)lds_raw;
    cg::grid_group grid = cg::this_grid();
    unsigned char* ws = p.ws;
    float* mods = (float*)(ws + OFF_MODS); float* kvm = (float*)(ws + OFF_KVMODS);
    bf16_t* H = (bf16_t*)(ws + OFF_H); float* Y = (float*)(ws + OFF_Y); bf16_t* BIG = (bf16_t*)(ws + OFF_BIG);
    const int G = gridDim.x, cblk = lblock();
#pragma unroll 1
    for (int ph = p.ph_lo; ph < p.ph_hi; ++ph) {
        switch (ph) {
        case 0: {
            mods_phase(lds, p);
            rope_tables(p);
            convert_w(lds, p.gla_w_in, 1024, 3088, (bf16_t*)(ws + OFF_WGIN), 3328, WM_GIN);
            convert_w(lds, p.gla_w_out, 1024, 1024, (bf16_t*)(ws + OFF_WGOUT), 1024, WM_ID);
            convert_w(lds, p.w_kv_a, 1024, 320, (bf16_t*)(ws + OFF_WKVA), 512, WM_LIM320);
            convert_w(lds, p.w_kv_b, 256, 2048, (bf16_t*)(ws + OFF_WKVB), 2048, WM_ID);
            convert_w(lds, p.w_dq, 1024, 384, (bf16_t*)(ws + OFF_WDQ), 512, WM_LIM384);
            convert_w(lds, p.w_uq, 384, 1536, (bf16_t*)(ws + OFF_WUQ), 1536, WM_ID);
            convert_w(lds, p.w_mout, 1024, 1024, (bf16_t*)(ws + OFF_WMOUT), 1024, WM_ID);
            convert_ffn(lds, p, 0, 0);
        } break;
        case 1: case 4: case 9: case 12: case 17: case 23: case 26: {
            const int ps = (ph == 1) ? -1 : (ph == 4) ? 0 : (ph == 9) ? 1 : (ph == 12) ? 2 : (ph == 17) ? 3 : (ph == 23) ? 4 : 5;
            RowP a;
            a.xin = (ph <= 4) ? p.x : p.out; a.y = nullptr; a.xout = p.out; a.rw = 0.f; a.gate = nullptr; a.gate_bs = 9216; a.g_post = nullptr;
            a.g1 = nullptr; a.sh1 = nullptr; a.sc1 = nullptr; a.bs1 = 9216; a.h1 = nullptr; a.g2 = nullptr; a.sh2 = nullptr; a.sc2 = nullptr; a.bs2 = 2048; a.h2 = nullptr;
            if (ps >= 0) { const int l = ps / 3, s = ps % 3; a.y = Y; a.rw = (s == 1) ? 1.f : 0.5f;
                a.gate = mods + (size_t)l * 8 * 9216 + (3 * s + 2) * 1024; a.g_post = p.norm_g + ((l * 3 + s) * 2 + 1) * 1024; }
            const int pre = ps + 1;
            if (pre < 6) { const int l = pre / 3, s = pre % 3; a.h1 = H; a.g1 = p.norm_g + ((l * 3 + s) * 2) * 1024;
                a.sh1 = mods + (size_t)l * 8 * 9216 + (3 * s) * 1024; a.sc1 = mods + (size_t)l * 8 * 9216 + (3 * s + 1) * 1024; }
            if (ph == 12) { a.h2 = BIG; a.g2 = p.kv_g_in; a.sh2 = kvm; a.sc2 = kvm + 1024; }
            rowwise_phase(a);
            if (ph == 4) convert_ffn(lds, p, 0, 1);
            if (ph == 12) convert_ffn(lds, p, 1, 0);
            if (ph == 17) convert_ffn(lds, p, 1, 1);
        } break;
        case 2: case 10: case 15: case 24: {
            pg8::Gemm g{H, (const bf16_t*)(ws + OFF_WGU), T, 5632, 1024}; pg8::StaticOrder S; S.init(T, 5632, G, cblk);
            pg8::EpiSwiglu E{BIG};
            pg8::gemm_phase<pg8::EpiSwiglu>(lds, g, S, E);
        } break;
        case 3: case 11: case 16: case 25: case 8: case 22: case 13: {
            pg8::Gemm g; pg8::EpiF32 E;
            if (ph == 8) { g = pg8::Gemm{H, (const bf16_t*)(ws + OFF_WGOUT), T, 1024, 1024}; E = pg8::EpiF32{Y, 1024}; }
            else if (ph == 22) { g = pg8::Gemm{H, (const bf16_t*)(ws + OFF_WMOUT), T, 1024, 1024}; E = pg8::EpiF32{Y, 1024}; }
            else if (ph == 13) { g = pg8::Gemm{BIG, (const bf16_t*)(ws + OFF_WKVA), T, 512, 1024}; E = pg8::EpiF32{Y, 512}; }
            else { g = pg8::Gemm{BIG, (const bf16_t*)(ws + OFF_WDN), T, 1024, 2816}; E = pg8::EpiF32{Y, 1024}; }
            pg8::StaticOrder S; S.init(T, g.N, G, cblk);
            pg8::gemm_phase<pg8::EpiF32>(lds, g, S, E);
        } break;
        case 5: case 20: {
            pg8::Gemm g; pg8::EpiBf16 E;
            if (ph == 5) { g = pg8::Gemm{H, (const bf16_t*)(ws + OFF_WGIN), T, 3328, 1024}; E = pg8::EpiBf16{BIG, 3328, (float*)(ws + OFF_GLOW), 12}; }
            else { g = pg8::Gemm{(const bf16_t*)(ws + OFF_Y + (size_t)T * 512 * 4), (const bf16_t*)(ws + OFF_WUQ), T, 1536, 384}; E = pg8::EpiBf16{(bf16_t*)(ws + OFF_BIG + (size_t)T * 2048 * 2), 1536, nullptr, -1}; }
            pg8::StaticOrder S; S.init(T, g.N, G, cblk);
            pg8::gemm_phase<pg8::EpiBf16>(lds, g, S, E);
        } break;
        case 6: gla_phase(lds, p); break;
        case 7: gla_gate_phase(p); break;
        case 14: ckv_phase(p); break;
        case 18: {
            { pg8::Gemm g{H, (const bf16_t*)(ws + OFF_WDQ), T, 512, 1024}; pg8::EpiF32 E{Y, 512}; pg8::StaticOrder S; S.init(T, 512, G, cblk);
              pg8::gemm_phase<pg8::EpiF32>(lds, g, S, E); }
            { pg8::Gemm g{(const bf16_t*)(ws + OFF_CKVN), (const bf16_t*)(ws + OFF_WKVB), T, 2048, 256}; pg8::EpiBf16 E{BIG, 2048, nullptr, -1}; pg8::StaticOrder S; S.init(T, 2048, G, cblk);
              pg8::gemm_phase<pg8::EpiBf16>(lds, g, S, E); }
        } break;
        case 19: cq_phase(p); break;
        case 21: attn_phase(lds, p); break;
        default: break;
        }
        if (ph + 1 < p.ph_hi) grid.sync();
    }
}

extern "C" void kernel_launch(void* const* d_in, const int* in_sizes, int n_in, void* d_out, int out_size, void* d_ws, size_t ws_size, hipStream_t stream) {
    static int grid_blocks = 0;
    if (grid_blocks == 0) {
        if (n_in != 23 || ws_size < WS_END) { fprintf(stderr, "kernel_launch: unexpected n_in %d / ws %zu (need %zu)\n", n_in, ws_size, (size_t)WS_END); grid_blocks = -1; return; }
        int dev = 0, cus = 0, per_cu = 0;
        hipGetDevice(&dev);
        hipDeviceGetAttribute(&cus, hipDeviceAttributeMultiprocessorCount, dev);
        if (hipFuncSetAttribute((const void*)fwd_megakernel, hipFuncAttributeMaxDynamicSharedMemorySize, LDS_BYTES) != hipSuccess) { fprintf(stderr, "kernel_launch: hipFuncSetAttribute failed\n"); grid_blocks = -1; return; }
        if (hipOccupancyMaxActiveBlocksPerMultiprocessor(&per_cu, (const void*)fwd_megakernel, NTHREADS, LDS_BYTES) != hipSuccess || per_cu < 1) { fprintf(stderr, "kernel_launch: occupancy query says %d\n", per_cu); per_cu = 1; }
        (void)hipGetLastError();
        grid_blocks = cus * 1;
        fprintf(stderr, "kernel_launch: cus %d per_cu %d grid %d\n", cus, per_cu, grid_blocks);
    }
    if (grid_blocks < 0) return;
    Prm p{};
    p.x = (const float*)d_in[0]; p.c = (const float*)d_in[1]; p.pos = (const int*)d_in[2]; p.cond_w = (const float*)d_in[3]; p.cond_b = (const float*)d_in[4];
    p.norm_g = (const float*)d_in[5]; p.ffn_gu = (const float*)d_in[6]; p.ffn_dn = (const float*)d_in[7]; p.gla_w_in = (const float*)d_in[8];
    p.gla_w_gate_up = (const float*)d_in[9]; p.gla_b_gate = (const float*)d_in[10]; p.gla_g_out = (const float*)d_in[11]; p.gla_w_out = (const float*)d_in[12];
    p.kv_g_in = (const float*)d_in[13]; p.kv_cond_w = (const float*)d_in[14]; p.kv_cond_b = (const float*)d_in[15]; p.w_kv_a = (const float*)d_in[16];
    p.g_kv = (const float*)d_in[17]; p.w_kv_b = (const float*)d_in[18]; p.w_dq = (const float*)d_in[19]; p.g_q = (const float*)d_in[20];
    p.w_uq = (const float*)d_in[21]; p.w_mout = (const float*)d_in[22];
    p.out = (float*)d_out; p.ws = (unsigned char*)d_ws;
#if MULTI_LAUNCH
    for (int ph = 0; ph < NPH; ++ph) {
        p.ph_lo = ph; p.ph_hi = ph + 1;
        hipLaunchKernelGGL(fwd_megakernel, dim3(grid_blocks), dim3(NTHREADS), LDS_BYTES, stream, p);
    }
#else
    p.ph_lo = 0; p.ph_hi = NPH;
    void* args[] = {&p};
    hipError_t e = hipLaunchCooperativeKernel((const void*)fwd_megakernel, dim3(grid_blocks), dim3(NTHREADS), args, LDS_BYTES, stream);
    if (e != hipSuccess) fprintf(stderr, "cooperative launch failed: %s (grid %d)\n", hipGetErrorString(e), grid_blocks);
#endif
}
```

```cpp
#include <hip/hip_runtime.h>
#include <hip/hip_cooperative_groups.h>
#include <cstdio>
namespace cg = cooperative_groups;

#define LAS __attribute__((address_space(3)))
#define DI __device__ __forceinline__
typedef unsigned short bf16_t;
typedef short bf16x8 __attribute__((ext_vector_type(8)));
typedef float f32x2 __attribute__((ext_vector_type(2)));
typedef float f32x4 __attribute__((ext_vector_type(4)));
typedef float f32x16 __attribute__((ext_vector_type(16)));
typedef unsigned u32x2 __attribute__((ext_vector_type(2)));
typedef unsigned u32x4 __attribute__((ext_vector_type(4)));
typedef __bf16 bf16v2 __attribute__((ext_vector_type(2)));

#ifndef MULTI_LAUNCH
#define MULTI_LAUNCH 0
#endif
#ifndef DUP_MASK
#define DUP_MASK 0u
#endif

constexpr int T = 32768, D = 1024, SEQ = 4096, NB = 8, DFF = 2816;
constexpr int NTHREADS = 512;
constexpr int LDS_BYTES = 131072 + 16;
constexpr float EPS = 1e-6f;
constexpr int NPH = 27;

constexpr size_t SZ_WGU = (size_t)5632 * 1024 * 2, SZ_WDN = (size_t)1024 * 2816 * 2, SZ_WGIN = (size_t)3328 * 1024 * 2;
constexpr size_t OFF_WGU = 0;
constexpr size_t OFF_WDN = OFF_WGU + SZ_WGU;
constexpr size_t OFF_WGIN = OFF_WDN + SZ_WDN;
constexpr size_t OFF_WGOUT = OFF_WGIN + SZ_WGIN;
constexpr size_t OFF_WKVA = OFF_WGOUT + (size_t)1024 * 1024 * 2;
constexpr size_t OFF_WKVB = OFF_WKVA + (size_t)512 * 1024 * 2;
constexpr size_t OFF_WDQ = OFF_WKVB + (size_t)2048 * 256 * 2;
constexpr size_t OFF_WUQ = OFF_WDQ + (size_t)512 * 1024 * 2;
constexpr size_t OFF_WMOUT = OFF_WUQ + (size_t)1536 * 384 * 2;
constexpr size_t OFF_MODS = OFF_WMOUT + (size_t)1024 * 1024 * 2;
constexpr size_t OFF_KVMODS = OFF_MODS + (size_t)2 * 8 * 9216 * 4;
constexpr size_t OFF_COS = OFF_KVMODS + (size_t)8 * 2048 * 4;
constexpr size_t OFF_SIN = OFF_COS + (size_t)T * 32 * 4;
constexpr size_t OFF_GLOW = OFF_SIN + (size_t)T * 32 * 4;
constexpr size_t OFF_CKVN = OFF_GLOW + (size_t)T * 16 * 4;
constexpr size_t OFF_KROPE = OFF_CKVN + (size_t)T * 256 * 2;
constexpr size_t OFF_H = OFF_KROPE + (size_t)T * 64 * 2;
constexpr size_t OFF_Y = OFF_H + (size_t)T * 1024 * 2;
constexpr size_t OFF_BIG = OFF_Y + (size_t)T * 1024 * 4;
constexpr size_t SZ_BIG = (size_t)T * 2048 * 2 + (size_t)T * 1536 * 2;
constexpr size_t OFF_BAR = OFF_BIG + SZ_BIG;
constexpr size_t WS_END = OFF_BAR + 16384;
static_assert(WS_END <= (size_t)536870912, "workspace");
static_assert(SZ_BIG >= (size_t)T * 3328 * 2 && SZ_BIG >= (size_t)T * 2816 * 2, "big");

struct Prm {
    const float* x; const float* c; const int* pos; const float* cond_w; const float* cond_b; const float* norm_g;
    const float* ffn_gu; const float* ffn_dn; const float* gla_w_in; const float* gla_w_gate_up; const float* gla_b_gate;
    const float* gla_g_out; const float* gla_w_out; const float* kv_g_in; const float* kv_cond_w; const float* kv_cond_b;
    const float* w_kv_a; const float* g_kv; const float* w_kv_b; const float* w_dq; const float* g_q; const float* w_uq; const float* w_mout;
    float* out; unsigned char* ws; int ph_lo, ph_hi;
};

DI float bf2f(unsigned short b) { return __uint_as_float(((unsigned)b) << 16); }
DI unsigned pk2(float lo, float hi) { f32x2 v = {lo, hi}; bf16v2 b = __builtin_convertvector(v, bf16v2); return __builtin_bit_cast(unsigned, b); }
DI bf16_t f2bf(float f) { return (bf16_t)(pk2(f, 0.f) & 0xffffu); }
DI float lo_f(unsigned u) { return __uint_as_float(u << 16); }
DI float hi_f(unsigned u) { return __uint_as_float(u & 0xffff0000u); }
DI float wave_sum(float v) {
#pragma unroll
    for (int o = 32; o > 0; o >>= 1) v += __shfl_xor(v, o);
    return v;
}
DI float silu_f(float v) { return v / (1.f + __expf(-v)); }
DI int crow(int reg, int hf) { return (reg & 3) + 8 * (reg >> 2) + 4 * hf; }
DI int lthread() { int t = threadIdx.x; asm volatile("" : "+v"(t)); return t; }
DI int lblock() { int t = blockIdx.x; asm volatile("" : "+s"(t)); return t; }
#define MFMA32(a, b, c) __builtin_amdgcn_mfma_f32_32x32x16_bf16((a), (b), (c), 0, 0, 0)

namespace pg8 {
constexpr int BM = 256, BK = 64, HALF = 128, HTB = HALF * BK * 2, STAGE_BYTES = 8 * HTB, NXCD = 8, WGM = 8;
DI int lds_byte(int r, int c) { const int st = (r >> 4) * 2 + (c >> 5), rr = r & 15, cc = c & 31, ob = rr * 64 + cc * 2; return st * 1024 + (ob ^ (((ob >> 9) & 1) << 5)); }
DI void stage_rc(int b, int& R, int& C) { const int st = b / 1024, sb = b % 1024, swz = sb ^ (((sb >> 9) & 1) << 5); R = (st >> 1) * 16 + swz / 64; C = (st & 1) * 32 + (swz % 64) / 2; }
DI int perm32(int rho) { const int n = rho >> 4, i = rho & 15; return 8 * (i >> 2) + 4 * n + (i & 3); }

struct Unit { int pm, pn; };
struct Gemm { const bf16_t* A; const bf16_t* Bt; int M, N, K; };

struct StaticOrder {
    int nM, nN, nwg, G, c;
    DI void init(int M, int N, int G_, int c_) { nM = M / BM; nN = N / BM; nwg = nM * nN; G = G_; c = c_; }
    DI bool next(int i, Unit& u) const {
        const long L = (long)i * G + c; if (L >= nwg) return false;
        int wgid = (int)L; { const int q = nwg / NXCD, r = nwg % NXCD, xcd = wgid % NXCD, off = wgid / NXCD; wgid = (xcd < r ? xcd * (q + 1) : r * (q + 1) + (xcd - r) * q) + off; }
        const int nig = WGM * nN, gid = wgid / nig, fm = gid * WGM, gsz = (nM - fm) < WGM ? (nM - fm) : WGM;
        u.pm = fm + ((wgid % nig) % gsz); u.pn = (wgid % nig) / gsz; return true;
    }
};

struct EpiF32 {
    static constexpr bool PERM = false;
    float* C; int ldc;
    DI void operator()(const f32x4 (&acc)[2][2][4][2], const Unit& u, int wr, int wc, int fr, int fq) const {
        const int row0 = u.pm * BM + wr * 64 + fr, col0 = u.pn * BM + wc * 32 + 4 * fq;
#pragma unroll
        for (int ai = 0; ai < 2; ++ai)
#pragma unroll
            for (int m = 0; m < 4; ++m) { float* rowp = C + (size_t)(row0 + ai * HALF + m * 16) * ldc + col0;
#pragma unroll
                for (int bj = 0; bj < 2; ++bj)
#pragma unroll
                    for (int n = 0; n < 2; ++n) *(f32x4*)(rowp + bj * HALF + n * 16) = acc[ai][bj][m][n]; }
    }
};
struct EpiBf16 {
    static constexpr bool PERM = true;
    bf16_t* O; int ldc; float* glow; int glow_pn;
    DI void operator()(const f32x4 (&acc)[2][2][4][2], const Unit& u, int wr, int wc, int fr, int fq) const {
        const int row0 = u.pm * BM + wr * 64 + fr, col0 = u.pn * BM + wc * 32 + 8 * fq;
        const bool gl = (glow != nullptr) && (u.pn == glow_pn) && (wc == 0) && (fq < 2);
#pragma unroll
        for (int ai = 0; ai < 2; ++ai)
#pragma unroll
            for (int m = 0; m < 4; ++m) { const int row = row0 + ai * HALF + m * 16; bf16_t* rowp = O + (size_t)row * ldc + col0;
#pragma unroll
                for (int bj = 0; bj < 2; ++bj) { const f32x4 v0 = acc[ai][bj][m][0], v1 = acc[ai][bj][m][1];
                    u32x4 pk; pk[0] = pk2(v0[0], v0[1]); pk[1] = pk2(v0[2], v0[3]); pk[2] = pk2(v1[0], v1[1]); pk[3] = pk2(v1[2], v1[3]);
                    *(u32x4*)(rowp + bj * HALF) = pk;
                    if (bj == 0 && gl) { *(f32x4*)(glow + (size_t)row * 16 + 8 * fq) = v0; *(f32x4*)(glow + (size_t)row * 16 + 8 * fq + 4) = v1; } } }
    }
};
struct EpiSwiglu {
    static constexpr bool PERM = true;
    bf16_t* O;
    DI void operator()(const f32x4 (&acc)[2][2][4][2], const Unit& u, int wr, int wc, int fr, int fq) const {
        const int row0 = u.pm * BM + wr * 64 + fr, col0 = u.pn * HALF + wc * 32 + 8 * fq;
#pragma unroll
        for (int ai = 0; ai < 2; ++ai)
#pragma unroll
            for (int m = 0; m < 4; ++m) { bf16_t* rowp = O + (size_t)(row0 + ai * HALF + m * 16) * DFF + col0;
                const f32x4 g0 = acc[ai][0][m][0], g1 = acc[ai][0][m][1], u0 = acc[ai][1][m][0], u1 = acc[ai][1][m][1];
                u32x4 pk;
                pk[0] = pk2(silu_f(g0[0]) * u0[0], silu_f(g0[1]) * u0[1]); pk[1] = pk2(silu_f(g0[2]) * u0[2], silu_f(g0[3]) * u0[3]);
                pk[2] = pk2(silu_f(g1[0]) * u1[0], silu_f(g1[1]) * u1[1]); pk[3] = pk2(silu_f(g1[2]) * u1[2], silu_f(g1[3]) * u1[3]);
                *(u32x4*)rowp = pk; }
    }
};

template <class Epi>
DI void gemm_phase(LAS unsigned char* lds, const Gemm g, const StaticOrder& S, const Epi& E) {
    const int tid = lthread(), wid = __builtin_amdgcn_readfirstlane(tid >> 6), lane = tid & 63, wr = wid >> 2, wc = wid & 3, fr = lane & 15, fq = lane >> 4;
    const int K = g.K, nt = K / BK;
    unsigned voffA[2], voffB[2];
#pragma unroll
    for (int i = 0; i < 2; ++i) { int R, C; stage_rc(tid * 16 + i * 8192, R, C); const int Rb = Epi::PERM ? ((R & ~31) + perm32(R & 31)) : R;
        voffA[i] = (unsigned)(R * K + C) * 2u; voffB[i] = (unsigned)(Rb * K + C) * 2u; }
    const size_t kstep = (size_t)(BK * 2);
    const size_t hstep = (size_t)HALF * K * 2;
    const size_t tstep = 2 * hstep;
    const unsigned ldsw = (unsigned)wid * 1024u;
    const int aoff = lds_byte(wr * 64 + fr, fq * 8), boff = lds_byte(wc * 32 + fr, fq * 8);
#define PG8_SA(b, h) (((b) * 2 + (h)) * HTB)
#define PG8_SB(b, h) ((4 + (b) * 2 + (h)) * HTB)
#define PG8_STAGE(bufoff, gbase, voff) do { _Pragma("unroll") for (int _i = 0; _i < 2; ++_i) \
        __builtin_amdgcn_global_load_lds((const unsigned*)((const char*)(gbase) + (voff)[_i]), (LAS unsigned*)(lds + (bufoff) + ldsw + _i * 8192), 16, 0, 0); } while (0)
#define PG8_LDA(dst, b, h) do { _Pragma("unroll") for (int m = 0; m < 4; ++m) _Pragma("unroll") for (int k = 0; k < 2; ++k) dst[m][k] = *(const LAS bf16x8*)(lds + PG8_SA(b, h) + aoff + m * 2048 + k * 1024); } while (0)
#define PG8_LDB(dst, b, h) do { _Pragma("unroll") for (int n = 0; n < 2; ++n) _Pragma("unroll") for (int k = 0; k < 2; ++k) dst[n][k] = *(const LAS bf16x8*)(lds + PG8_SB(b, h) + boff + n * 2048 + k * 1024); } while (0)
#define PG8_MMA(ai, bj, At, Bt) do { __builtin_amdgcn_s_setprio(1); _Pragma("unroll") for (int m = 0; m < 4; ++m) _Pragma("unroll") for (int n = 0; n < 2; ++n) _Pragma("unroll") for (int k = 0; k < 2; ++k) \
        acc[ai][bj][m][n] = __builtin_amdgcn_mfma_f32_16x16x32_bf16(Bt[n][k], At[m][k], acc[ai][bj][m][n], 0, 0, 0); __builtin_amdgcn_s_setprio(0); } while (0)
#define PG8_WAIT_V(n) asm volatile("s_waitcnt vmcnt(" #n ")" ::: "memory")
#define PG8_WAIT_L(n) asm volatile("s_waitcnt lgkmcnt(" #n ")" ::: "memory")
#define PG8_BAR __builtin_amdgcn_s_barrier()
#define PG8_SCHED __builtin_amdgcn_sched_barrier(0)
    Unit cur, nxt; int ui = 0;
    if (!S.next(0, cur)) return;
    f32x4 acc[2][2][4][2];
#pragma unroll
    for (int a = 0; a < 2; ++a)
#pragma unroll
        for (int b = 0; b < 2; ++b)
#pragma unroll
            for (int m = 0; m < 4; ++m)
#pragma unroll
                for (int n = 0; n < 2; ++n) acc[a][b][m][n] = (f32x4){0.f, 0.f, 0.f, 0.f};
    bf16x8 At[4][2], B0[2][2], B1[2][2];
    const char* cA = (const char*)g.A + (size_t)cur.pm * tstep; const char* cB = (const char*)g.Bt + (size_t)cur.pn * tstep;
    PG8_STAGE(PG8_SB(0, 0), cB, voffB); PG8_STAGE(PG8_SA(0, 0), cA, voffA); PG8_STAGE(PG8_SB(0, 1), cB + hstep, voffB); PG8_STAGE(PG8_SA(0, 1), cA + hstep, voffA);
    if (wr == 1) PG8_BAR;
    PG8_WAIT_V(4); PG8_BAR;
    PG8_STAGE(PG8_SB(1, 0), cB + kstep, voffB); PG8_STAGE(PG8_SA(1, 0), cA + kstep, voffA); PG8_STAGE(PG8_SB(1, 1), cB + hstep + kstep, voffB);
    PG8_WAIT_V(6); PG8_BAR;
    for (;;) {
        const bool has_next = S.next(ui + 1, nxt);
        const char* nA = has_next ? (const char*)g.A + (size_t)nxt.pm * tstep : cA; const char* nB = has_next ? (const char*)g.Bt + (size_t)nxt.pn * tstep : cB;
        for (int t = 0; t < nt; t += 2) {
            const bool last = (t == nt - 2);
            const char* a1 = cA + (size_t)(t + 1) * kstep;
            const char* a2 = last ? nA : cA + (size_t)(t + 2) * kstep; const char* b2 = last ? nB : cB + (size_t)(t + 2) * kstep;
            const char* a3 = a2 + kstep; const char* b3 = b2 + kstep;
            PG8_LDB(B0, 0, 0); PG8_SCHED; PG8_LDA(At, 0, 0); PG8_STAGE(PG8_SA(1, 1), a1 + hstep, voffA);
            PG8_WAIT_L(8); PG8_BAR; PG8_WAIT_L(0); PG8_MMA(0, 0, At, B0); PG8_BAR; PG8_SCHED;
            PG8_LDB(B1, 0, 1); PG8_STAGE(PG8_SB(0, 0), b2, voffB);
            PG8_BAR; PG8_WAIT_L(0); PG8_MMA(0, 1, At, B1); PG8_BAR;
            PG8_LDA(At, 0, 1); PG8_STAGE(PG8_SA(0, 0), a2, voffA);
            PG8_BAR; PG8_WAIT_L(0); PG8_MMA(1, 0, At, B0); PG8_BAR; PG8_SCHED;
            PG8_STAGE(PG8_SB(0, 1), b2 + hstep, voffB);
            PG8_WAIT_V(6); PG8_BAR; PG8_MMA(1, 1, At, B1); PG8_BAR;
            PG8_LDB(B0, 1, 0); PG8_SCHED; PG8_LDA(At, 1, 0); PG8_STAGE(PG8_SA(0, 1), a2 + hstep, voffA);
            PG8_WAIT_L(8); PG8_BAR; PG8_WAIT_L(0); PG8_MMA(0, 0, At, B0); PG8_BAR; PG8_SCHED;
            PG8_LDB(B1, 1, 1); PG8_STAGE(PG8_SB(1, 0), b3, voffB);
            PG8_BAR; PG8_WAIT_L(0); PG8_MMA(0, 1, At, B1); PG8_BAR;
            PG8_LDA(At, 1, 1); PG8_STAGE(PG8_SA(1, 0), a3, voffA);
            PG8_BAR; PG8_WAIT_L(0); PG8_MMA(1, 0, At, B0); PG8_BAR; PG8_SCHED;
            PG8_STAGE(PG8_SB(1, 1), b3 + hstep, voffB);
            PG8_WAIT_V(6); PG8_BAR; PG8_MMA(1, 1, At, B1); PG8_BAR;
        }
        E(acc, cur, wr, wc, fr, fq);
        if (!has_next) break;
#pragma unroll
        for (int a = 0; a < 2; ++a)
#pragma unroll
            for (int b = 0; b < 2; ++b)
#pragma unroll
                for (int m = 0; m < 4; ++m)
#pragma unroll
                    for (int n = 0; n < 2; ++n) acc[a][b][m][n] = (f32x4){0.f, 0.f, 0.f, 0.f};
        cur = nxt; cA = nA; cB = nB; ++ui;
    }
    PG8_WAIT_V(0);
    if (wr == 0) PG8_BAR;
    PG8_BAR;
#undef PG8_SA
#undef PG8_SB
#undef PG8_STAGE
#undef PG8_LDA
#undef PG8_LDB
#undef PG8_MMA
#undef PG8_WAIT_V
#undef PG8_WAIT_L
#undef PG8_BAR
#undef PG8_SCHED
}
}

enum { WM_ID = 0, WM_GU, WM_GIN, WM_LIM320, WM_LIM384 };
DI int wmap(int mode, int r) {
    switch (mode) {
        case WM_GU: { const int t = r >> 8, w = r & 255; return w < 128 ? t * 128 + w : DFF + t * 128 + (w - 128); }
        case WM_GIN: return r < 2048 ? r : (r < 3072 ? r + 16 : (r < 3088 ? r - 1024 : -1));
        case WM_LIM320: return r < 320 ? r : -1;
        case WM_LIM384: return r < 384 ? r : -1;
        default: return r;
    }
}
DI void convert_w(LAS unsigned char* lds, const float* __restrict__ src, int K, int N, bf16_t* __restrict__ dst, int Nd, int mode) {
    LAS float* tile = (LAS float*)lds;
    const int tid = lthread(), ntk = K >> 6, ntiles = (Nd >> 6) * ntk;
    for (int t = lblock(); t < ntiles; t += gridDim.x) {
        const int r0 = (t / ntk) << 6, k0 = (t % ntk) << 6;
        { const int j = tid & 63, i0 = tid >> 6; const int n = wmap(mode, r0 + j);
#pragma unroll
          for (int ii = 0; ii < 8; ++ii) { const int i = i0 + ii * 8; tile[i * 65 + j] = (n >= 0) ? src[(size_t)(k0 + i) * N + n] : 0.f; } }
        __syncthreads();
        { const int i = tid & 63, j0 = tid >> 6;
#pragma unroll
          for (int jj = 0; jj < 8; ++jj) { const int j = j0 + jj * 8; dst[(size_t)(r0 + j) * K + k0 + i] = f2bf(tile[i * 65 + j]); } }
        __syncthreads();
    }
}
DI void convert_ffn(LAS unsigned char* lds, const Prm& p, int l, int f) {
    const int idx = l * 2 + f;
    convert_w(lds, p.ffn_gu + (size_t)idx * 1024 * 5632, 1024, 5632, (bf16_t*)(p.ws + OFF_WGU), 5632, WM_GU);
    convert_w(lds, p.ffn_dn + (size_t)idx * 2816 * 1024, 2816, 1024, (bf16_t*)(p.ws + OFF_WDN), 1024, WM_ID);
}

DI void mods_phase(LAS unsigned char* lds, const Prm& p) {
    LAS float* cact = (LAS float*)lds;
    LAS float* red = (LAS float*)(lds + 32768);
    const int tid = lthread();
    for (int i = tid; i < 8192; i += NTHREADS) cact[i] = silu_f(p.c[i]);
    __syncthreads();
    float* mods = (float*)(p.ws + OFF_MODS); float* kvm = (float*)(p.ws + OFF_KVMODS);
    for (int item = lblock(); item < 320; item += gridDim.x) {
        const int col0 = item * 64;
        const float* W; int N, cc; const float* bias; float* out; int obs;
        if (col0 < 18432) { const int l = col0 / 9216; cc = col0 - l * 9216; W = p.cond_w + (size_t)l * 1024 * 9216; N = 9216; bias = p.cond_b + l * 9216; out = mods + (size_t)l * 8 * 9216; obs = 9216; }
        else { cc = col0 - 18432; W = p.kv_cond_w; N = 2048; bias = p.kv_cond_b; out = kvm; obs = 2048; }
        const int j = tid & 63, kg = tid >> 6;
        float a0 = 0.f, a1 = 0.f, a2 = 0.f, a3 = 0.f, a4 = 0.f, a5 = 0.f, a6 = 0.f, a7 = 0.f;
        const float* wp = W + (size_t)(kg * 128) * N + cc + j;
#pragma unroll 4
        for (int k = 0; k < 128; ++k) { const float w = wp[(size_t)k * N]; const int kk = kg * 128 + k;
            a0 += cact[kk] * w; a1 += cact[1024 + kk] * w; a2 += cact[2048 + kk] * w; a3 += cact[3072 + kk] * w;
            a4 += cact[4096 + kk] * w; a5 += cact[5120 + kk] * w; a6 += cact[6144 + kk] * w; a7 += cact[7168 + kk] * w; }
        red[(kg * 8 + 0) * 64 + j] = a0; red[(kg * 8 + 1) * 64 + j] = a1; red[(kg * 8 + 2) * 64 + j] = a2; red[(kg * 8 + 3) * 64 + j] = a3;
        red[(kg * 8 + 4) * 64 + j] = a4; red[(kg * 8 + 5) * 64 + j] = a5; red[(kg * 8 + 6) * 64 + j] = a6; red[(kg * 8 + 7) * 64 + j] = a7;
        __syncthreads();
        { const int b = tid >> 6; float s = bias[cc + j];
#pragma unroll
          for (int q = 0; q < 8; ++q) s += red[(q * 8 + b) * 64 + j];
          out[(size_t)b * obs + cc + j] = s; }
        __syncthreads();
    }
}
DI void rope_tables(const Prm& p) {
    float* COS = (float*)(p.ws + OFF_COS); float* SIN = (float*)(p.ws + OFF_SIN);
    const int gt = lblock() * NTHREADS + lthread(), nth = gridDim.x * NTHREADS;
    for (int idx = gt; idx < T * 32; idx += nth) {
        const int t = idx >> 5, i = idx & 31;
        const float inv = powf(10000.f, -(float)(2 * i) / 64.f);
        const float ang = (float)p.pos[t] * inv;
        COS[idx] = cosf(ang); SIN[idx] = sinf(ang);
    }
}

struct RowP {
    const float* xin; const float* y; float* xout; float rw; const float* gate; int gate_bs; const float* g_post;
    const float* g1; const float* sh1; const float* sc1; int bs1; bf16_t* h1;
    const float* g2; const float* sh2; const float* sc2; int bs2; bf16_t* h2;
};
DI void rowwise_phase(const RowP& a) {
    const int tidx_ = lthread(); const int lane = tidx_ & 63, gw = lblock() * 8 + (tidx_ >> 6), nw = gridDim.x * 8;
    for (int row = gw; row < T; row += nw) {
        const int b = row >> 12;
        f32x4 xv[4];
#pragma unroll
        for (int i = 0; i < 4; ++i) xv[i] = *(const f32x4*)(a.xin + (size_t)row * D + i * 256 + lane * 4);
        if (a.y) {
            f32x4 yv[4]; float ss = 0.f;
#pragma unroll
            for (int i = 0; i < 4; ++i) { yv[i] = *(const f32x4*)(a.y + (size_t)row * D + i * 256 + lane * 4);
                ss += yv[i][0] * yv[i][0] + yv[i][1] * yv[i][1] + yv[i][2] * yv[i][2] + yv[i][3] * yv[i][3]; }
            ss = wave_sum(ss);
            const float rstd = rsqrtf(ss * (1.f / D) + EPS) * a.rw;
#pragma unroll
            for (int i = 0; i < 4; ++i) { const int col = i * 256 + lane * 4;
                const f32x4 gt = *(const f32x4*)(a.gate + (size_t)b * a.gate_bs + col), gp = *(const f32x4*)(a.g_post + col);
                xv[i] = xv[i] + gt * (yv[i] * rstd) * gp;
                *(f32x4*)(a.xout + (size_t)row * D + col) = xv[i]; }
        }
        if (a.h1) {
            float ss = 0.f;
#pragma unroll
            for (int i = 0; i < 4; ++i) ss += xv[i][0] * xv[i][0] + xv[i][1] * xv[i][1] + xv[i][2] * xv[i][2] + xv[i][3] * xv[i][3];
            ss = wave_sum(ss);
            const float rstd = rsqrtf(ss * (1.f / D) + EPS);
#pragma unroll
            for (int i = 0; i < 4; ++i) { const int col = i * 256 + lane * 4;
                const f32x4 g = *(const f32x4*)(a.g1 + col), sc = *(const f32x4*)(a.sc1 + (size_t)b * a.bs1 + col), sh = *(const f32x4*)(a.sh1 + (size_t)b * a.bs1 + col);
                const f32x4 hv = (xv[i] * rstd) * g * (sc + 1.f) + sh;
                u32x2 pk; pk[0] = pk2(hv[0], hv[1]); pk[1] = pk2(hv[2], hv[3]);
                *(u32x2*)(a.h1 + (size_t)row * D + col) = pk; }
            if (a.h2) {
#pragma unroll
                for (int i = 0; i < 4; ++i) { const int col = i * 256 + lane * 4;
                    const f32x4 g = *(const f32x4*)(a.g2 + col), sc = *(const f32x4*)(a.sc2 + (size_t)b * a.bs2 + col), sh = *(const f32x4*)(a.sh2 + (size_t)b * a.bs2 + col);
                    const f32x4 hv = (xv[i] * rstd) * g * (sc + 1.f) + sh;
                    u32x2 pk; pk[0] = pk2(hv[0], hv[1]); pk[1] = pk2(hv[2], hv[3]);
                    *(u32x2*)(a.h2 + (size_t)row * D + col) = pk; }
            }
        }
    }
}

DI void ckv_phase(const Prm& p) {
    const float* raw = (const float*)(p.ws + OFF_Y); bf16_t* ckvn = (bf16_t*)(p.ws + OFF_CKVN); bf16_t* krope = (bf16_t*)(p.ws + OFF_KROPE);
    const float* COS = (const float*)(p.ws + OFF_COS); const float* SIN = (const float*)(p.ws + OFF_SIN);
    const int tidx_ = lthread(); const int lane = tidx_ & 63, gw = lblock() * 8 + (tidx_ >> 6), nw = gridDim.x * 8;
    for (int row = gw; row < T; row += nw) {
        const f32x4 v = *(const f32x4*)(raw + (size_t)row * 512 + lane * 4);
        float ss = wave_sum(v[0] * v[0] + v[1] * v[1] + v[2] * v[2] + v[3] * v[3]);
        const float rstd = rsqrtf(ss * (1.f / 256.f) + EPS);
        const f32x4 g = *(const f32x4*)(p.g_kv + lane * 4);
        u32x2 pk; pk[0] = pk2(v[0] * rstd * g[0], v[1] * rstd * g[1]); pk[1] = pk2(v[2] * rstd * g[2], v[3] * rstd * g[3]);
        *(u32x2*)(ckvn + (size_t)row * 256 + lane * 4) = pk;
        if (lane < 32) {
            const float x1 = raw[(size_t)row * 512 + 256 + lane], x2 = raw[(size_t)row * 512 + 288 + lane];
            const float c = COS[(size_t)row * 32 + lane], s = SIN[(size_t)row * 32 + lane];
            krope[(size_t)row * 64 + lane] = f2bf(x1 * c - x2 * s);
            krope[(size_t)row * 64 + 32 + lane] = f2bf(x1 * s + x2 * c);
        }
    }
}
DI void cq_phase(const Prm& p) {
    const float* raw = (const float*)(p.ws + OFF_Y); bf16_t* cqn = (bf16_t*)(p.ws + OFF_Y + (size_t)T * 512 * 4);
    const int tidx_ = lthread(); const int lane = tidx_ & 63, gw = lblock() * 8 + (tidx_ >> 6), nw = gridDim.x * 8;
    for (int row = gw; row < T; row += nw) {
        f32x2 v[3]; float ss = 0.f;
#pragma unroll
        for (int i = 0; i < 3; ++i) { v[i] = *(const f32x2*)(raw + (size_t)row * 512 + i * 128 + lane * 2); ss += v[i][0] * v[i][0] + v[i][1] * v[i][1]; }
        ss = wave_sum(ss);
        const float rstd = rsqrtf(ss * (1.f / 384.f) + EPS);
#pragma unroll
        for (int i = 0; i < 3; ++i) { const f32x2 g = *(const f32x2*)(p.g_q + i * 128 + lane * 2);
            *(unsigned*)(cqn + (size_t)row * 384 + i * 128 + lane * 2) = pk2(v[i][0] * rstd * g[0], v[i][1] * rstd * g[1]); }
    }
}
DI void gla_gate_phase(const Prm& p) {
    const float* og = (const float*)(p.ws + OFF_Y); const bf16_t* proj = (const bf16_t*)(p.ws + OFF_BIG); bf16_t* hout = (bf16_t*)(p.ws + OFF_H);
    const int tidx_ = lthread(); const int lane = tidx_ & 63, gw = lblock() * 8 + (tidx_ >> 6), nw = gridDim.x * 8;
    for (int row = gw; row < T; row += nw) {
        f32x4 v[4]; float ss = 0.f;
#pragma unroll
        for (int i = 0; i < 4; ++i) { v[i] = *(const f32x4*)(og + (size_t)row * D + lane * 16 + i * 4); ss += v[i][0] * v[i][0] + v[i][1] * v[i][1] + v[i][2] * v[i][2] + v[i][3] * v[i][3]; }
#pragma unroll
        for (int o = 8; o > 0; o >>= 1) ss += __shfl_xor(ss, o);
        const float rstd = rsqrtf(ss * (1.f / 256.f) + EPS);
        const u32x4 r0 = *(const u32x4*)(proj + (size_t)row * 3328 + 2048 + lane * 16), r1 = *(const u32x4*)(proj + (size_t)row * 3328 + 2048 + lane * 16 + 8);
        const int gc = (lane & 15) * 16;
        u32x4 o0, o1;
#pragma unroll
        for (int i = 0; i < 4; ++i) {
            const f32x4 g = *(const f32x4*)(p.gla_g_out + gc + i * 4);
            const unsigned ra = (i < 2) ? r0[2 * i] : r1[2 * (i - 2)], rb = (i < 2) ? r0[2 * i + 1] : r1[2 * (i - 2) + 1];
            const float e0 = v[i][0] * rstd * g[0] * silu_f(lo_f(ra)), e1 = v[i][1] * rstd * g[1] * silu_f(hi_f(ra));
            const float e2 = v[i][2] * rstd * g[2] * silu_f(lo_f(rb)), e3 = v[i][3] * rstd * g[3] * silu_f(hi_f(rb));
            if (i < 2) { o0[2 * i] = pk2(e0, e1); o0[2 * i + 1] = pk2(e2, e3); } else { o1[2 * (i - 2)] = pk2(e0, e1); o1[2 * (i - 2) + 1] = pk2(e2, e3); }
        }
        *(u32x4*)(hout + (size_t)row * D + lane * 16) = o0; *(u32x4*)(hout + (size_t)row * D + lane * 16 + 8) = o1;
    }
}

DI void gla_phase(LAS unsigned char* lds, const Prm& p) {
    const int tid = lthread(), wid = __builtin_amdgcn_readfirstlane(tid >> 6), lane = tid & 63, r = lane & 31, hf = lane >> 5;
    LAS float* GL = (LAS float*)(lds);
    LAS float* LA = (LAS float*)(lds + 4096);
    LAS float* SEG = (LAS float*)(lds + 36864);
    LAS float* BL = (LAS float*)(lds + 38912);
    LAS unsigned char* QD = lds + 39424;
    LAS unsigned char* KD = lds + 56832;
    LAS unsigned char* KUT = lds + 74240;
    LAS unsigned char* VTs = lds + 92672;
    LAS unsigned char* ATT = lds + 97280;
    LAS unsigned char* ST = lds + 106496;
    const bf16_t* proj = (const bf16_t*)(p.ws + OFF_BIG); const float* glow = (const float*)(p.ws + OFF_GLOW); float* og = (float*)(p.ws + OFF_Y);
    const float qscale = 0.08838834764831845f;
    for (int item = lblock(); item < 256; item += gridDim.x) {
        const int b = item >> 5, h = (item >> 3) & 3, sl = item & 7;
        const int seg = tid >> 7, c = tid & 127;
        float wg[16];
#pragma unroll
        for (int q = 0; q < 16; ++q) wg[q] = p.gla_w_gate_up[q * 512 + h * 128 + c];
        const float bg = p.gla_b_gate[h * 128 + c];
        for (int i = tid; i < 32 * 136 / 2; i += NTHREADS) ((LAS unsigned*)ST)[i] = 0u;
        f32x16 Sacc;
#pragma unroll
        for (int q = 0; q < 16; ++q) Sacc[q] = 0.f;
        __syncthreads();
        const size_t tok0 = (size_t)b * SEQ;
        u32x4 qraw[2], kraw[2], vraw; f32x4 glraw;
        const int qrow0 = tid >> 4, qc8 = tid & 15;
        const int vrow = tid >> 2, vc8 = tid & 3;
#define GLA_LOAD(n_) do { const size_t t0_ = tok0 + (size_t)(n_) * 64; \
        _Pragma("unroll") for (int it = 0; it < 2; ++it) { const bf16_t* rp = proj + (t0_ + qrow0 + 32 * it) * 3328 + h * 128 + qc8 * 8; qraw[it] = *(const u32x4*)rp; kraw[it] = *(const u32x4*)(rp + 512); } \
        if (tid < 256) { vraw = *(const u32x4*)(proj + (t0_ + vrow) * 3328 + 1024 + h * 256 + sl * 32 + vc8 * 8); glraw = *(const f32x4*)(glow + (t0_ + vrow) * 16 + vc8 * 4); } } while (0)
        GLA_LOAD(0);
        for (int n = 0; n < 64; ++n) {
            const size_t t0 = tok0 + (size_t)n * 64;
            if (tid < 256) *(LAS f32x4*)(GL + vrow * 16 + vc8 * 4) = glraw;
            __syncthreads();
            float bs[16]; float run = 0.f;
#pragma unroll
            for (int i = 0; i < 16; ++i) { const int row = seg * 16 + i; float z = bg;
                const f32x4 g0 = *(const LAS f32x4*)(GL + row * 16), g1 = *(const LAS f32x4*)(GL + row * 16 + 4), g2 = *(const LAS f32x4*)(GL + row * 16 + 8), g3 = *(const LAS f32x4*)(GL + row * 16 + 12);
                z += g0[0] * wg[0] + g0[1] * wg[1] + g0[2] * wg[2] + g0[3] * wg[3] + g1[0] * wg[4] + g1[1] * wg[5] + g1[2] * wg[6] + g1[3] * wg[7]
                   + g2[0] * wg[8] + g2[1] * wg[9] + g2[2] * wg[10] + g2[3] * wg[11] + g3[0] * wg[12] + g3[1] * wg[13] + g3[2] * wg[14] + g3[3] * wg[15];
                const float ls = fminf(z, 0.f) - log1pf(expf(-fabsf(z)));
                run += ls * 0.0625f; bs[i] = run; }
            SEG[seg * 128 + c] = run;
            __syncthreads();
            { float off = 0.f;
#pragma unroll
              for (int s = 0; s < 3; ++s) off += (s < seg) ? SEG[s * 128 + c] : 0.f;
#pragma unroll
              for (int i = 0; i < 16; ++i) LA[(seg * 16 + i) * 128 + c] = bs[i] + off;
              if (seg == 3) BL[c] = bs[15] + off; }
            __syncthreads();
#pragma unroll
            for (int it = 0; it < 2; ++it) { const int row = qrow0 + 32 * it;
                const f32x4 b0 = *(const LAS f32x4*)(LA + row * 128 + qc8 * 8), b1 = *(const LAS f32x4*)(LA + row * 128 + qc8 * 8 + 4);
                const f32x4 l0 = *(const LAS f32x4*)(BL + qc8 * 8), l1 = *(const LAS f32x4*)(BL + qc8 * 8 + 4);
                u32x4 qd, kd;
#pragma unroll
                for (int j2 = 0; j2 < 4; ++j2) {
                    const float ba = (j2 < 2) ? b0[2 * j2] : b1[2 * (j2 - 2)], bb = (j2 < 2) ? b0[2 * j2 + 1] : b1[2 * (j2 - 2) + 1];
                    const float la_ = (j2 < 2) ? l0[2 * j2] : l1[2 * (j2 - 2)], lb_ = (j2 < 2) ? l0[2 * j2 + 1] : l1[2 * (j2 - 2) + 1];
                    const float qa = lo_f(qraw[it][j2]), qb = hi_f(qraw[it][j2]), ka = lo_f(kraw[it][j2]), kb = hi_f(kraw[it][j2]);
                    qd[j2] = pk2(qa * qscale * __expf(ba), qb * qscale * __expf(bb));
                    kd[j2] = pk2(ka * __expf(-ba), kb * __expf(-bb));
                    *(LAS bf16_t*)(KUT + ((qc8 * 8 + 2 * j2) * 72 + row) * 2) = f2bf(ka * __expf(la_ - ba));
                    *(LAS bf16_t*)(KUT + ((qc8 * 8 + 2 * j2 + 1) * 72 + row) * 2) = f2bf(kb * __expf(lb_ - bb));
                }
                *(LAS u32x4*)(QD + (row * 136 + qc8 * 8) * 2) = qd; *(LAS u32x4*)(KD + (row * 136 + qc8 * 8) * 2) = kd; }
            if (tid < 256) {
#pragma unroll
                for (int j2 = 0; j2 < 4; ++j2) {
                    *(LAS bf16_t*)(VTs + ((vc8 * 8 + 2 * j2) * 72 + vrow) * 2) = (bf16_t)(vraw[j2] & 0xffffu);
                    *(LAS bf16_t*)(VTs + ((vc8 * 8 + 2 * j2 + 1) * 72 + vrow) * 2) = (bf16_t)(vraw[j2] >> 16); }
            }
            if (n < 63) GLA_LOAD(n + 1);
            __syncthreads();
            if (wid < 4) {
                const int ti = wid >> 1, tj = wid & 1;
                f32x16 acc;
#pragma unroll
                for (int q = 0; q < 16; ++q) acc[q] = 0.f;
                if (tj <= ti) {
#pragma unroll
                    for (int ks = 0; ks < 8; ++ks) {
                        const bf16x8 a = *(const LAS bf16x8*)(QD + ((32 * ti + r) * 136 + ks * 16 + 8 * hf) * 2);
                        const bf16x8 bb = *(const LAS bf16x8*)(KD + ((32 * tj + r) * 136 + ks * 16 + 8 * hf) * 2);
                        acc = MFMA32(a, bb, acc); }
                }
#pragma unroll
                for (int q = 0; q < 16; ++q) { const int i = 32 * ti + crow(q, hf), j = 32 * tj + r;
                    const float v = (j <= i) ? acc[q] : 0.f;
                    *(LAS bf16_t*)(ATT + (i * 72 + j) * 2) = f2bf(v); }
            } else {
                const int dt = wid - 4;
#pragma unroll
                for (int q = 0; q < 16; ++q) Sacc[q] *= __expf(BL[32 * dt + crow(q, hf)]);
#pragma unroll
                for (int ks = 0; ks < 4; ++ks) {
                    const bf16x8 a = *(const LAS bf16x8*)(KUT + ((32 * dt + r) * 72 + ks * 16 + 8 * hf) * 2);
                    const bf16x8 bb = *(const LAS bf16x8*)(VTs + (r * 72 + ks * 16 + 8 * hf) * 2);
                    Sacc = MFMA32(a, bb, Sacc); }
            }
            __syncthreads();
            if (wid < 2) {
                const int ti = wid;
                f32x16 acc;
#pragma unroll
                for (int q = 0; q < 16; ++q) acc[q] = 0.f;
#pragma unroll
                for (int ks = 0; ks < 4; ++ks) {
                    const bf16x8 a = *(const LAS bf16x8*)(ATT + ((32 * ti + r) * 72 + ks * 16 + 8 * hf) * 2);
                    const bf16x8 bb = *(const LAS bf16x8*)(VTs + (r * 72 + ks * 16 + 8 * hf) * 2);
                    acc = MFMA32(a, bb, acc); }
#pragma unroll
                for (int ks = 0; ks < 8; ++ks) {
                    const bf16x8 a = *(const LAS bf16x8*)(QD + ((32 * ti + r) * 136 + ks * 16 + 8 * hf) * 2);
                    const bf16x8 bb = *(const LAS bf16x8*)(ST + (r * 136 + ks * 16 + 8 * hf) * 2);
                    acc = MFMA32(a, bb, acc); }
#pragma unroll
                for (int q = 0; q < 16; ++q) og[(t0 + 32 * ti + crow(q, hf)) * D + h * 256 + sl * 32 + r] = acc[q];
            }
            __syncthreads();
            if (wid >= 4) {
                const int dt = wid - 4;
#pragma unroll
                for (int g = 0; g < 4; ++g) { u32x2 pk; pk[0] = pk2(Sacc[4 * g], Sacc[4 * g + 1]); pk[1] = pk2(Sacc[4 * g + 2], Sacc[4 * g + 3]);
                    *(LAS u32x2*)(ST + (r * 136 + 32 * dt + 8 * g + 4 * hf) * 2) = pk; }
            }
        }
#undef GLA_LOAD
        __syncthreads();
    }
}

DI void attn_phase(LAS unsigned char* lds, const Prm& p) {
    const int tid = lthread(), wid = __builtin_amdgcn_readfirstlane(tid >> 6), lane = tid & 63, r = lane & 31, hf = lane >> 5;
    constexpr int KT_STRIDE = 400, KT_BYTES = 64 * KT_STRIDE, VT_STRIDE = 144, VT_BYTES = 128 * VT_STRIDE;
    LAS unsigned char* KT = lds;
    LAS unsigned char* VT = lds + 2 * KT_BYTES;
    const bf16_t* Q = (const bf16_t*)(p.ws + OFF_BIG + (size_t)T * 2048 * 2); const bf16_t* KV = (const bf16_t*)(p.ws + OFF_BIG);
    const bf16_t* KR = (const bf16_t*)(p.ws + OFF_KROPE); bf16_t* AO = (bf16_t*)(p.ws + OFF_H);
    const float* COS = (const float*)(p.ws + OFF_COS); const float* SIN = (const float*)(p.ws + OFF_SIN);
    const float SC = 0.07216878364870322f * 1.4426950408889634f;
    for (int it = lblock(); it < 1024; it += gridDim.x) {
        const int pass = it >> 8, blk = it & 255, bh = blk & 63, g = blk >> 6;
        const int qt = (pass == 0) ? g : (pass == 1) ? 7 - g : (pass == 2) ? 8 + g : 15 - g;
        const int b = bh >> 3, h = bh & 7, q0 = qt * 256;
        const size_t tok0 = (size_t)b * SEQ;
        const int qpos = q0 + 32 * wid + r;
        const size_t qrow = tok0 + qpos;
        bf16x8 qf[12];
        { const bf16_t* qp = Q + qrow * 1536 + h * 192 + 8 * hf;
#pragma unroll
          for (int ks = 0; ks < 12; ++ks) qf[ks] = *(const bf16x8*)(qp + ks * 16);
#pragma unroll
          for (int pr = 0; pr < 2; ++pr) {
              const int i0 = 16 * pr + 8 * hf;
              const f32x4 c0 = *(const f32x4*)(COS + qrow * 32 + i0), c1 = *(const f32x4*)(COS + qrow * 32 + i0 + 4);
              const f32x4 s0 = *(const f32x4*)(SIN + qrow * 32 + i0), s1 = *(const f32x4*)(SIN + qrow * 32 + i0 + 4);
              bf16x8 x1v = qf[8 + pr], x2v = qf[10 + pr], o1, o2;
#pragma unroll
              for (int j = 0; j < 8; ++j) { const float cc = (j < 4) ? c0[j & 3] : c1[j & 3], ss = (j < 4) ? s0[j & 3] : s1[j & 3];
                  const float x1 = bf2f((unsigned short)x1v[j]), x2 = bf2f((unsigned short)x2v[j]);
                  o1[j] = (short)f2bf(x1 * cc - x2 * ss); o2[j] = (short)f2bf(x1 * ss + x2 * cc); }
              qf[8 + pr] = o1; qf[10 + pr] = o2; } }
        float m = -1e30f, l = 0.f;
        f32x16 O[4];
#pragma unroll
        for (int d = 0; d < 4; ++d)
#pragma unroll
            for (int q = 0; q < 16; ++q) O[d][q] = 0.f;
        const int nkt = 4 * (qt + 1);
        u32x4 kraw[3], vraw[2];
        const int kkey = tid >> 4, kc8 = tid & 15;
        const int rkey = tid >> 3, rc8 = tid & 7;
        const int vp = tid >> 4, vc8 = tid & 15;
        const int vrd0 = r * VT_STRIDE + 8 * ((hf) ^ (r >> 3)), vrd1 = r * VT_STRIDE + 8 * ((2 + hf) ^ (r >> 3));
const unsigned offk0 = (unsigned)(kkey * 2048 + kc8 * 8), offk1 = offk0 + 32u * 2048u, offr = (unsigned)(rkey * 64 + rc8 * 8);
        const unsigned offv0 = (unsigned)(2 * vp * 2048 + 128 + vc8 * 8), offv1 = offv0 + 2048u;
        const bf16_t* kvb0 = KV + tok0 * 2048 + h * 256; const bf16_t* krb0 = KR + tok0 * 64;
#define ATT_LOAD(kt_) do { const bf16_t* kvb_ = kvb0 + (size_t)(kt_) * 64 * 2048; const bf16_t* krb_ = krb0 + (size_t)(kt_) * 64 * 64; \
        kraw[0] = *(const u32x4*)(kvb_ + offk0); kraw[1] = *(const u32x4*)(kvb_ + offk1); \
        kraw[2] = *(const u32x4*)(krb_ + offr); \
        vraw[0] = *(const u32x4*)(kvb_ + offv0); vraw[1] = *(const u32x4*)(kvb_ + offv1); } while (0)
#define ATT_STORE(buf_) do { LAS unsigned char* kt_ = KT + (buf_) * KT_BYTES; LAS unsigned char* vt_ = VT + (buf_) * VT_BYTES; \
        *(LAS u32x4*)(kt_ + kkey * KT_STRIDE + kc8 * 16) = kraw[0]; *(LAS u32x4*)(kt_ + (kkey + 32) * KT_STRIDE + kc8 * 16) = kraw[1]; \
        *(LAS u32x4*)(kt_ + rkey * KT_STRIDE + 256 + rc8 * 16) = kraw[2]; \
        _Pragma("unroll") for (int j2 = 0; j2 < 4; ++j2) { \
            const unsigned lo_ = (vraw[0][j2] & 0xffffu) | (vraw[1][j2] << 16), hi_ = (vraw[0][j2] >> 16) | (vraw[1][j2] & 0xffff0000u); \
            *(LAS unsigned*)(vt_ + (vc8 * 8 + 2 * j2) * VT_STRIDE + 4 * (vp ^ (2 * vc8))) = lo_; \
            *(LAS unsigned*)(vt_ + (vc8 * 8 + 2 * j2 + 1) * VT_STRIDE + 4 * (vp ^ (2 * vc8))) = hi_; } } while (0)
        ATT_LOAD(0); ATT_STORE(0);
        __syncthreads();
        for (int kt = 0; kt < nkt; ++kt) {
            const int cur = kt & 1;
            const bool more = (kt + 1 < nkt);
            if (more) ATT_LOAD(kt + 1);
            const int kbase = kt * 64;
            if (kbase <= q0 + 32 * wid + 31) {
                const LAS unsigned char* ktb = KT + cur * KT_BYTES; const LAS unsigned char* vtb = VT + cur * VT_BYTES;
                f32x16 s0, s1;
#pragma unroll
                for (int q = 0; q < 16; ++q) { s0[q] = 0.f; s1[q] = 0.f; }
#pragma unroll
                for (int ks = 0; ks < 12; ++ks) {
                    const bf16x8 a0 = *(const LAS bf16x8*)(ktb + r * KT_STRIDE + ks * 32 + 16 * hf);
                    const bf16x8 a1 = *(const LAS bf16x8*)(ktb + (32 + r) * KT_STRIDE + ks * 32 + 16 * hf);
                    s0 = MFMA32(a0, qf[ks], s0); s1 = MFMA32(a1, qf[ks], s1);
                    }
                const bool diag = (kbase + 63 > q0 + 32 * wid);
                float mx = -1e30f;
#pragma unroll
                for (int q = 0; q < 16; ++q) {
                    float v0 = s0[q] * SC, v1 = s1[q] * SC;
                    if (diag) { const int key = kbase + crow(q, hf); if (key > qpos) v0 = -1e30f; if (key + 32 > qpos) v1 = -1e30f; }
                    s0[q] = v0; s1[q] = v1; mx = fmaxf(mx, fmaxf(v0, v1)); }
                mx = fmaxf(mx, __shfl_xor(mx, 32));
                const float mn = fmaxf(m, mx), alpha = __builtin_amdgcn_exp2f(m - mn);
                m = mn;
                float ls = 0.f;
#pragma unroll
                for (int q = 0; q < 16; ++q) { s0[q] = __builtin_amdgcn_exp2f(s0[q] - mn); s1[q] = __builtin_amdgcn_exp2f(s1[q] - mn); ls += s0[q] + s1[q]; }
                l = l * alpha + ls;
#pragma unroll
                for (int d = 0; d < 4; ++d)
#pragma unroll
                    for (int q = 0; q < 16; ++q) O[d][q] *= alpha;
                bf16x8 pb[2][2];
#pragma unroll
                for (int s = 0; s < 2; ++s) {
                    u32x4 t0, t1;
#pragma unroll
                    for (int j2 = 0; j2 < 4; ++j2) { t0[j2] = pk2(s0[8 * s + 2 * j2], s0[8 * s + 2 * j2 + 1]); t1[j2] = pk2(s1[8 * s + 2 * j2], s1[8 * s + 2 * j2 + 1]); }
                    pb[0][s] = __builtin_bit_cast(bf16x8, t0); pb[1][s] = __builtin_bit_cast(bf16x8, t1); }
#pragma unroll
                for (int d = 0; d < 4; ++d) {
#pragma unroll
                    for (int ksub = 0; ksub < 2; ++ksub)
#pragma unroll
                        for (int s = 0; s < 2; ++s) {
                            const int imm = d * 32 * VT_STRIDE + 32 * (((2 * ksub + s) ^ d) & 3);
                            const u32x2 lo = *(const LAS u32x2*)(vtb + vrd0 + imm);
                            const u32x2 hi = *(const LAS u32x2*)(vtb + vrd1 + imm);
                            u32x4 av; av[0] = lo[0]; av[1] = lo[1]; av[2] = hi[0]; av[3] = hi[1];
                            O[d] = MFMA32(__builtin_bit_cast(bf16x8, av), pb[ksub][s], O[d]); }
                }
            }
            if (more) ATT_STORE(cur ^ 1);
            __syncthreads();
        }
#undef ATT_LOAD
#undef ATT_STORE
        l += __shfl_xor(l, 32);
        const float inv = 1.f / l;
#pragma unroll
        for (int d = 0; d < 4; ++d)
#pragma unroll
            for (int g4 = 0; g4 < 4; ++g4) { u32x2 pk; pk[0] = pk2(O[d][4 * g4] * inv, O[d][4 * g4 + 1] * inv); pk[1] = pk2(O[d][4 * g4 + 2] * inv, O[d][4 * g4 + 3] * inv);
                *(u32x2*)(AO + qrow * D + h * 128 + 32 * d + 8 * g4 + 4 * hf) = pk; }
    }
}


#define XB_TMO      128
#define XB_XCNT(j)  (256  + 64 * (j))
#define XB_XSUB(j)  (1280 + 64 * (j))
#define XB_XGEN(j)  (2304 + 64 * (j))
#define XB_TOP      3328
#define XB_TOPGEN   3392
#define XCD_BAR_WORDS 3456
#define XB_SPIN_CAP (1u << 22)
DI unsigned xb_ld(unsigned* p)              { return __hip_atomic_load(p, __ATOMIC_RELAXED, __HIP_MEMORY_SCOPE_AGENT); }
DI unsigned xb_add(unsigned* p, unsigned v) { return __hip_atomic_fetch_add(p, v, __ATOMIC_RELAXED, __HIP_MEMORY_SCOPE_AGENT); }
DI unsigned xb_xcc_id() { return (unsigned)__builtin_amdgcn_s_getreg((3 << 11) | 20) & 0xFu; }
#define XB_SPIN(cond, bar) do { unsigned _sp = 0; while (cond) { __builtin_amdgcn_s_sleep(1); \
    if ((++_sp & 255u) == 0u) { if (xb_ld(&(bar)[XB_TMO])) break; if (_sp > XB_SPIN_CAP) { atomicAdd(&(bar)[XB_TMO], 1u); break; } } } } while (0)
struct XcdBarrier { unsigned* bar; unsigned x; volatile LAS unsigned* st; };
DI XcdBarrier xcd_barrier_post(unsigned* bar, volatile LAS unsigned* st) {
    XcdBarrier b; b.bar = bar; b.x = xb_xcc_id(); b.st = st;
    if (threadIdx.x == 0) (void)xb_add(&bar[XB_XCNT(b.x)], 1u);
    return b;
}
DI void xcd_barrier_complete(unsigned* bar, unsigned x, unsigned& nloc, unsigned& nx) {
    const unsigned G = gridDim.x * gridDim.y * gridDim.z;
    unsigned sum, cnt, mine, sp = 0u;
    for (;;) {
        sum = 0u; cnt = 0u; mine = 0u;
#pragma unroll
        for (unsigned j = 0; j < 16; ++j) { const unsigned c = xb_ld(&bar[XB_XCNT(j)]); sum += c; cnt += (c > 0u) ? 1u : 0u; mine = (j == x) ? c : mine; }
        if (sum == G) break;
        __builtin_amdgcn_s_sleep(1);
        if ((++sp & 255u) == 0u) { if (xb_ld(&bar[XB_TMO])) break; if (sp > XB_SPIN_CAP) { atomicAdd(&bar[XB_TMO], 1u); break; } }
    }
    nloc = mine > 0u ? mine : 1u; nx = cnt > 0u ? cnt : 1u;
}
DI void xcd_barrier(const XcdBarrier& b) {
    asm volatile("s_waitcnt vmcnt(0)" ::: "memory");
    __syncthreads();
    if (threadIdx.x == 0) {
        unsigned* bar = b.bar;
        __builtin_amdgcn_s_waitcnt(0);
        unsigned nloc = b.st[0], nx = b.st[1];
        if (nloc == 0u) { xcd_barrier_complete(bar, b.x, nloc, nx); b.st[0] = nloc; b.st[1] = nx; }
        const unsigned old = xb_add(&bar[XB_XSUB(b.x)], 1u);
        const unsigned gen = old / nloc;
        if (old + 1u == (gen + 1u) * nloc) {
            __builtin_amdgcn_fence(__ATOMIC_RELEASE, "agent");
            asm volatile("s_waitcnt vmcnt(0)" ::: "memory");
            const unsigned og = xb_add(&bar[XB_TOP], 1u);
            const unsigned tg = og / nx;
            if (og + 1u == (tg + 1u) * nx) xb_add(&bar[XB_TOPGEN], 1u);
            else XB_SPIN(xb_ld(&bar[XB_TOPGEN]) == tg, bar);
            __builtin_amdgcn_fence(__ATOMIC_ACQUIRE, "agent");
            xb_add(&bar[XB_XGEN(b.x)], 1u);
            asm volatile("s_waitcnt vmcnt(0)" ::: "memory");
        } else {
            XB_SPIN(xb_ld(&bar[XB_XGEN(b.x)]) == gen, bar);
            __builtin_amdgcn_fence(__ATOMIC_ACQUIRE, "agent");
            asm volatile("s_waitcnt vmcnt(0)" ::: "memory");
        }
    }
    __syncthreads();
}

__global__ void __launch_bounds__(NTHREADS) fwd_megakernel(Prm p) {
    extern __shared__ __attribute__((aligned(16))) unsigned char lds_raw[];
    LAS unsigned char* lds = (LAS unsigned char*)lds_raw;
    cg::grid_group grid = cg::this_grid();
    if (threadIdx.x < 4) ((LAS unsigned*)(lds + 131072))[threadIdx.x] = 0u;
    __syncthreads();
    XcdBarrier xbar = xcd_barrier_post((unsigned*)(p.ws + OFF_BAR), (volatile LAS unsigned*)(lds + 131072));
    unsigned char* ws = p.ws;
    float* mods = (float*)(ws + OFF_MODS); float* kvm = (float*)(ws + OFF_KVMODS);
    bf16_t* H = (bf16_t*)(ws + OFF_H); float* Y = (float*)(ws + OFF_Y); bf16_t* BIG = (bf16_t*)(ws + OFF_BIG);
    const int G = gridDim.x, cblk = lblock();
#pragma unroll 1
    for (int ph = p.ph_lo; ph < p.ph_hi; ++ph) {
#if DUP_MASK
      const int nrep = ((DUP_MASK >> ph) & 1u) ? 2 : 1;
#pragma unroll 1
      for (int rep = 0; rep < nrep; ++rep)
#endif
        switch (ph) {
        case 0: {
            mods_phase(lds, p);
            rope_tables(p);
            convert_w(lds, p.gla_w_in, 1024, 3088, (bf16_t*)(ws + OFF_WGIN), 3328, WM_GIN);
            convert_w(lds, p.gla_w_out, 1024, 1024, (bf16_t*)(ws + OFF_WGOUT), 1024, WM_ID);
            convert_w(lds, p.w_kv_a, 1024, 320, (bf16_t*)(ws + OFF_WKVA), 512, WM_LIM320);
            convert_w(lds, p.w_kv_b, 256, 2048, (bf16_t*)(ws + OFF_WKVB), 2048, WM_ID);
            convert_w(lds, p.w_dq, 1024, 384, (bf16_t*)(ws + OFF_WDQ), 512, WM_LIM384);
            convert_w(lds, p.w_uq, 384, 1536, (bf16_t*)(ws + OFF_WUQ), 1536, WM_ID);
            convert_w(lds, p.w_mout, 1024, 1024, (bf16_t*)(ws + OFF_WMOUT), 1024, WM_ID);
            convert_ffn(lds, p, 0, 0);
        } break;
        case 1: case 4: case 9: case 12: case 17: case 23: case 26: {
            const int ps = (ph == 1) ? -1 : (ph == 4) ? 0 : (ph == 9) ? 1 : (ph == 12) ? 2 : (ph == 17) ? 3 : (ph == 23) ? 4 : 5;
            RowP a;
            a.xin = (ph <= 4) ? p.x : p.out; a.y = nullptr; a.xout = p.out; a.rw = 0.f; a.gate = nullptr; a.gate_bs = 9216; a.g_post = nullptr;
            a.g1 = nullptr; a.sh1 = nullptr; a.sc1 = nullptr; a.bs1 = 9216; a.h1 = nullptr; a.g2 = nullptr; a.sh2 = nullptr; a.sc2 = nullptr; a.bs2 = 2048; a.h2 = nullptr;
            if (ps >= 0) { const int l = ps / 3, s = ps % 3; a.y = Y; a.rw = (s == 1) ? 1.f : 0.5f;
                a.gate = mods + (size_t)l * 8 * 9216 + (3 * s + 2) * 1024; a.g_post = p.norm_g + ((l * 3 + s) * 2 + 1) * 1024; }
            const int pre = ps + 1;
            if (pre < 6) { const int l = pre / 3, s = pre % 3; a.h1 = H; a.g1 = p.norm_g + ((l * 3 + s) * 2) * 1024;
                a.sh1 = mods + (size_t)l * 8 * 9216 + (3 * s) * 1024; a.sc1 = mods + (size_t)l * 8 * 9216 + (3 * s + 1) * 1024; }
            if (ph == 12) { a.h2 = BIG; a.g2 = p.kv_g_in; a.sh2 = kvm; a.sc2 = kvm + 1024; }
            rowwise_phase(a);
            if (ph == 4) convert_ffn(lds, p, 0, 1);
            if (ph == 12) convert_ffn(lds, p, 1, 0);
            if (ph == 17) convert_ffn(lds, p, 1, 1);
        } break;
        case 2: case 10: case 15: case 24: {
            pg8::Gemm g{H, (const bf16_t*)(ws + OFF_WGU), T, 5632, 1024}; pg8::StaticOrder S; S.init(T, 5632, G, cblk);
            pg8::EpiSwiglu E{BIG};
            pg8::gemm_phase<pg8::EpiSwiglu>(lds, g, S, E);
        } break;
        case 3: case 11: case 16: case 25: case 8: case 22: case 13: {
            pg8::Gemm g; pg8::EpiF32 E;
            if (ph == 8) { g = pg8::Gemm{H, (const bf16_t*)(ws + OFF_WGOUT), T, 1024, 1024}; E = pg8::EpiF32{Y, 1024}; }
            else if (ph == 22) { g = pg8::Gemm{H, (const bf16_t*)(ws + OFF_WMOUT), T, 1024, 1024}; E = pg8::EpiF32{Y, 1024}; }
            else if (ph == 13) { g = pg8::Gemm{BIG, (const bf16_t*)(ws + OFF_WKVA), T, 512, 1024}; E = pg8::EpiF32{Y, 512}; }
            else { g = pg8::Gemm{BIG, (const bf16_t*)(ws + OFF_WDN), T, 1024, 2816}; E = pg8::EpiF32{Y, 1024}; }
            pg8::StaticOrder S; S.init(T, g.N, G, cblk);
            pg8::gemm_phase<pg8::EpiF32>(lds, g, S, E);
        } break;
        case 5: case 20: {
            pg8::Gemm g; pg8::EpiBf16 E;
            if (ph == 5) { g = pg8::Gemm{H, (const bf16_t*)(ws + OFF_WGIN), T, 3328, 1024}; E = pg8::EpiBf16{BIG, 3328, (float*)(ws + OFF_GLOW), 12}; }
            else { g = pg8::Gemm{(const bf16_t*)(ws + OFF_Y + (size_t)T * 512 * 4), (const bf16_t*)(ws + OFF_WUQ), T, 1536, 384}; E = pg8::EpiBf16{(bf16_t*)(ws + OFF_BIG + (size_t)T * 2048 * 2), 1536, nullptr, -1}; }
            pg8::StaticOrder S; S.init(T, g.N, G, cblk);
            pg8::gemm_phase<pg8::EpiBf16>(lds, g, S, E);
        } break;
        case 6: gla_phase(lds, p); break;
        case 7: gla_gate_phase(p); break;
        case 14: ckv_phase(p); break;
        case 18: {
            { pg8::Gemm g{H, (const bf16_t*)(ws + OFF_WDQ), T, 512, 1024}; pg8::EpiF32 E{Y, 512}; pg8::StaticOrder S; S.init(T, 512, G, cblk);
              pg8::gemm_phase<pg8::EpiF32>(lds, g, S, E); }
            { pg8::Gemm g{(const bf16_t*)(ws + OFF_CKVN), (const bf16_t*)(ws + OFF_WKVB), T, 2048, 256}; pg8::EpiBf16 E{BIG, 2048, nullptr, -1}; pg8::StaticOrder S; S.init(T, 2048, G, cblk);
              pg8::gemm_phase<pg8::EpiBf16>(lds, g, S, E); }
        } break;
        case 19: cq_phase(p); break;
        case 21: attn_phase(lds, p); break;
        default: break;
        }
        if (ph + 1 < p.ph_hi) { if (p.ph_hi > NPH) grid.sync(); else xcd_barrier(xbar); }
    }
}

extern "C" void kernel_launch(void* const* d_in, const int* in_sizes, int n_in, void* d_out, int out_size, void* d_ws, size_t ws_size, hipStream_t stream) {
    static int grid_blocks = 0;
    if (grid_blocks == 0) {
        if (n_in != 23 || ws_size < WS_END) { fprintf(stderr, "kernel_launch: unexpected n_in %d / ws %zu (need %zu)\n", n_in, ws_size, (size_t)WS_END); grid_blocks = -1; return; }
        int dev = 0, cus = 0, per_cu = 0;
        (void)hipGetDevice(&dev);
        (void)hipDeviceGetAttribute(&cus, hipDeviceAttributeMultiprocessorCount, dev);
        if (hipFuncSetAttribute((const void*)fwd_megakernel, hipFuncAttributeMaxDynamicSharedMemorySize, LDS_BYTES) != hipSuccess) { fprintf(stderr, "kernel_launch: hipFuncSetAttribute failed\n"); grid_blocks = -1; return; }
        if (hipOccupancyMaxActiveBlocksPerMultiprocessor(&per_cu, (const void*)fwd_megakernel, NTHREADS, LDS_BYTES) != hipSuccess || per_cu < 1) { fprintf(stderr, "kernel_launch: occupancy query says %d\n", per_cu); per_cu = 1; }
        (void)hipGetLastError();
        grid_blocks = cus * 1;
        fprintf(stderr, "kernel_launch: cus %d per_cu %d grid %d\n", cus, per_cu, grid_blocks);
    }
    if (grid_blocks < 0) return;
    Prm p{};
    p.x = (const float*)d_in[0]; p.c = (const float*)d_in[1]; p.pos = (const int*)d_in[2]; p.cond_w = (const float*)d_in[3]; p.cond_b = (const float*)d_in[4];
    p.norm_g = (const float*)d_in[5]; p.ffn_gu = (const float*)d_in[6]; p.ffn_dn = (const float*)d_in[7]; p.gla_w_in = (const float*)d_in[8];
    p.gla_w_gate_up = (const float*)d_in[9]; p.gla_b_gate = (const float*)d_in[10]; p.gla_g_out = (const float*)d_in[11]; p.gla_w_out = (const float*)d_in[12];
    p.kv_g_in = (const float*)d_in[13]; p.kv_cond_w = (const float*)d_in[14]; p.kv_cond_b = (const float*)d_in[15]; p.w_kv_a = (const float*)d_in[16];
    p.g_kv = (const float*)d_in[17]; p.w_kv_b = (const float*)d_in[18]; p.w_dq = (const float*)d_in[19]; p.g_q = (const float*)d_in[20];
    p.w_uq = (const float*)d_in[21]; p.w_mout = (const float*)d_in[22];
    p.out = (float*)d_out; p.ws = (unsigned char*)d_ws;
    (void)hipMemsetAsync((unsigned char*)d_ws + OFF_BAR, 0, 16384, stream);
#if MULTI_LAUNCH
    for (int ph = 0; ph < NPH; ++ph) {
        p.ph_lo = ph; p.ph_hi = ph + 1;
        hipLaunchKernelGGL(fwd_megakernel, dim3(grid_blocks), dim3(NTHREADS), LDS_BYTES, stream, p);
    }
#else
    p.ph_lo = 0; p.ph_hi = NPH;
    void* args[] = {&p};
    hipError_t e = hipLaunchCooperativeKernel((const void*)fwd_megakernel, dim3(grid_blocks), dim3(NTHREADS), args, LDS_BYTES, stream);
    if (e != hipSuccess) fprintf(stderr, "cooperative launch failed: %s (grid %d)\n", hipGetErrorString(e), grid_blocks);
#endif
}
```

```cpp
#include <hip/hip_runtime.h>
#include <hip/hip_cooperative_groups.h>
#include <cstdio>
namespace cg = cooperative_groups;

#define LAS __attribute__((address_space(3)))
#define DI __device__ __forceinline__
typedef unsigned short bf16_t;
typedef short bf16x8 __attribute__((ext_vector_type(8)));
typedef float f32x2 __attribute__((ext_vector_type(2)));
typedef float f32x4 __attribute__((ext_vector_type(4)));
typedef float f32x16 __attribute__((ext_vector_type(16)));
typedef unsigned u32x2 __attribute__((ext_vector_type(2)));
typedef unsigned u32x4 __attribute__((ext_vector_type(4)));
typedef __bf16 bf16v2 __attribute__((ext_vector_type(2)));

#ifndef MULTI_LAUNCH
#define MULTI_LAUNCH 0
#endif
#ifndef DUP_MASK
#define DUP_MASK 0u
#endif

constexpr int T = 32768, D = 1024, SEQ = 4096, NB = 8, DFF = 2816;
constexpr int NTHREADS = 512;
constexpr int LDS_BYTES = 131072 + 16;
constexpr float EPS = 1e-6f;
enum { PH_PRO = 0, PH_ROW0, PH_A_G1, PH_A_G2, PH_ROW1, PH_GIN, PH_GLA_CHUNK, PH_GLA_SCAN, PH_GLA_GATE, PH_GOUT, PH_ROW2, PH_B_G1, PH_B_G2, PH_ROW3,
       PH_KVA, PH_CKV, PH_C_G1, PH_C_G2, PH_ROW4, PH_DQ_KVB, PH_CQ, PH_UQ, PH_ATTN, PH_MOUT, PH_ROW5, PH_D_G1, PH_D_G2, PH_ROW6, NPH };

constexpr size_t SZ_WGU = (size_t)5632 * 1024 * 2, SZ_WDN = (size_t)1024 * 2816 * 2, SZ_WGIN = (size_t)3328 * 1024 * 2;
constexpr size_t OFF_BAR = 0;
constexpr size_t OFF_WGU = 16384;
constexpr size_t OFF_WDN = OFF_WGU + SZ_WGU;
constexpr size_t OFF_WGIN = OFF_WDN + SZ_WDN;
constexpr size_t OFF_WGOUT = OFF_WGIN + SZ_WGIN;
constexpr size_t OFF_WKVA = OFF_WGOUT + (size_t)1024 * 1024 * 2;
constexpr size_t OFF_WKVB = OFF_WKVA + (size_t)512 * 1024 * 2;
constexpr size_t OFF_WDQ = OFF_WKVB + (size_t)2048 * 256 * 2;
constexpr size_t OFF_WUQ = OFF_WDQ + (size_t)512 * 1024 * 2;
constexpr size_t OFF_WMOUT = OFF_WUQ + (size_t)1536 * 384 * 2;
constexpr size_t OFF_MODS = OFF_WMOUT + (size_t)1024 * 1024 * 2;
constexpr size_t OFF_KVMODS = OFF_MODS + (size_t)2 * 8 * 9216 * 4;
constexpr size_t OFF_COS = OFF_KVMODS + (size_t)8 * 2048 * 4;
constexpr size_t OFF_SIN = OFF_COS + (size_t)T * 32 * 4;
constexpr size_t OFF_GLOW = OFF_SIN + (size_t)T * 32 * 4;
constexpr size_t OFF_CKVN = OFF_GLOW + (size_t)T * 16 * 4;
constexpr size_t OFF_KROPE = OFF_CKVN + (size_t)T * 256 * 2;
constexpr size_t OFF_H = OFF_KROPE + (size_t)T * 64 * 2;
constexpr size_t OFF_Y = OFF_H + (size_t)T * 1024 * 2;
constexpr size_t OFF_BIG = OFF_Y + (size_t)T * 1024 * 4;
constexpr size_t SZ_BIG = (size_t)T * 2048 * 2 + (size_t)T * 1536 * 2;
constexpr size_t OFF_VTA = OFF_BIG + (size_t)T * 3328 * 2;
constexpr size_t OFF_DEC = OFF_VTA + (size_t)1536 * 32768;
constexpr size_t WS_END = (OFF_DEC + (size_t)2048 * 512 > OFF_BIG + SZ_BIG) ? OFF_DEC + (size_t)2048 * 512 : OFF_BIG + SZ_BIG;
static_assert(WS_END <= (size_t)536870912, "workspace");
static_assert(SZ_BIG >= (size_t)T * 3328 * 2 && SZ_BIG >= (size_t)T * 2816 * 2, "big");

struct Prm {
    const float* x; const float* c; const int* pos; const float* cond_w; const float* cond_b; const float* norm_g;
    const float* ffn_gu; const float* ffn_dn; const float* gla_w_in; const float* gla_w_gate_up; const float* gla_b_gate;
    const float* gla_g_out; const float* gla_w_out; const float* kv_g_in; const float* kv_cond_w; const float* kv_cond_b;
    const float* w_kv_a; const float* g_kv; const float* w_kv_b; const float* w_dq; const float* g_q; const float* w_uq; const float* w_mout;
    float* out; unsigned char* ws; int ph_lo, ph_hi;
};

DI float bf2f(unsigned short b) { return __uint_as_float(((unsigned)b) << 16); }
DI unsigned pk2(float lo, float hi) { f32x2 v = {lo, hi}; bf16v2 b = __builtin_convertvector(v, bf16v2); return __builtin_bit_cast(unsigned, b); }
DI bf16_t f2bf(float f) { return (bf16_t)(pk2(f, 0.f) & 0xffffu); }
DI float lo_f(unsigned u) { return __uint_as_float(u << 16); }
DI float hi_f(unsigned u) { return __uint_as_float(u & 0xffff0000u); }
DI float wave_sum(float v) {
#pragma unroll
    for (int o = 32; o > 0; o >>= 1) v += __shfl_xor(v, o);
    return v;
}
DI float silu_f(float v) { return v / (1.f + __expf(-v)); }
DI int crow(int reg, int hf) { return (reg & 3) + 8 * (reg >> 2) + 4 * hf; }
DI int lthread() { int t = threadIdx.x; asm volatile("" : "+v"(t)); return t; }
DI int lblock() { int t = blockIdx.x; asm volatile("" : "+s"(t)); return t; }
#define MFMA32(a, b, c) __builtin_amdgcn_mfma_f32_32x32x16_bf16((a), (b), (c), 0, 0, 0)

namespace pg8 {
constexpr int BM = 256, BK = 64, HALF = 128, HTB = HALF * BK * 2, STAGE_BYTES = 8 * HTB, NXCD = 8, WGM = 8;
DI int lds_byte(int r, int c) { const int st = (r >> 4) * 2 + (c >> 5), rr = r & 15, cc = c & 31, ob = rr * 64 + cc * 2; return st * 1024 + (ob ^ (((ob >> 9) & 1) << 5)); }
DI void stage_rc(int b, int& R, int& C) { const int st = b / 1024, sb = b % 1024, swz = sb ^ (((sb >> 9) & 1) << 5); R = (st >> 1) * 16 + swz / 64; C = (st & 1) * 32 + (swz % 64) / 2; }
DI int perm32(int rho) { const int n = rho >> 4, i = rho & 15; return 8 * (i >> 2) + 4 * n + (i & 3); }

struct Unit { int pm, pn; };
struct Gemm { const bf16_t* A; const bf16_t* Bt; int M, N, K; };

struct StaticOrder {
    int nM, nN, nwg, G, c;
    DI void init(int M, int N, int G_, int c_) { nM = M / BM; nN = N / BM; nwg = nM * nN; G = G_; c = c_; }
    DI bool next(int i, Unit& u) const {
        const long L = (long)i * G + c; if (L >= nwg) return false;
        int wgid = (int)L; { const int q = nwg / NXCD, r = nwg % NXCD, xcd = wgid % NXCD, off = wgid / NXCD; wgid = (xcd < r ? xcd * (q + 1) : r * (q + 1) + (xcd - r) * q) + off; }
        const int nig = WGM * nN, gid = wgid / nig, fm = gid * WGM, gsz = (nM - fm) < WGM ? (nM - fm) : WGM;
        u.pm = fm + ((wgid % nig) % gsz); u.pn = (wgid % nig) / gsz; return true;
    }
};

struct EpiF32 {
    static constexpr bool PERM = false;
    float* C; int ldc;
    DI void operator()(const f32x4 (&acc)[2][2][4][2], const Unit& u, int wr, int wc, int fr, int fq) const {
        const int row0 = u.pm * BM + wr * 64 + fr, col0 = u.pn * BM + wc * 32 + 4 * fq;
#pragma unroll
        for (int ai = 0; ai < 2; ++ai)
#pragma unroll
            for (int m = 0; m < 4; ++m) { float* rowp = C + (size_t)(row0 + ai * HALF + m * 16) * ldc + col0;
#pragma unroll
                for (int bj = 0; bj < 2; ++bj)
#pragma unroll
                    for (int n = 0; n < 2; ++n) *(f32x4*)(rowp + bj * HALF + n * 16) = acc[ai][bj][m][n]; }
    }
};
struct EpiBf16 {
    static constexpr bool PERM = true;
    bf16_t* O; int ldc; float* glow; int glow_pn;
    DI void operator()(const f32x4 (&acc)[2][2][4][2], const Unit& u, int wr, int wc, int fr, int fq) const {
        const int row0 = u.pm * BM + wr * 64 + fr, col0 = u.pn * BM + wc * 32 + 8 * fq;
        const bool gl = (glow != nullptr) && (u.pn == glow_pn) && (wc == 0) && (fq < 2);
#pragma unroll
        for (int ai = 0; ai < 2; ++ai)
#pragma unroll
            for (int m = 0; m < 4; ++m) { const int row = row0 + ai * HALF + m * 16; bf16_t* rowp = O + (size_t)row * ldc + col0;
#pragma unroll
                for (int bj = 0; bj < 2; ++bj) { const f32x4 v0 = acc[ai][bj][m][0], v1 = acc[ai][bj][m][1];
                    u32x4 pk; pk[0] = pk2(v0[0], v0[1]); pk[1] = pk2(v0[2], v0[3]); pk[2] = pk2(v1[0], v1[1]); pk[3] = pk2(v1[2], v1[3]);
                    *(u32x4*)(rowp + bj * HALF) = pk;
                    if (bj == 0 && gl) { *(f32x4*)(glow + (size_t)row * 16 + 8 * fq) = v0; *(f32x4*)(glow + (size_t)row * 16 + 8 * fq + 4) = v1; } } }
    }
};
struct EpiSwiglu {
    static constexpr bool PERM = true;
    bf16_t* O;
    DI void operator()(const f32x4 (&acc)[2][2][4][2], const Unit& u, int wr, int wc, int fr, int fq) const {
        const int row0 = u.pm * BM + wr * 64 + fr, col0 = u.pn * HALF + wc * 32 + 8 * fq;
#pragma unroll
        for (int ai = 0; ai < 2; ++ai)
#pragma unroll
            for (int m = 0; m < 4; ++m) { bf16_t* rowp = O + (size_t)(row0 + ai * HALF + m * 16) * DFF + col0;
                const f32x4 g0 = acc[ai][0][m][0], g1 = acc[ai][0][m][1], u0 = acc[ai][1][m][0], u1 = acc[ai][1][m][1];
                u32x4 pk;
                pk[0] = pk2(silu_f(g0[0]) * u0[0], silu_f(g0[1]) * u0[1]); pk[1] = pk2(silu_f(g0[2]) * u0[2], silu_f(g0[3]) * u0[3]);
                pk[2] = pk2(silu_f(g1[0]) * u1[0], silu_f(g1[1]) * u1[1]); pk[3] = pk2(silu_f(g1[2]) * u1[2], silu_f(g1[3]) * u1[3]);
                *(u32x4*)rowp = pk; }
    }
};

template <class Epi>
DI void gemm_phase(LAS unsigned char* lds, const Gemm g, const StaticOrder& S, const Epi& E) {
    const int tid = lthread(), wid = __builtin_amdgcn_readfirstlane(tid >> 6), lane = tid & 63, wr = wid >> 2, wc = wid & 3, fr = lane & 15, fq = lane >> 4;
    const int K = g.K, nt = K / BK;
    unsigned voffA[2], voffB[2];
#pragma unroll
    for (int i = 0; i < 2; ++i) { int R, C; stage_rc(tid * 16 + i * 8192, R, C); const int Rb = Epi::PERM ? ((R & ~31) + perm32(R & 31)) : R;
        voffA[i] = (unsigned)(R * K + C) * 2u; voffB[i] = (unsigned)(Rb * K + C) * 2u; }
    const size_t kstep = (size_t)(BK * 2);
    const size_t hstep = (size_t)HALF * K * 2;
    const size_t tstep = 2 * hstep;
    const unsigned ldsw = (unsigned)wid * 1024u;
    const int aoff = lds_byte(wr * 64 + fr, fq * 8), boff = lds_byte(wc * 32 + fr, fq * 8);
#define PG8_SA(b, h) (((b) * 2 + (h)) * HTB)
#define PG8_SB(b, h) ((4 + (b) * 2 + (h)) * HTB)
#define PG8_STAGE(bufoff, gbase, voff) do { _Pragma("unroll") for (int _i = 0; _i < 2; ++_i) \
        __builtin_amdgcn_global_load_lds((const unsigned*)((const char*)(gbase) + (voff)[_i]), (LAS unsigned*)(lds + (bufoff) + ldsw + _i * 8192), 16, 0, 0); } while (0)
#define PG8_LDA(dst, b, h) do { _Pragma("unroll") for (int m = 0; m < 4; ++m) _Pragma("unroll") for (int k = 0; k < 2; ++k) dst[m][k] = *(const LAS bf16x8*)(lds + PG8_SA(b, h) + aoff + m * 2048 + k * 1024); } while (0)
#define PG8_LDB(dst, b, h) do { _Pragma("unroll") for (int n = 0; n < 2; ++n) _Pragma("unroll") for (int k = 0; k < 2; ++k) dst[n][k] = *(const LAS bf16x8*)(lds + PG8_SB(b, h) + boff + n * 2048 + k * 1024); } while (0)
#define PG8_MMA(ai, bj, At, Bt) do { __builtin_amdgcn_s_setprio(1); _Pragma("unroll") for (int m = 0; m < 4; ++m) _Pragma("unroll") for (int n = 0; n < 2; ++n) _Pragma("unroll") for (int k = 0; k < 2; ++k) \
        acc[ai][bj][m][n] = __builtin_amdgcn_mfma_f32_16x16x32_bf16(Bt[n][k], At[m][k], acc[ai][bj][m][n], 0, 0, 0); __builtin_amdgcn_s_setprio(0); } while (0)
#define PG8_WAIT_V(n) asm volatile("s_waitcnt vmcnt(" #n ")" ::: "memory")
#define PG8_WAIT_L(n) asm volatile("s_waitcnt lgkmcnt(" #n ")" ::: "memory")
#define PG8_BAR __builtin_amdgcn_s_barrier()
#define PG8_SCHED __builtin_amdgcn_sched_barrier(0)
    Unit cur, nxt; int ui = 0;
    if (!S.next(0, cur)) return;
    f32x4 acc[2][2][4][2];
#pragma unroll
    for (int a = 0; a < 2; ++a)
#pragma unroll
        for (int b = 0; b < 2; ++b)
#pragma unroll
            for (int m = 0; m < 4; ++m)
#pragma unroll
                for (int n = 0; n < 2; ++n) acc[a][b][m][n] = (f32x4){0.f, 0.f, 0.f, 0.f};
    bf16x8 At[4][2], B0[2][2], B1[2][2];
    const char* cA = (const char*)g.A + (size_t)cur.pm * tstep; const char* cB = (const char*)g.Bt + (size_t)cur.pn * tstep;
    PG8_STAGE(PG8_SB(0, 0), cB, voffB); PG8_STAGE(PG8_SA(0, 0), cA, voffA); PG8_STAGE(PG8_SB(0, 1), cB + hstep, voffB); PG8_STAGE(PG8_SA(0, 1), cA + hstep, voffA);
    if (wr == 1) PG8_BAR;
    PG8_WAIT_V(4); PG8_BAR;
    PG8_STAGE(PG8_SB(1, 0), cB + kstep, voffB); PG8_STAGE(PG8_SA(1, 0), cA + kstep, voffA); PG8_STAGE(PG8_SB(1, 1), cB + hstep + kstep, voffB);
    PG8_WAIT_V(6); PG8_BAR;
    for (;;) {
        const bool has_next = S.next(ui + 1, nxt);
        const char* nA = has_next ? (const char*)g.A + (size_t)nxt.pm * tstep : cA; const char* nB = has_next ? (const char*)g.Bt + (size_t)nxt.pn * tstep : cB;
        for (int t = 0; t < nt; t += 2) {
            const bool last = (t == nt - 2);
            const char* a1 = cA + (size_t)(t + 1) * kstep;
            const char* a2 = last ? nA : cA + (size_t)(t + 2) * kstep; const char* b2 = last ? nB : cB + (size_t)(t + 2) * kstep;
            const char* a3 = a2 + kstep; const char* b3 = b2 + kstep;
            PG8_LDB(B0, 0, 0); PG8_SCHED; PG8_LDA(At, 0, 0); PG8_STAGE(PG8_SA(1, 1), a1 + hstep, voffA);
            PG8_WAIT_L(8); PG8_BAR; PG8_WAIT_L(0); PG8_MMA(0, 0, At, B0); PG8_BAR; PG8_SCHED;
            PG8_LDB(B1, 0, 1); PG8_STAGE(PG8_SB(0, 0), b2, voffB);
            PG8_BAR; PG8_WAIT_L(0); PG8_MMA(0, 1, At, B1); PG8_BAR;
            PG8_LDA(At, 0, 1); PG8_STAGE(PG8_SA(0, 0), a2, voffA);
            PG8_BAR; PG8_WAIT_L(0); PG8_MMA(1, 0, At, B0); PG8_BAR; PG8_SCHED;
            PG8_STAGE(PG8_SB(0, 1), b2 + hstep, voffB);
            PG8_WAIT_V(6); PG8_BAR; PG8_MMA(1, 1, At, B1); PG8_BAR;
            PG8_LDB(B0, 1, 0); PG8_SCHED; PG8_LDA(At, 1, 0); PG8_STAGE(PG8_SA(0, 1), a2 + hstep, voffA);
            PG8_WAIT_L(8); PG8_BAR; PG8_WAIT_L(0); PG8_MMA(0, 0, At, B0); PG8_BAR; PG8_SCHED;
            PG8_LDB(B1, 1, 1); PG8_STAGE(PG8_SB(1, 0), b3, voffB);
            PG8_BAR; PG8_WAIT_L(0); PG8_MMA(0, 1, At, B1); PG8_BAR;
            PG8_LDA(At, 1, 1); PG8_STAGE(PG8_SA(1, 0), a3, voffA);
            PG8_BAR; PG8_WAIT_L(0); PG8_MMA(1, 0, At, B0); PG8_BAR; PG8_SCHED;
            PG8_STAGE(PG8_SB(1, 1), b3 + hstep, voffB);
            PG8_WAIT_V(6); PG8_BAR; PG8_MMA(1, 1, At, B1); PG8_BAR;
        }
        E(acc, cur, wr, wc, fr, fq);
        if (!has_next) break;
#pragma unroll
        for (int a = 0; a < 2; ++a)
#pragma unroll
            for (int b = 0; b < 2; ++b)
#pragma unroll
                for (int m = 0; m < 4; ++m)
#pragma unroll
                    for (int n = 0; n < 2; ++n) acc[a][b][m][n] = (f32x4){0.f, 0.f, 0.f, 0.f};
        cur = nxt; cA = nA; cB = nB; ++ui;
    }
    PG8_WAIT_V(0);
    if (wr == 0) PG8_BAR;
    PG8_BAR;
#undef PG8_SA
#undef PG8_SB
#undef PG8_STAGE
#undef PG8_LDA
#undef PG8_LDB
#undef PG8_MMA
#undef PG8_WAIT_V
#undef PG8_WAIT_L
#undef PG8_BAR
#undef PG8_SCHED
}
}

enum { WM_ID = 0, WM_GU, WM_GIN, WM_LIM320, WM_LIM384 };
DI int wmap(int mode, int r) {
    switch (mode) {
        case WM_GU: { const int t = r >> 8, w = r & 255; return w < 128 ? t * 128 + w : DFF + t * 128 + (w - 128); }
        case WM_GIN: return r < 2048 ? r : (r < 3072 ? r + 16 : (r < 3088 ? r - 1024 : -1));
        case WM_LIM320: return r < 320 ? r : -1;
        case WM_LIM384: return r < 384 ? r : -1;
        default: return r;
    }
}
DI void convert_w(LAS unsigned char* lds, const float* __restrict__ src, int K, int N, bf16_t* __restrict__ dst, int Nd, int mode) {
    LAS float* tile = (LAS float*)lds;
    const int tid = lthread(), ntk = K >> 6, ntiles = (Nd >> 6) * ntk;
    for (int t = lblock(); t < ntiles; t += gridDim.x) {
        const int r0 = (t / ntk) << 6, k0 = (t % ntk) << 6;
        { const int j = tid & 63, i0 = tid >> 6; const int n = wmap(mode, r0 + j);
#pragma unroll
          for (int ii = 0; ii < 8; ++ii) { const int i = i0 + ii * 8; tile[i * 65 + j] = (n >= 0) ? src[(size_t)(k0 + i) * N + n] : 0.f; } }
        __syncthreads();
        { const int i = tid & 63, j0 = tid >> 6;
#pragma unroll
          for (int jj = 0; jj < 8; ++jj) { const int j = j0 + jj * 8; dst[(size_t)(r0 + j) * K + k0 + i] = f2bf(tile[i * 65 + j]); } }
        __syncthreads();
    }
}
DI void convert_ffn(LAS unsigned char* lds, const Prm& p, int l, int f) {
    const int idx = l * 2 + f;
    convert_w(lds, p.ffn_gu + (size_t)idx * 1024 * 5632, 1024, 5632, (bf16_t*)(p.ws + OFF_WGU), 5632, WM_GU);
    convert_w(lds, p.ffn_dn + (size_t)idx * 2816 * 1024, 2816, 1024, (bf16_t*)(p.ws + OFF_WDN), 1024, WM_ID);
}

DI void mods_phase(LAS unsigned char* lds, const Prm& p) {
    LAS float* cact = (LAS float*)lds;
    LAS float* red = (LAS float*)(lds + 32768);
    const int tid = lthread();
    for (int i = tid; i < 8192; i += NTHREADS) cact[i] = silu_f(p.c[i]);
    __syncthreads();
    float* mods = (float*)(p.ws + OFF_MODS); float* kvm = (float*)(p.ws + OFF_KVMODS);
    for (int item = lblock(); item < 320; item += gridDim.x) {
        const int col0 = item * 64;
        const float* W; int N, cc; const float* bias; float* out; int obs;
        if (col0 < 18432) { const int l = col0 / 9216; cc = col0 - l * 9216; W = p.cond_w + (size_t)l * 1024 * 9216; N = 9216; bias = p.cond_b + l * 9216; out = mods + (size_t)l * 8 * 9216; obs = 9216; }
        else { cc = col0 - 18432; W = p.kv_cond_w; N = 2048; bias = p.kv_cond_b; out = kvm; obs = 2048; }
        const int j = tid & 63, kg = tid >> 6;
        float a0 = 0.f, a1 = 0.f, a2 = 0.f, a3 = 0.f, a4 = 0.f, a5 = 0.f, a6 = 0.f, a7 = 0.f;
        const float* wp = W + (size_t)(kg * 128) * N + cc + j;
#pragma unroll 4
        for (int k = 0; k < 128; ++k) { const float w = wp[(size_t)k * N]; const int kk = kg * 128 + k;
            a0 += cact[kk] * w; a1 += cact[1024 + kk] * w; a2 += cact[2048 + kk] * w; a3 += cact[3072 + kk] * w;
            a4 += cact[4096 + kk] * w; a5 += cact[5120 + kk] * w; a6 += cact[6144 + kk] * w; a7 += cact[7168 + kk] * w; }
        red[(kg * 8 + 0) * 64 + j] = a0; red[(kg * 8 + 1) * 64 + j] = a1; red[(kg * 8 + 2) * 64 + j] = a2; red[(kg * 8 + 3) * 64 + j] = a3;
        red[(kg * 8 + 4) * 64 + j] = a4; red[(kg * 8 + 5) * 64 + j] = a5; red[(kg * 8 + 6) * 64 + j] = a6; red[(kg * 8 + 7) * 64 + j] = a7;
        __syncthreads();
        { const int b = tid >> 6; float s = bias[cc + j];
#pragma unroll
          for (int q = 0; q < 8; ++q) s += red[(q * 8 + b) * 64 + j];
          out[(size_t)b * obs + cc + j] = s; }
        __syncthreads();
    }
}
DI void rope_tables(const Prm& p) {
    float* COS = (float*)(p.ws + OFF_COS); float* SIN = (float*)(p.ws + OFF_SIN);
    const int gt = lblock() * NTHREADS + lthread(), nth = gridDim.x * NTHREADS;
    for (int idx = gt; idx < T * 32; idx += nth) {
        const int t = idx >> 5, i = idx & 31;
        const float inv = powf(10000.f, -(float)(2 * i) / 64.f);
        const float ang = (float)p.pos[t] * inv;
        COS[idx] = cosf(ang); SIN[idx] = sinf(ang);
    }
}

struct RowP {
    const float* xin; const float* y; float* xout; float rw; const float* gate; int gate_bs; const float* g_post;
    const float* g1; const float* sh1; const float* sc1; int bs1; bf16_t* h1;
    const float* g2; const float* sh2; const float* sc2; int bs2; bf16_t* h2;
};
DI void rowwise_phase(const RowP& a) {
    const int tidx_ = lthread(); const int lane = tidx_ & 63, gw = lblock() * 8 + (tidx_ >> 6), nw = gridDim.x * 8;
    for (int row = gw; row < T; row += nw) {
        const int b = row >> 12;
        f32x4 xv[4];
#pragma unroll
        for (int i = 0; i < 4; ++i) xv[i] = *(const f32x4*)(a.xin + (size_t)row * D + i * 256 + lane * 4);
        if (a.y) {
            f32x4 yv[4]; float ss = 0.f;
#pragma unroll
            for (int i = 0; i < 4; ++i) { yv[i] = *(const f32x4*)(a.y + (size_t)row * D + i * 256 + lane * 4);
                ss += yv[i][0] * yv[i][0] + yv[i][1] * yv[i][1] + yv[i][2] * yv[i][2] + yv[i][3] * yv[i][3]; }
            ss = wave_sum(ss);
            const float rstd = rsqrtf(ss * (1.f / D) + EPS) * a.rw;
#pragma unroll
            for (int i = 0; i < 4; ++i) { const int col = i * 256 + lane * 4;
                const f32x4 gt = *(const f32x4*)(a.gate + (size_t)b * a.gate_bs + col), gp = *(const f32x4*)(a.g_post + col);
                xv[i] = xv[i] + gt * (yv[i] * rstd) * gp;
                *(f32x4*)(a.xout + (size_t)row * D + col) = xv[i]; }
        }
        if (a.h1) {
            float ss = 0.f;
#pragma unroll
            for (int i = 0; i < 4; ++i) ss += xv[i][0] * xv[i][0] + xv[i][1] * xv[i][1] + xv[i][2] * xv[i][2] + xv[i][3] * xv[i][3];
            ss = wave_sum(ss);
            const float rstd = rsqrtf(ss * (1.f / D) + EPS);
#pragma unroll
            for (int i = 0; i < 4; ++i) { const int col = i * 256 + lane * 4;
                const f32x4 g = *(const f32x4*)(a.g1 + col), sc = *(const f32x4*)(a.sc1 + (size_t)b * a.bs1 + col), sh = *(const f32x4*)(a.sh1 + (size_t)b * a.bs1 + col);
                const f32x4 hv = (xv[i] * rstd) * g * (sc + 1.f) + sh;
                u32x2 pk; pk[0] = pk2(hv[0], hv[1]); pk[1] = pk2(hv[2], hv[3]);
                *(u32x2*)(a.h1 + (size_t)row * D + col) = pk; }
            if (a.h2) {
#pragma unroll
                for (int i = 0; i < 4; ++i) { const int col = i * 256 + lane * 4;
                    const f32x4 g = *(const f32x4*)(a.g2 + col), sc = *(const f32x4*)(a.sc2 + (size_t)b * a.bs2 + col), sh = *(const f32x4*)(a.sh2 + (size_t)b * a.bs2 + col);
                    const f32x4 hv = (xv[i] * rstd) * g * (sc + 1.f) + sh;
                    u32x2 pk; pk[0] = pk2(hv[0], hv[1]); pk[1] = pk2(hv[2], hv[3]);
                    *(u32x2*)(a.h2 + (size_t)row * D + col) = pk; }
            }
        }
    }
}

DI void ckv_phase(const Prm& p) {
    const float* raw = (const float*)(p.ws + OFF_Y); bf16_t* ckvn = (bf16_t*)(p.ws + OFF_CKVN); bf16_t* krope = (bf16_t*)(p.ws + OFF_KROPE);
    const float* COS = (const float*)(p.ws + OFF_COS); const float* SIN = (const float*)(p.ws + OFF_SIN);
    const int tidx_ = lthread(); const int lane = tidx_ & 63, gw = lblock() * 8 + (tidx_ >> 6), nw = gridDim.x * 8;
    for (int row = gw; row < T; row += nw) {
        const f32x4 v = *(const f32x4*)(raw + (size_t)row * 512 + lane * 4);
        float ss = wave_sum(v[0] * v[0] + v[1] * v[1] + v[2] * v[2] + v[3] * v[3]);
        const float rstd = rsqrtf(ss * (1.f / 256.f) + EPS);
        const f32x4 g = *(const f32x4*)(p.g_kv + lane * 4);
        u32x2 pk; pk[0] = pk2(v[0] * rstd * g[0], v[1] * rstd * g[1]); pk[1] = pk2(v[2] * rstd * g[2], v[3] * rstd * g[3]);
        *(u32x2*)(ckvn + (size_t)row * 256 + lane * 4) = pk;
        if (lane < 32) {
            const float x1 = raw[(size_t)row * 512 + 256 + lane], x2 = raw[(size_t)row * 512 + 288 + lane];
            const float c = COS[(size_t)row * 32 + lane], s = SIN[(size_t)row * 32 + lane];
            krope[(size_t)row * 64 + lane] = f2bf(x1 * c - x2 * s);
            krope[(size_t)row * 64 + 32 + lane] = f2bf(x1 * s + x2 * c);
        }
    }
}
DI void cq_phase(const Prm& p) {
    const float* raw = (const float*)(p.ws + OFF_Y); bf16_t* cqn = (bf16_t*)(p.ws + OFF_Y + (size_t)T * 512 * 4);
    const int tidx_ = lthread(); const int lane = tidx_ & 63, gw = lblock() * 8 + (tidx_ >> 6), nw = gridDim.x * 8;
    for (int row = gw; row < T; row += nw) {
        f32x2 v[3]; float ss = 0.f;
#pragma unroll
        for (int i = 0; i < 3; ++i) { v[i] = *(const f32x2*)(raw + (size_t)row * 512 + i * 128 + lane * 2); ss += v[i][0] * v[i][0] + v[i][1] * v[i][1]; }
        ss = wave_sum(ss);
        const float rstd = rsqrtf(ss * (1.f / 384.f) + EPS);
#pragma unroll
        for (int i = 0; i < 3; ++i) { const f32x2 g = *(const f32x2*)(p.g_q + i * 128 + lane * 2);
            *(unsigned*)(cqn + (size_t)row * 384 + i * 128 + lane * 2) = pk2(v[i][0] * rstd * g[0], v[i][1] * rstd * g[1]); }
    }
}
DI void gla_gate_phase(const Prm& p) {
    const float* og = (const float*)(p.ws + OFF_Y); const bf16_t* proj = (const bf16_t*)(p.ws + OFF_BIG); bf16_t* hout = (bf16_t*)(p.ws + OFF_H);
    const float* oint = (const float*)(p.ws + OFF_BIG);
    const int tidx_ = lthread(); const int lane = tidx_ & 63, gw = lblock() * 8 + (tidx_ >> 6), nw = gridDim.x * 8;
    for (int row = gw; row < T; row += nw) {
        f32x4 v[4]; float ss = 0.f;
#pragma unroll
        for (int i = 0; i < 4; ++i) { v[i] = *(const f32x4*)(og + (size_t)row * D + lane * 16 + i * 4) + *(const f32x4*)(oint + (size_t)row * 1664 + lane * 16 + i * 4);
            ss += v[i][0] * v[i][0] + v[i][1] * v[i][1] + v[i][2] * v[i][2] + v[i][3] * v[i][3]; }
#pragma unroll
        for (int o = 8; o > 0; o >>= 1) ss += __shfl_xor(ss, o);
        const float rstd = rsqrtf(ss * (1.f / 256.f) + EPS);
        const u32x4 r0 = *(const u32x4*)(proj + (size_t)row * 3328 + 2048 + lane * 16), r1 = *(const u32x4*)(proj + (size_t)row * 3328 + 2048 + lane * 16 + 8);
        const int gc = (lane & 15) * 16;
        u32x4 o0, o1;
#pragma unroll
        for (int i = 0; i < 4; ++i) {
            const f32x4 g = *(const f32x4*)(p.gla_g_out + gc + i * 4);
            const unsigned ra = (i < 2) ? r0[2 * i] : r1[2 * (i - 2)], rb = (i < 2) ? r0[2 * i + 1] : r1[2 * (i - 2) + 1];
            const float e0 = v[i][0] * rstd * g[0] * silu_f(lo_f(ra)), e1 = v[i][1] * rstd * g[1] * silu_f(hi_f(ra));
            const float e2 = v[i][2] * rstd * g[2] * silu_f(lo_f(rb)), e3 = v[i][3] * rstd * g[3] * silu_f(hi_f(rb));
            if (i < 2) { o0[2 * i] = pk2(e0, e1); o0[2 * i + 1] = pk2(e2, e3); } else { o1[2 * (i - 2)] = pk2(e0, e1); o1[2 * (i - 2) + 1] = pk2(e2, e3); }
        }
        *(u32x4*)(hout + (size_t)row * D + lane * 16) = o0; *(u32x4*)(hout + (size_t)row * D + lane * 16 + 8) = o1;
    }
}

DI bf16_t* gla_vt_ptr(unsigned char* ws, int ci) { return (bf16_t*)(ci < 1536 ? ws + OFF_VTA + (size_t)ci * 32768 : ws + OFF_CKVN + (size_t)(ci - 1536) * 32768); }
DI void gla_chunk_phase(LAS unsigned char* lds, const Prm& p) {
    const int tid = lthread(), wid = __builtin_amdgcn_readfirstlane(tid >> 6), lane = tid & 63, r = lane & 31, hf = lane >> 5;
    LAS float* GL = (LAS float*)(lds);
    LAS float* LA = (LAS float*)(lds + 4096);
    LAS unsigned char* ATT = lds + 4096;
    LAS float* SEG = (LAS float*)(lds + 36864);
    LAS float* BL = (LAS float*)(lds + 38912);
    LAS unsigned char* QD = lds + 39424;
    LAS unsigned char* KD = lds + 56832;
    LAS unsigned char* KUT = lds + 74240;
    LAS unsigned char* VTs = lds + 92672;
    const bf16_t* proj = (const bf16_t*)(p.ws + OFF_BIG); const float* glow = (const float*)(p.ws + OFF_GLOW); float* og = (float*)(p.ws + OFF_Y);
    bf16_t* QDg = (bf16_t*)(p.ws + OFF_H); bf16_t* KUTg = (bf16_t*)(p.ws + OFF_H + (size_t)2048 * 16384); float* DECg = (float*)(p.ws + OFF_DEC);
    const float qscale = 0.08838834764831845f;
    const int seg = tid >> 7, c = tid & 127;
    const int kp = tid >> 4, kc8 = tid & 15;
    const int vpp = tid >> 5, vc8 = tid & 31;
    const int grow = tid >> 2, gc4 = tid & 3;
    for (int ci = lblock(); ci < 2048; ci += gridDim.x) {
        const int b = ci >> 8, h = (ci >> 6) & 3, n = ci & 63;
        const size_t t0 = (size_t)b * SEQ + (size_t)n * 64;
        float wg[16];
#pragma unroll
        for (int q = 0; q < 16; ++q) wg[q] = p.gla_w_gate_up[q * 512 + h * 128 + c];
        const float bg = p.gla_b_gate[h * 128 + c];
        u32x4 qraw[2], kraw[2], vraw[4]; f32x4 glraw = {0.f, 0.f, 0.f, 0.f};
#pragma unroll
        for (int i = 0; i < 2; ++i) { const bf16_t* rp = proj + (t0 + 2 * kp + i) * 3328 + h * 128 + kc8 * 8; qraw[i] = *(const u32x4*)rp; kraw[i] = *(const u32x4*)(rp + 512); }
#pragma unroll
        for (int i = 0; i < 4; ++i) vraw[i] = *(const u32x4*)(proj + (t0 + 2 * vpp + (i & 1) + 32 * (i >> 1)) * 3328 + 1024 + h * 256 + vc8 * 8);
        if (tid < 256) glraw = *(const f32x4*)(glow + (t0 + grow) * 16 + gc4 * 4);
        if (tid < 256) *(LAS f32x4*)(GL + grow * 16 + gc4 * 4) = glraw;
        __syncthreads();
        float bs[16]; float run = 0.f;
#pragma unroll
        for (int i = 0; i < 16; ++i) { const int row = seg * 16 + i; float z = bg;
            const f32x4 g0 = *(const LAS f32x4*)(GL + row * 16), g1 = *(const LAS f32x4*)(GL + row * 16 + 4), g2 = *(const LAS f32x4*)(GL + row * 16 + 8), g3 = *(const LAS f32x4*)(GL + row * 16 + 12);
            z += g0[0] * wg[0] + g0[1] * wg[1] + g0[2] * wg[2] + g0[3] * wg[3] + g1[0] * wg[4] + g1[1] * wg[5] + g1[2] * wg[6] + g1[3] * wg[7]
               + g2[0] * wg[8] + g2[1] * wg[9] + g2[2] * wg[10] + g2[3] * wg[11] + g3[0] * wg[12] + g3[1] * wg[13] + g3[2] * wg[14] + g3[3] * wg[15];
            const float ls = fminf(z, 0.f) - __logf(1.f + __expf(-fabsf(z)));
            run += ls * 0.0625f; bs[i] = run; }
        SEG[seg * 128 + c] = run;
        __syncthreads();
        { float off = 0.f;
#pragma unroll
          for (int s = 0; s < 3; ++s) off += (s < seg) ? SEG[s * 128 + c] : 0.f;
#pragma unroll
          for (int i = 0; i < 16; ++i) LA[(seg * 16 + i) * 128 + c] = bs[i] + off;
          if (seg == 3) BL[c] = bs[15] + off; }
        __syncthreads();
        {
            const f32x4 l0 = *(const LAS f32x4*)(BL + kc8 * 8), l1 = *(const LAS f32x4*)(BL + kc8 * 8 + 4);
            f32x4 ba0 = *(const LAS f32x4*)(LA + (2 * kp) * 128 + kc8 * 8), ba1 = *(const LAS f32x4*)(LA + (2 * kp) * 128 + kc8 * 8 + 4);
            f32x4 bb0 = *(const LAS f32x4*)(LA + (2 * kp + 1) * 128 + kc8 * 8), bb1 = *(const LAS f32x4*)(LA + (2 * kp + 1) * 128 + kc8 * 8 + 4);
            u32x4 qd0, kd0, qd1, kd1;
            const int kcol = (kp ^ ((kc8 & 7) << 2)) * 4;
#pragma unroll
            for (int j2 = 0; j2 < 4; ++j2) {
                const float bl_a = (j2 < 2) ? l0[2 * j2] : l1[2 * (j2 - 2)], bl_b = (j2 < 2) ? l0[2 * j2 + 1] : l1[2 * (j2 - 2) + 1];
                const float a_a = (j2 < 2) ? ba0[2 * j2] : ba1[2 * (j2 - 2)], a_b = (j2 < 2) ? ba0[2 * j2 + 1] : ba1[2 * (j2 - 2) + 1];
                const float b_a = (j2 < 2) ? bb0[2 * j2] : bb1[2 * (j2 - 2)], b_b = (j2 < 2) ? bb0[2 * j2 + 1] : bb1[2 * (j2 - 2) + 1];
                const float q0a = lo_f(qraw[0][j2]), q0b = hi_f(qraw[0][j2]), k0a = lo_f(kraw[0][j2]), k0b = hi_f(kraw[0][j2]);
                const float q1a = lo_f(qraw[1][j2]), q1b = hi_f(qraw[1][j2]), k1a = lo_f(kraw[1][j2]), k1b = hi_f(kraw[1][j2]);
                qd0[j2] = pk2(q0a * qscale * __expf(a_a), q0b * qscale * __expf(a_b)); kd0[j2] = pk2(k0a * __expf(-a_a), k0b * __expf(-a_b));
                qd1[j2] = pk2(q1a * qscale * __expf(b_a), q1b * qscale * __expf(b_b)); kd1[j2] = pk2(k1a * __expf(-b_a), k1b * __expf(-b_b));
                *(LAS unsigned*)(KUT + (kc8 * 8 + 2 * j2) * 144 + kcol) = pk2(k0a * __expf(bl_a - a_a), k1a * __expf(bl_a - b_a));
                *(LAS unsigned*)(KUT + (kc8 * 8 + 2 * j2 + 1) * 144 + kcol) = pk2(k0b * __expf(bl_b - a_b), k1b * __expf(bl_b - b_b));
            }
            *(LAS u32x4*)(QD + ((2 * kp) * 136 + kc8 * 8) * 2) = qd0; *(LAS u32x4*)(KD + ((2 * kp) * 136 + kc8 * 8) * 2) = kd0;
            *(LAS u32x4*)(QD + ((2 * kp + 1) * 136 + kc8 * 8) * 2) = qd1; *(LAS u32x4*)(KD + ((2 * kp + 1) * 136 + kc8 * 8) * 2) = kd1;
        }
        {
            const int vcol0 = (vpp ^ ((vc8 & 7) << 2)) * 4, vcol1 = ((vpp + 16) ^ ((vc8 & 7) << 2)) * 4;
#pragma unroll
            for (int j2 = 0; j2 < 4; ++j2) {
                *(LAS unsigned*)(VTs + (vc8 * 8 + 2 * j2) * 144 + vcol0) = (vraw[0][j2] & 0xffffu) | (vraw[1][j2] << 16);
                *(LAS unsigned*)(VTs + (vc8 * 8 + 2 * j2 + 1) * 144 + vcol0) = (vraw[0][j2] >> 16) | (vraw[1][j2] & 0xffff0000u);
                *(LAS unsigned*)(VTs + (vc8 * 8 + 2 * j2) * 144 + vcol1) = (vraw[2][j2] & 0xffffu) | (vraw[3][j2] << 16);
                *(LAS unsigned*)(VTs + (vc8 * 8 + 2 * j2 + 1) * 144 + vcol1) = (vraw[2][j2] >> 16) | (vraw[3][j2] & 0xffff0000u); }
        }
        __syncthreads();
        if (wid < 4) {
            const int ti = wid >> 1, tj = wid & 1;
            f32x16 acc;
#pragma unroll
            for (int q = 0; q < 16; ++q) acc[q] = 0.f;
            if (tj <= ti) {
#pragma unroll
                for (int ks = 0; ks < 8; ++ks) {
                    const bf16x8 a = *(const LAS bf16x8*)(QD + ((32 * ti + r) * 136 + ks * 16 + 8 * hf) * 2);
                    const bf16x8 bb = *(const LAS bf16x8*)(KD + ((32 * tj + r) * 136 + ks * 16 + 8 * hf) * 2);
                    acc = MFMA32(a, bb, acc); }
            }
#pragma unroll
            for (int q = 0; q < 16; ++q) { const int i = 32 * ti + crow(q, hf), j = 32 * tj + r;
                const float v = (j <= i) ? acc[q] : 0.f;
                *(LAS bf16_t*)(ATT + (i * 72 + j) * 2) = f2bf(v); }
        }
        {
#pragma unroll
            for (int i = 0; i < 2; ++i) { const int e = tid + 512 * i, row = e >> 4, c8 = e & 15;
                *(u32x4*)(QDg + (size_t)ci * 8192 + row * 128 + c8 * 8) = *(const LAS u32x4*)(QD + (row * 136 + c8 * 8) * 2); }
#pragma unroll
            for (int i = 0; i < 2; ++i) { const int e = tid + 512 * i, row = e >> 3, c8 = e & 7;
                *(u32x4*)(KUTg + (size_t)ci * 8192 + row * 64 + c8 * 8) = *(const LAS u32x4*)(KUT + row * 144 + 16 * (c8 ^ ((row >> 3) & 7))); }
            bf16_t* vtg = gla_vt_ptr(p.ws, ci);
#pragma unroll
            for (int i = 0; i < 4; ++i) { const int e = tid + 512 * i, row = e >> 3, c8 = e & 7;
                *(u32x4*)(vtg + row * 64 + c8 * 8) = *(const LAS u32x4*)(VTs + row * 144 + 16 * (c8 ^ ((row >> 3) & 7))); }
            if (tid < 32) { const f32x4 bl = *(const LAS f32x4*)(BL + tid * 4); f32x4 d; d[0] = __expf(bl[0]); d[1] = __expf(bl[1]); d[2] = __expf(bl[2]); d[3] = __expf(bl[3]);
                *(f32x4*)(DECg + (size_t)ci * 128 + tid * 4) = d; }
        }
        __syncthreads();
        {
            f32x16 acc0, acc1;
#pragma unroll
            for (int q = 0; q < 16; ++q) { acc0[q] = 0.f; acc1[q] = 0.f; }
            const int dv = 32 * wid + r, sw = (dv >> 3) & 7;
#pragma unroll
            for (int ks = 0; ks < 4; ++ks) {
                const bf16x8 a0 = *(const LAS bf16x8*)(ATT + (r * 72 + ks * 16 + 8 * hf) * 2);
                const bf16x8 a1 = *(const LAS bf16x8*)(ATT + ((32 + r) * 72 + ks * 16 + 8 * hf) * 2);
                const bf16x8 bb = *(const LAS bf16x8*)(VTs + dv * 144 + 16 * ((2 * ks + hf) ^ sw));
                acc0 = MFMA32(a0, bb, acc0); acc1 = MFMA32(a1, bb, acc1); }
#pragma unroll
            for (int q = 0; q < 16; ++q) { og[(t0 + crow(q, hf)) * D + h * 256 + dv] = acc0[q]; og[(t0 + 32 + crow(q, hf)) * D + h * 256 + dv] = acc1[q]; }
        }
        __syncthreads();
    }
}

DI void gla_scan_phase(LAS unsigned char* lds, const Prm& p) {
    const int tid = lthread(), wid = __builtin_amdgcn_readfirstlane(tid >> 6), lane = tid & 63, r = lane & 31, hf = lane >> 5;
    constexpr int BUF = 36352;
    float* oint = (float*)(p.ws + OFF_BIG);
    const bf16_t* QDg = (const bf16_t*)(p.ws + OFF_H); const bf16_t* KUTg = (const bf16_t*)(p.ws + OFF_H + (size_t)2048 * 16384); const float* DECg = (const float*)(p.ws + OFF_DEC);
    for (int item = lblock(); item < 32; item += gridDim.x) {
        const int b = item >> 2, h = item & 3;
        const int ci0 = item * 64;
        const int dv = 32 * wid + r;
        f32x16 S[4];
#pragma unroll
        for (int t = 0; t < 4; ++t)
#pragma unroll
            for (int q = 0; q < 16; ++q) S[t][q] = 0.f;
        u32x4 sq[2], sk[2]; f32x4 sd = {0.f, 0.f, 0.f, 0.f}; bf16x8 vf[4], vfn[4];
        const int qrow = tid >> 4, qc8 = tid & 15;
        const int krow = tid >> 3, kc8 = tid & 7;
#define SCAN_LOAD(ci_) do { const bf16_t* qg_ = QDg + (size_t)(ci_) * 8192; const bf16_t* kg_ = KUTg + (size_t)(ci_) * 8192; \
        sq[0] = *(const u32x4*)(qg_ + qrow * 128 + qc8 * 8); sq[1] = *(const u32x4*)(qg_ + (qrow + 32) * 128 + qc8 * 8); \
        sk[0] = *(const u32x4*)(kg_ + krow * 64 + kc8 * 8); sk[1] = *(const u32x4*)(kg_ + (krow + 64) * 64 + kc8 * 8); \
        if (tid < 32) sd = *(const f32x4*)(DECg + (size_t)(ci_) * 128 + tid * 4); } while (0)
#define SCAN_STORE(buf_) do { LAS unsigned char* b_ = lds + (buf_) * BUF; \
        *(LAS u32x4*)(b_ + (qrow * 136 + qc8 * 8) * 2) = sq[0]; *(LAS u32x4*)(b_ + ((qrow + 32) * 136 + qc8 * 8) * 2) = sq[1]; \
        *(LAS u32x4*)(b_ + 17408 + (krow * 72 + kc8 * 8) * 2) = sk[0]; *(LAS u32x4*)(b_ + 17408 + ((krow + 64) * 72 + kc8 * 8) * 2) = sk[1]; \
        if (tid < 32) *(LAS f32x4*)(b_ + 35840 + tid * 16) = sd; } while (0)
#define SCAN_VLOAD(dst, ci_) do { const bf16_t* vg_ = gla_vt_ptr(p.ws, (ci_)) + dv * 64 + 8 * hf; \
        _Pragma("unroll") for (int ks = 0; ks < 4; ++ks) dst[ks] = *(const bf16x8*)(vg_ + ks * 16); } while (0)
        SCAN_LOAD(ci0); SCAN_VLOAD(vf, ci0); SCAN_STORE(0);
        __syncthreads();
        for (int n = 0; n < 64; ++n) {
            const int cur = n & 1;
            const bool more = (n + 1 < 64);
            if (more) { SCAN_LOAD(ci0 + n + 1); SCAN_VLOAD(vfn, ci0 + n + 1); }
            const LAS unsigned char* qb = lds + cur * BUF; const LAS unsigned char* kb = qb + 17408; const LAS float* db = (const LAS float*)(qb + 35840);
            const size_t t0 = (size_t)b * SEQ + (size_t)n * 64;
            float* op = oint + t0 * 1664 + h * 256 + dv;
            f32x16 a0, a1;
#pragma unroll
            for (int q = 0; q < 16; ++q) { a0[q] = 0.f; a1[q] = 0.f; }
#pragma unroll
            for (int t = 0; t < 4; ++t)
#pragma unroll
                for (int s = 0; s < 2; ++s) {
                    u32x4 sp;
#pragma unroll
                    for (int j2 = 0; j2 < 4; ++j2) sp[j2] = pk2(S[t][8 * s + 2 * j2], S[t][8 * s + 2 * j2 + 1]);
                    const int dk0 = 32 * t + 16 * s + 4 * hf;
                    const u32x2 l0 = *(const LAS u32x2*)(qb + (r * 136 + dk0) * 2), h0 = *(const LAS u32x2*)(qb + (r * 136 + dk0 + 8) * 2);
                    const u32x2 l1 = *(const LAS u32x2*)(qb + ((32 + r) * 136 + dk0) * 2), h1 = *(const LAS u32x2*)(qb + ((32 + r) * 136 + dk0 + 8) * 2);
                    u32x4 f0, f1; f0[0] = l0[0]; f0[1] = l0[1]; f0[2] = h0[0]; f0[3] = h0[1]; f1[0] = l1[0]; f1[1] = l1[1]; f1[2] = h1[0]; f1[3] = h1[1];
                    a0 = MFMA32(__builtin_bit_cast(bf16x8, f0), __builtin_bit_cast(bf16x8, sp), a0);
                    a1 = MFMA32(__builtin_bit_cast(bf16x8, f1), __builtin_bit_cast(bf16x8, sp), a1); }
#pragma unroll
            for (int q = 0; q < 16; ++q) { op[(size_t)crow(q, hf) * 1664] = a0[q]; op[(size_t)(32 + crow(q, hf)) * 1664] = a1[q]; }
#pragma unroll
            for (int t = 0; t < 4; ++t) {
#pragma unroll
                for (int g = 0; g < 4; ++g) { const f32x4 d4 = *(const LAS f32x4*)(db + 32 * t + 8 * g + 4 * hf);
                    S[t][4 * g] *= d4[0]; S[t][4 * g + 1] *= d4[1]; S[t][4 * g + 2] *= d4[2]; S[t][4 * g + 3] *= d4[3]; }
#pragma unroll
                for (int ks = 0; ks < 4; ++ks) {
                    const bf16x8 a = *(const LAS bf16x8*)(kb + ((32 * t + r) * 72 + ks * 16 + 8 * hf) * 2);
                    S[t] = MFMA32(a, vf[ks], S[t]); }
            }
            if (more) { SCAN_STORE(cur ^ 1);
#pragma unroll
                for (int ks = 0; ks < 4; ++ks) vf[ks] = vfn[ks]; }
            __syncthreads();
        }
#undef SCAN_LOAD
#undef SCAN_STORE
#undef SCAN_VLOAD
    }
}

DI void attn_phase(LAS unsigned char* lds, const Prm& p) {
    const int tid = lthread(), wid = __builtin_amdgcn_readfirstlane(tid >> 6), lane = tid & 63, r = lane & 31, hf = lane >> 5;
    constexpr int KT_STRIDE = 400, KT_BYTES = 64 * KT_STRIDE, VT_STRIDE = 144, VT_BYTES = 128 * VT_STRIDE;
    LAS unsigned char* KT = lds;
    LAS unsigned char* VT = lds + 2 * KT_BYTES;
    const bf16_t* Q = (const bf16_t*)(p.ws + OFF_BIG + (size_t)T * 2048 * 2); const bf16_t* KV = (const bf16_t*)(p.ws + OFF_BIG);
    const bf16_t* KR = (const bf16_t*)(p.ws + OFF_KROPE); bf16_t* AO = (bf16_t*)(p.ws + OFF_H);
    const float* COS = (const float*)(p.ws + OFF_COS); const float* SIN = (const float*)(p.ws + OFF_SIN);
    const float SC = 0.07216878364870322f * 1.4426950408889634f;
    for (int it = lblock(); it < 1024; it += gridDim.x) {
        const int pass = it >> 8, blk = it & 255, bh = blk & 63, g = blk >> 6;
        const int qt = (pass == 0) ? g : (pass == 1) ? 7 - g : (pass == 2) ? 8 + g : 15 - g;
        const int b = bh >> 3, h = bh & 7, q0 = qt * 256;
        const size_t tok0 = (size_t)b * SEQ;
        const int qpos = q0 + 32 * wid + r;
        const size_t qrow = tok0 + qpos;
        bf16x8 qf[12];
        { const bf16_t* qp = Q + qrow * 1536 + h * 192 + 8 * hf;
#pragma unroll
          for (int ks = 0; ks < 12; ++ks) qf[ks] = *(const bf16x8*)(qp + ks * 16);
#pragma unroll
          for (int pr = 0; pr < 2; ++pr) {
              const int i0 = 16 * pr + 8 * hf;
              const f32x4 c0 = *(const f32x4*)(COS + qrow * 32 + i0), c1 = *(const f32x4*)(COS + qrow * 32 + i0 + 4);
              const f32x4 s0 = *(const f32x4*)(SIN + qrow * 32 + i0), s1 = *(const f32x4*)(SIN + qrow * 32 + i0 + 4);
              bf16x8 x1v = qf[8 + pr], x2v = qf[10 + pr], o1, o2;
#pragma unroll
              for (int j = 0; j < 8; ++j) { const float cc = (j < 4) ? c0[j & 3] : c1[j & 3], ss = (j < 4) ? s0[j & 3] : s1[j & 3];
                  const float x1 = bf2f((unsigned short)x1v[j]), x2 = bf2f((unsigned short)x2v[j]);
                  o1[j] = (short)f2bf(x1 * cc - x2 * ss); o2[j] = (short)f2bf(x1 * ss + x2 * cc); }
              qf[8 + pr] = o1; qf[10 + pr] = o2; } }
        float m = -1e30f, l = 0.f;
        f32x16 O[4];
#pragma unroll
        for (int d = 0; d < 4; ++d)
#pragma unroll
            for (int q = 0; q < 16; ++q) O[d][q] = 0.f;
        const int nkt = 4 * (qt + 1);
        u32x4 kraw[3], vraw[2];
        const int kkey = tid >> 4, kc8 = tid & 15;
        const int rkey = tid >> 3, rc8 = tid & 7;
        const int vp = tid >> 4, vc8 = tid & 15;
        const int vrd0 = r * VT_STRIDE + 8 * ((hf) ^ (r >> 3)), vrd1 = r * VT_STRIDE + 8 * ((2 + hf) ^ (r >> 3));
const unsigned offk0 = (unsigned)(kkey * 2048 + kc8 * 8), offk1 = offk0 + 32u * 2048u, offr = (unsigned)(rkey * 64 + rc8 * 8);
        const unsigned offv0 = (unsigned)(2 * vp * 2048 + 128 + vc8 * 8), offv1 = offv0 + 2048u;
        const bf16_t* kvb0 = KV + tok0 * 2048 + h * 256; const bf16_t* krb0 = KR + tok0 * 64;
#define ATT_LOAD(kt_) do { const bf16_t* kvb_ = kvb0 + (size_t)(kt_) * 64 * 2048; const bf16_t* krb_ = krb0 + (size_t)(kt_) * 64 * 64; \
        kraw[0] = *(const u32x4*)(kvb_ + offk0); kraw[1] = *(const u32x4*)(kvb_ + offk1); \
        kraw[2] = *(const u32x4*)(krb_ + offr); \
        vraw[0] = *(const u32x4*)(kvb_ + offv0); vraw[1] = *(const u32x4*)(kvb_ + offv1); } while (0)
#define ATT_STORE(buf_) do { LAS unsigned char* kt_ = KT + (buf_) * KT_BYTES; LAS unsigned char* vt_ = VT + (buf_) * VT_BYTES; \
        *(LAS u32x4*)(kt_ + kkey * KT_STRIDE + kc8 * 16) = kraw[0]; *(LAS u32x4*)(kt_ + (kkey + 32) * KT_STRIDE + kc8 * 16) = kraw[1]; \
        *(LAS u32x4*)(kt_ + rkey * KT_STRIDE + 256 + rc8 * 16) = kraw[2]; \
        _Pragma("unroll") for (int j2 = 0; j2 < 4; ++j2) { \
            const unsigned lo_ = (vraw[0][j2] & 0xffffu) | (vraw[1][j2] << 16), hi_ = (vraw[0][j2] >> 16) | (vraw[1][j2] & 0xffff0000u); \
            *(LAS unsigned*)(vt_ + (vc8 * 8 + 2 * j2) * VT_STRIDE + 4 * (vp ^ (2 * vc8))) = lo_; \
            *(LAS unsigned*)(vt_ + (vc8 * 8 + 2 * j2 + 1) * VT_STRIDE + 4 * (vp ^ (2 * vc8))) = hi_; } } while (0)
        ATT_LOAD(0); ATT_STORE(0);
        __syncthreads();
        for (int kt = 0; kt < nkt; ++kt) {
            const int cur = kt & 1;
            const bool more = (kt + 1 < nkt);
            if (more) ATT_LOAD(kt + 1);
            const int kbase = kt * 64;
            if (kbase <= q0 + 32 * wid + 31) {
                const LAS unsigned char* ktb = KT + cur * KT_BYTES; const LAS unsigned char* vtb = VT + cur * VT_BYTES;
                f32x16 s0, s1;
#pragma unroll
                for (int q = 0; q < 16; ++q) { s0[q] = 0.f; s1[q] = 0.f; }
#pragma unroll
                for (int ks = 0; ks < 12; ++ks) {
                    const bf16x8 a0 = *(const LAS bf16x8*)(ktb + r * KT_STRIDE + ks * 32 + 16 * hf);
                    const bf16x8 a1 = *(const LAS bf16x8*)(ktb + (32 + r) * KT_STRIDE + ks * 32 + 16 * hf);
                    s0 = MFMA32(a0, qf[ks], s0); s1 = MFMA32(a1, qf[ks], s1);
                    }
                const bool diag = (kbase + 63 > q0 + 32 * wid);
                float mx = -1e30f;
#pragma unroll
                for (int q = 0; q < 16; ++q) {
                    float v0 = s0[q] * SC, v1 = s1[q] * SC;
                    if (diag) { const int key = kbase + crow(q, hf); if (key > qpos) v0 = -1e30f; if (key + 32 > qpos) v1 = -1e30f; }
                    s0[q] = v0; s1[q] = v1; mx = fmaxf(mx, fmaxf(v0, v1)); }
                mx = fmaxf(mx, __shfl_xor(mx, 32));
                const float mn = fmaxf(m, mx), alpha = __builtin_amdgcn_exp2f(m - mn);
                m = mn;
                float ls = 0.f;
#pragma unroll
                for (int q = 0; q < 16; ++q) { s0[q] = __builtin_amdgcn_exp2f(s0[q] - mn); s1[q] = __builtin_amdgcn_exp2f(s1[q] - mn); ls += s0[q] + s1[q]; }
                l = l * alpha + ls;
#pragma unroll
                for (int d = 0; d < 4; ++d)
#pragma unroll
                    for (int q = 0; q < 16; ++q) O[d][q] *= alpha;
                bf16x8 pb[2][2];
#pragma unroll
                for (int s = 0; s < 2; ++s) {
                    u32x4 t0, t1;
#pragma unroll
                    for (int j2 = 0; j2 < 4; ++j2) { t0[j2] = pk2(s0[8 * s + 2 * j2], s0[8 * s + 2 * j2 + 1]); t1[j2] = pk2(s1[8 * s + 2 * j2], s1[8 * s + 2 * j2 + 1]); }
                    pb[0][s] = __builtin_bit_cast(bf16x8, t0); pb[1][s] = __builtin_bit_cast(bf16x8, t1); }
#pragma unroll
                for (int d = 0; d < 4; ++d) {
#pragma unroll
                    for (int ksub = 0; ksub < 2; ++ksub)
#pragma unroll
                        for (int s = 0; s < 2; ++s) {
                            const int imm = d * 32 * VT_STRIDE + 32 * (((2 * ksub + s) ^ d) & 3);
                            const u32x2 lo = *(const LAS u32x2*)(vtb + vrd0 + imm);
                            const u32x2 hi = *(const LAS u32x2*)(vtb + vrd1 + imm);
                            u32x4 av; av[0] = lo[0]; av[1] = lo[1]; av[2] = hi[0]; av[3] = hi[1];
                            O[d] = MFMA32(__builtin_bit_cast(bf16x8, av), pb[ksub][s], O[d]); }
                }
            }
            if (more) ATT_STORE(cur ^ 1);
            __syncthreads();
        }
#undef ATT_LOAD
#undef ATT_STORE
        l += __shfl_xor(l, 32);
        const float inv = 1.f / l;
#pragma unroll
        for (int d = 0; d < 4; ++d)
#pragma unroll
            for (int g4 = 0; g4 < 4; ++g4) { u32x2 pk; pk[0] = pk2(O[d][4 * g4] * inv, O[d][4 * g4 + 1] * inv); pk[1] = pk2(O[d][4 * g4 + 2] * inv, O[d][4 * g4 + 3] * inv);
                *(u32x2*)(AO + qrow * D + h * 128 + 32 * d + 8 * g4 + 4 * hf) = pk; }
    }
}


#define XB_TMO      128
#define XB_XCNT(j)  (256  + 64 * (j))
#define XB_XSUB(j)  (1280 + 64 * (j))
#define XB_XGEN(j)  (2304 + 64 * (j))
#define XB_TOP      3328
#define XB_TOPGEN   3392
#define XCD_BAR_WORDS 3456
#define XB_SPIN_CAP (1u << 22)
DI unsigned xb_ld(unsigned* p)              { return __hip_atomic_load(p, __ATOMIC_RELAXED, __HIP_MEMORY_SCOPE_AGENT); }
DI unsigned xb_add(unsigned* p, unsigned v) { return __hip_atomic_fetch_add(p, v, __ATOMIC_RELAXED, __HIP_MEMORY_SCOPE_AGENT); }
DI unsigned xb_xcc_id() { return (unsigned)__builtin_amdgcn_s_getreg((3 << 11) | 20) & 0xFu; }
#define XB_SPIN(cond, bar) do { unsigned _sp = 0; while (cond) { __builtin_amdgcn_s_sleep(1); \
    if ((++_sp & 255u) == 0u) { if (xb_ld(&(bar)[XB_TMO])) break; if (_sp > XB_SPIN_CAP) { atomicAdd(&(bar)[XB_TMO], 1u); break; } } } } while (0)
struct XcdBarrier { unsigned* bar; unsigned x; volatile LAS unsigned* st; };
DI XcdBarrier xcd_barrier_post(unsigned* bar, volatile LAS unsigned* st) {
    XcdBarrier b; b.bar = bar; b.x = xb_xcc_id(); b.st = st;
    if (threadIdx.x == 0) (void)xb_add(&bar[XB_XCNT(b.x)], 1u);
    return b;
}
DI void xcd_barrier_complete(unsigned* bar, unsigned x, unsigned& nloc, unsigned& nx) {
    const unsigned G = gridDim.x * gridDim.y * gridDim.z;
    unsigned sum, cnt, mine, sp = 0u;
    for (;;) {
        sum = 0u; cnt = 0u; mine = 0u;
#pragma unroll
        for (unsigned j = 0; j < 16; ++j) { const unsigned c = xb_ld(&bar[XB_XCNT(j)]); sum += c; cnt += (c > 0u) ? 1u : 0u; mine = (j == x) ? c : mine; }
        if (sum == G) break;
        __builtin_amdgcn_s_sleep(1);
        if ((++sp & 255u) == 0u) { if (xb_ld(&bar[XB_TMO])) break; if (sp > XB_SPIN_CAP) { atomicAdd(&bar[XB_TMO], 1u); break; } }
    }
    nloc = mine > 0u ? mine : 1u; nx = cnt > 0u ? cnt : 1u;
}
DI void xcd_barrier(const XcdBarrier& b) {
    asm volatile("s_waitcnt vmcnt(0)" ::: "memory");
    __syncthreads();
    if (threadIdx.x == 0) {
        unsigned* bar = b.bar;
        __builtin_amdgcn_s_waitcnt(0);
        unsigned nloc = b.st[0], nx = b.st[1];
        if (nloc == 0u) { xcd_barrier_complete(bar, b.x, nloc, nx); b.st[0] = nloc; b.st[1] = nx; }
        const unsigned old = xb_add(&bar[XB_XSUB(b.x)], 1u);
        const unsigned gen = old / nloc;
        if (old + 1u == (gen + 1u) * nloc) {
            __builtin_amdgcn_fence(__ATOMIC_RELEASE, "agent");
            asm volatile("s_waitcnt vmcnt(0)" ::: "memory");
            const unsigned og = xb_add(&bar[XB_TOP], 1u);
            const unsigned tg = og / nx;
            if (og + 1u == (tg + 1u) * nx) xb_add(&bar[XB_TOPGEN], 1u);
            else XB_SPIN(xb_ld(&bar[XB_TOPGEN]) == tg, bar);
            __builtin_amdgcn_fence(__ATOMIC_ACQUIRE, "agent");
            xb_add(&bar[XB_XGEN(b.x)], 1u);
            asm volatile("s_waitcnt vmcnt(0)" ::: "memory");
        } else {
            XB_SPIN(xb_ld(&bar[XB_XGEN(b.x)]) == gen, bar);
            __builtin_amdgcn_fence(__ATOMIC_ACQUIRE, "agent");
            asm volatile("s_waitcnt vmcnt(0)" ::: "memory");
        }
    }
    __syncthreads();
}

__global__ void __launch_bounds__(NTHREADS) fwd_megakernel(Prm p) {
    extern __shared__ __attribute__((aligned(16))) unsigned char lds_raw[];
    LAS unsigned char* lds = (LAS unsigned char*)lds_raw;
    cg::grid_group grid = cg::this_grid();
    if (threadIdx.x < 4) ((LAS unsigned*)(lds + 131072))[threadIdx.x] = 0u;
    __syncthreads();
    XcdBarrier xbar = xcd_barrier_post((unsigned*)(p.ws + OFF_BAR), (volatile LAS unsigned*)(lds + 131072));
    unsigned char* ws = p.ws;
    float* mods = (float*)(ws + OFF_MODS); float* kvm = (float*)(ws + OFF_KVMODS);
    bf16_t* H = (bf16_t*)(ws + OFF_H); float* Y = (float*)(ws + OFF_Y); bf16_t* BIG = (bf16_t*)(ws + OFF_BIG);
    const int G = gridDim.x, cblk = lblock();
#pragma unroll 1
    for (int ph = p.ph_lo; ph < p.ph_hi; ++ph) {
#if DUP_MASK
      const int nrep = ((DUP_MASK >> ph) & 1u) ? 2 : 1;
#pragma unroll 1
      for (int rep = 0; rep < nrep; ++rep)
#endif
        switch (ph) {
        case PH_PRO: {
            mods_phase(lds, p);
            rope_tables(p);
            convert_w(lds, p.gla_w_in, 1024, 3088, (bf16_t*)(ws + OFF_WGIN), 3328, WM_GIN);
            convert_w(lds, p.gla_w_out, 1024, 1024, (bf16_t*)(ws + OFF_WGOUT), 1024, WM_ID);
            convert_w(lds, p.w_kv_a, 1024, 320, (bf16_t*)(ws + OFF_WKVA), 512, WM_LIM320);
            convert_w(lds, p.w_kv_b, 256, 2048, (bf16_t*)(ws + OFF_WKVB), 2048, WM_ID);
            convert_w(lds, p.w_dq, 1024, 384, (bf16_t*)(ws + OFF_WDQ), 512, WM_LIM384);
            convert_w(lds, p.w_uq, 384, 1536, (bf16_t*)(ws + OFF_WUQ), 1536, WM_ID);
            convert_w(lds, p.w_mout, 1024, 1024, (bf16_t*)(ws + OFF_WMOUT), 1024, WM_ID);
            convert_ffn(lds, p, 0, 0);
        } break;
        case PH_ROW0: case PH_ROW1: case PH_ROW2: case PH_ROW3: case PH_ROW4: case PH_ROW5: case PH_ROW6: {
            const int ps = (ph == PH_ROW0) ? -1 : (ph == PH_ROW1) ? 0 : (ph == PH_ROW2) ? 1 : (ph == PH_ROW3) ? 2 : (ph == PH_ROW4) ? 3 : (ph == PH_ROW5) ? 4 : 5;
            RowP a;
            a.xin = (ph <= PH_ROW1) ? p.x : p.out; a.y = nullptr; a.xout = p.out; a.rw = 0.f; a.gate = nullptr; a.gate_bs = 9216; a.g_post = nullptr;
            a.g1 = nullptr; a.sh1 = nullptr; a.sc1 = nullptr; a.bs1 = 9216; a.h1 = nullptr; a.g2 = nullptr; a.sh2 = nullptr; a.sc2 = nullptr; a.bs2 = 2048; a.h2 = nullptr;
            if (ps >= 0) { const int l = ps / 3, s = ps % 3; a.y = Y; a.rw = (s == 1) ? 1.f : 0.5f;
                a.gate = mods + (size_t)l * 8 * 9216 + (3 * s + 2) * 1024; a.g_post = p.norm_g + ((l * 3 + s) * 2 + 1) * 1024; }
            const int pre = ps + 1;
            if (pre < 6) { const int l = pre / 3, s = pre % 3; a.h1 = H; a.g1 = p.norm_g + ((l * 3 + s) * 2) * 1024;
                a.sh1 = mods + (size_t)l * 8 * 9216 + (3 * s) * 1024; a.sc1 = mods + (size_t)l * 8 * 9216 + (3 * s + 1) * 1024; }
            if (ph == PH_ROW3) { a.h2 = BIG; a.g2 = p.kv_g_in; a.sh2 = kvm; a.sc2 = kvm + 1024; }
            rowwise_phase(a);
            if (ph == PH_ROW1) convert_ffn(lds, p, 0, 1);
            if (ph == PH_ROW3) convert_ffn(lds, p, 1, 0);
            if (ph == PH_ROW4) convert_ffn(lds, p, 1, 1);
        } break;
        case PH_A_G1: case PH_B_G1: case PH_C_G1: case PH_D_G1: {
            pg8::Gemm g{H, (const bf16_t*)(ws + OFF_WGU), T, 5632, 1024}; pg8::StaticOrder S; S.init(T, 5632, G, cblk);
            pg8::EpiSwiglu E{BIG};
            pg8::gemm_phase<pg8::EpiSwiglu>(lds, g, S, E);
        } break;
        case PH_A_G2: case PH_B_G2: case PH_C_G2: case PH_D_G2: case PH_GOUT: case PH_MOUT: case PH_KVA: {
            pg8::Gemm g; pg8::EpiF32 E;
            if (ph == PH_GOUT) { g = pg8::Gemm{H, (const bf16_t*)(ws + OFF_WGOUT), T, 1024, 1024}; E = pg8::EpiF32{Y, 1024}; }
            else if (ph == PH_MOUT) { g = pg8::Gemm{H, (const bf16_t*)(ws + OFF_WMOUT), T, 1024, 1024}; E = pg8::EpiF32{Y, 1024}; }
            else if (ph == PH_KVA) { g = pg8::Gemm{BIG, (const bf16_t*)(ws + OFF_WKVA), T, 512, 1024}; E = pg8::EpiF32{Y, 512}; }
            else { g = pg8::Gemm{BIG, (const bf16_t*)(ws + OFF_WDN), T, 1024, 2816}; E = pg8::EpiF32{Y, 1024}; }
            pg8::StaticOrder S; S.init(T, g.N, G, cblk);
            pg8::gemm_phase<pg8::EpiF32>(lds, g, S, E);
        } break;
        case PH_GIN: case PH_UQ: {
            pg8::Gemm g; pg8::EpiBf16 E;
            if (ph == PH_GIN) { g = pg8::Gemm{H, (const bf16_t*)(ws + OFF_WGIN), T, 3328, 1024}; E = pg8::EpiBf16{BIG, 3328, (float*)(ws + OFF_GLOW), 12}; }
            else { g = pg8::Gemm{(const bf16_t*)(ws + OFF_Y + (size_t)T * 512 * 4), (const bf16_t*)(ws + OFF_WUQ), T, 1536, 384}; E = pg8::EpiBf16{(bf16_t*)(ws + OFF_BIG + (size_t)T * 2048 * 2), 1536, nullptr, -1}; }
            pg8::StaticOrder S; S.init(T, g.N, G, cblk);
            pg8::gemm_phase<pg8::EpiBf16>(lds, g, S, E);
        } break;
        case PH_GLA_CHUNK: gla_chunk_phase(lds, p); break;
        case PH_GLA_SCAN: gla_scan_phase(lds, p); break;
        case PH_GLA_GATE: gla_gate_phase(p); break;
        case PH_CKV: ckv_phase(p); break;
        case PH_DQ_KVB: {
            { pg8::Gemm g{H, (const bf16_t*)(ws + OFF_WDQ), T, 512, 1024}; pg8::EpiF32 E{Y, 512}; pg8::StaticOrder S; S.init(T, 512, G, cblk);
              pg8::gemm_phase<pg8::EpiF32>(lds, g, S, E); }
            { pg8::Gemm g{(const bf16_t*)(ws + OFF_CKVN), (const bf16_t*)(ws + OFF_WKVB), T, 2048, 256}; pg8::EpiBf16 E{BIG, 2048, nullptr, -1}; pg8::StaticOrder S; S.init(T, 2048, G, cblk);
              pg8::gemm_phase<pg8::EpiBf16>(lds, g, S, E); }
        } break;
        case PH_CQ: cq_phase(p); break;
        case PH_ATTN: attn_phase(lds, p); break;
        default: break;
        }
        if (ph + 1 < p.ph_hi) { if (p.ph_hi > NPH) grid.sync(); else xcd_barrier(xbar); }
    }
}

extern "C" void kernel_launch(void* const* d_in, const int* in_sizes, int n_in, void* d_out, int out_size, void* d_ws, size_t ws_size, hipStream_t stream) {
    static int grid_blocks = 0;
    if (grid_blocks == 0) {
        if (n_in != 23 || ws_size < WS_END) { fprintf(stderr, "kernel_launch: unexpected n_in %d / ws %zu (need %zu)\n", n_in, ws_size, (size_t)WS_END); grid_blocks = -1; return; }
        int dev = 0, cus = 0, per_cu = 0;
        (void)hipGetDevice(&dev);
        (void)hipDeviceGetAttribute(&cus, hipDeviceAttributeMultiprocessorCount, dev);
        if (hipFuncSetAttribute((const void*)fwd_megakernel, hipFuncAttributeMaxDynamicSharedMemorySize, LDS_BYTES) != hipSuccess) { fprintf(stderr, "kernel_launch: hipFuncSetAttribute failed\n"); grid_blocks = -1; return; }
        if (hipOccupancyMaxActiveBlocksPerMultiprocessor(&per_cu, (const void*)fwd_megakernel, NTHREADS, LDS_BYTES) != hipSuccess || per_cu < 1) { fprintf(stderr, "kernel_launch: occupancy query says %d\n", per_cu); per_cu = 1; }
        (void)hipGetLastError();
        grid_blocks = cus * 1;
        fprintf(stderr, "kernel_launch: cus %d per_cu %d grid %d\n", cus, per_cu, grid_blocks);
    }
    if (grid_blocks < 0) return;
    Prm p{};
    p.x = (const float*)d_in[0]; p.c = (const float*)d_in[1]; p.pos = (const int*)d_in[2]; p.cond_w = (const float*)d_in[3]; p.cond_b = (const float*)d_in[4];
    p.norm_g = (const float*)d_in[5]; p.ffn_gu = (const float*)d_in[6]; p.ffn_dn = (const float*)d_in[7]; p.gla_w_in = (const float*)d_in[8];
    p.gla_w_gate_up = (const float*)d_in[9]; p.gla_b_gate = (const float*)d_in[10]; p.gla_g_out = (const float*)d_in[11]; p.gla_w_out = (const float*)d_in[12];
    p.kv_g_in = (const float*)d_in[13]; p.kv_cond_w = (const float*)d_in[14]; p.kv_cond_b = (const float*)d_in[15]; p.w_kv_a = (const float*)d_in[16];
    p.g_kv = (const float*)d_in[17]; p.w_kv_b = (const float*)d_in[18]; p.w_dq = (const float*)d_in[19]; p.g_q = (const float*)d_in[20];
    p.w_uq = (const float*)d_in[21]; p.w_mout = (const float*)d_in[22];
    p.out = (float*)d_out; p.ws = (unsigned char*)d_ws;
    (void)hipMemsetAsync((unsigned char*)d_ws + OFF_BAR, 0, 16384, stream);
#if MULTI_LAUNCH
    for (int ph = 0; ph < NPH; ++ph) {
        p.ph_lo = ph; p.ph_hi = ph + 1;
        hipLaunchKernelGGL(fwd_megakernel, dim3(grid_blocks), dim3(NTHREADS), LDS_BYTES, stream, p);
    }
#else
    p.ph_lo = 0; p.ph_hi = NPH;
    void* args[] = {&p};
    hipError_t e = hipLaunchCooperativeKernel((const void*)fwd_megakernel, dim3(grid_blocks), dim3(NTHREADS), args, LDS_BYTES, stream);
    if (e != hipSuccess) fprintf(stderr, "cooperative launch failed: %s (grid %d)\n", hipGetErrorString(e), grid_blocks);
#endif
}
```

```cpp
#include <hip/hip_runtime.h>
#include <hip/hip_cooperative_groups.h>
#include <cstdio>
namespace cg = cooperative_groups;

#define LAS __attribute__((address_space(3)))
#define DI __device__ __forceinline__
typedef unsigned short bf16_t;
typedef short bf16x8 __attribute__((ext_vector_type(8)));
typedef float f32x2 __attribute__((ext_vector_type(2)));
typedef float f32x4 __attribute__((ext_vector_type(4)));
typedef float f32x16 __attribute__((ext_vector_type(16)));
typedef unsigned u32x2 __attribute__((ext_vector_type(2)));
typedef unsigned u32x4 __attribute__((ext_vector_type(4)));
typedef __bf16 bf16v2 __attribute__((ext_vector_type(2)));

#ifndef MULTI_LAUNCH
#define MULTI_LAUNCH 0
#endif
#ifndef DUP_MASK
#define DUP_MASK 0u
#endif

constexpr int T = 32768, D = 1024, SEQ = 4096, NB = 8, DFF = 2816;
constexpr int NTHREADS = 512;
constexpr int LDS_BYTES = 131072 + 16;
constexpr float EPS = 1e-6f;
enum { PH_PRO = 0, PH_ROW0, PH_A_G1, PH_A_G2, PH_ROW1, PH_GIN, PH_GLA_CHUNK, PH_GLA_SCAN, PH_GLA_GATE, PH_GOUT, PH_ROW2, PH_B_G1, PH_B_G2, PH_ROW3,
       PH_KVA, PH_CKV, PH_C_G1, PH_C_G2, PH_ROW4, PH_DQ_KVB, PH_CQ, PH_UQ, PH_ATTN, PH_MOUT, PH_ROW5, PH_D_G1, PH_D_G2, PH_ROW6, NPH };

constexpr size_t SZ_WGU = (size_t)5632 * 1024 * 2, SZ_WDN = (size_t)1024 * 2816 * 2, SZ_WGIN = (size_t)3328 * 1024 * 2;
constexpr size_t OFF_BAR = 0;
constexpr size_t OFF_WGU = 16384;
constexpr size_t OFF_WDN = OFF_WGU + SZ_WGU;
constexpr size_t OFF_WGIN = OFF_WDN + SZ_WDN;
constexpr size_t OFF_WGOUT = OFF_WGIN + SZ_WGIN;
constexpr size_t OFF_WKVA = OFF_WGOUT + (size_t)1024 * 1024 * 2;
constexpr size_t OFF_WKVB = OFF_WKVA + (size_t)512 * 1024 * 2;
constexpr size_t OFF_WDQ = OFF_WKVB + (size_t)2048 * 256 * 2;
constexpr size_t OFF_WUQ = OFF_WDQ + (size_t)512 * 1024 * 2;
constexpr size_t OFF_WMOUT = OFF_WUQ + (size_t)1536 * 384 * 2;
constexpr size_t OFF_MODS = OFF_WMOUT + (size_t)1024 * 1024 * 2;
constexpr size_t OFF_KVMODS = OFF_MODS + (size_t)2 * 8 * 9216 * 4;
constexpr size_t OFF_COS = OFF_KVMODS + (size_t)8 * 2048 * 4;
constexpr size_t OFF_SIN = OFF_COS + (size_t)T * 32 * 4;
constexpr size_t OFF_GLOW = OFF_SIN + (size_t)T * 32 * 4;
constexpr size_t OFF_CKVN = OFF_GLOW + (size_t)T * 16 * 4;
constexpr size_t OFF_KROPE = OFF_CKVN + (size_t)T * 256 * 2;
constexpr size_t OFF_H = OFF_KROPE + (size_t)T * 64 * 2;
constexpr size_t OFF_Y = OFF_H + (size_t)T * 1024 * 2;
constexpr size_t OFF_BIG = OFF_Y + (size_t)T * 1024 * 4;
constexpr size_t SZ_BIG = (size_t)T * 2048 * 2 + (size_t)T * 1536 * 2;
constexpr size_t OFF_VTA = OFF_BIG + (size_t)T * 3328 * 2;
constexpr size_t OFF_DEC = OFF_VTA + (size_t)1536 * 32768;
constexpr size_t WS_END = (OFF_DEC + (size_t)2048 * 512 > OFF_BIG + SZ_BIG) ? OFF_DEC + (size_t)2048 * 512 : OFF_BIG + SZ_BIG;
static_assert(WS_END <= (size_t)536870912, "workspace");
static_assert(SZ_BIG >= (size_t)T * 3328 * 2 && SZ_BIG >= (size_t)T * 2816 * 2, "big");

struct Prm {
    const float* x; const float* c; const int* pos; const float* cond_w; const float* cond_b; const float* norm_g;
    const float* ffn_gu; const float* ffn_dn; const float* gla_w_in; const float* gla_w_gate_up; const float* gla_b_gate;
    const float* gla_g_out; const float* gla_w_out; const float* kv_g_in; const float* kv_cond_w; const float* kv_cond_b;
    const float* w_kv_a; const float* g_kv; const float* w_kv_b; const float* w_dq; const float* g_q; const float* w_uq; const float* w_mout;
    float* out; unsigned char* ws; int ph_lo, ph_hi;
};

DI float bf2f(unsigned short b) { return __uint_as_float(((unsigned)b) << 16); }
DI unsigned pk2(float lo, float hi) { f32x2 v = {lo, hi}; bf16v2 b = __builtin_convertvector(v, bf16v2); return __builtin_bit_cast(unsigned, b); }
DI bf16_t f2bf(float f) { return (bf16_t)(pk2(f, 0.f) & 0xffffu); }
DI float lo_f(unsigned u) { return __uint_as_float(u << 16); }
DI float hi_f(unsigned u) { return __uint_as_float(u & 0xffff0000u); }
DI float wave_sum(float v) {
#pragma unroll
    for (int o = 32; o > 0; o >>= 1) v += __shfl_xor(v, o);
    return v;
}
DI float silu_f(float v) { return v / (1.f + __expf(-v)); }
DI int crow(int reg, int hf) { return (reg & 3) + 8 * (reg >> 2) + 4 * hf; }
DI int lthread() { int t = threadIdx.x; asm volatile("" : "+v"(t)); return t; }
DI int lblock() { int t = blockIdx.x; asm volatile("" : "+s"(t)); return t; }
#define MFMA32(a, b, c) __builtin_amdgcn_mfma_f32_32x32x16_bf16((a), (b), (c), 0, 0, 0)

namespace pg8 {
constexpr int BM = 256, BK = 64, HALF = 128, HTB = HALF * BK * 2, STAGE_BYTES = 8 * HTB, NXCD = 8, WGM = 8;
DI int lds_byte(int r, int c) { const int st = (r >> 4) * 2 + (c >> 5), rr = r & 15, cc = c & 31, ob = rr * 64 + cc * 2; return st * 1024 + (ob ^ (((ob >> 9) & 1) << 5)); }
DI void stage_rc(int b, int& R, int& C) { const int st = b / 1024, sb = b % 1024, swz = sb ^ (((sb >> 9) & 1) << 5); R = (st >> 1) * 16 + swz / 64; C = (st & 1) * 32 + (swz % 64) / 2; }
DI int perm32(int rho) { const int n = rho >> 4, i = rho & 15; return 8 * (i >> 2) + 4 * n + (i & 3); }

struct Unit { int pm, pn; };
struct Gemm { const bf16_t* A; const bf16_t* Bt; int M, N, K; };

struct StaticOrder {
    int nM, nN, nwg, G, c;
    DI void init(int M, int N, int G_, int c_) { nM = M / BM; nN = N / BM; nwg = nM * nN; G = G_; c = c_; }
    DI bool next(int i, Unit& u) const {
        const long L = (long)i * G + c; if (L >= nwg) return false;
        int wgid = (int)L; { const int q = nwg / NXCD, r = nwg % NXCD, xcd = wgid % NXCD, off = wgid / NXCD; wgid = (xcd < r ? xcd * (q + 1) : r * (q + 1) + (xcd - r) * q) + off; }
        const int nig = WGM * nN, gid = wgid / nig, fm = gid * WGM, gsz = (nM - fm) < WGM ? (nM - fm) : WGM;
        u.pm = fm + ((wgid % nig) % gsz); u.pn = (wgid % nig) / gsz; return true;
    }
};

struct EpiF32 {
    static constexpr bool PERM = false;
    float* C; int ldc;
    DI void operator()(const f32x4 (&acc)[2][2][4][2], const Unit& u, int wr, int wc, int fr, int fq) const {
        const int row0 = u.pm * BM + wr * 64 + fr, col0 = u.pn * BM + wc * 32 + 4 * fq;
#pragma unroll
        for (int ai = 0; ai < 2; ++ai)
#pragma unroll
            for (int m = 0; m < 4; ++m) { float* rowp = C + (size_t)(row0 + ai * HALF + m * 16) * ldc + col0;
#pragma unroll
                for (int bj = 0; bj < 2; ++bj)
#pragma unroll
                    for (int n = 0; n < 2; ++n) *(f32x4*)(rowp + bj * HALF + n * 16) = acc[ai][bj][m][n]; }
    }
};
struct EpiBf16 {
    static constexpr bool PERM = true;
    bf16_t* O; int ldc; float* glow; int glow_pn;
    DI void operator()(const f32x4 (&acc)[2][2][4][2], const Unit& u, int wr, int wc, int fr, int fq) const {
        const int row0 = u.pm * BM + wr * 64 + fr, col0 = u.pn * BM + wc * 32 + 8 * fq;
        const bool gl = (glow != nullptr) && (u.pn == glow_pn) && (wc == 0) && (fq < 2);
#pragma unroll
        for (int ai = 0; ai < 2; ++ai)
#pragma unroll
            for (int m = 0; m < 4; ++m) { const int row = row0 + ai * HALF + m * 16; bf16_t* rowp = O + (size_t)row * ldc + col0;
#pragma unroll
                for (int bj = 0; bj < 2; ++bj) { const f32x4 v0 = acc[ai][bj][m][0], v1 = acc[ai][bj][m][1];
                    u32x4 pk; pk[0] = pk2(v0[0], v0[1]); pk[1] = pk2(v0[2], v0[3]); pk[2] = pk2(v1[0], v1[1]); pk[3] = pk2(v1[2], v1[3]);
                    *(u32x4*)(rowp + bj * HALF) = pk;
                    if (bj == 0 && gl) { *(f32x4*)(glow + (size_t)row * 16 + 8 * fq) = v0; *(f32x4*)(glow + (size_t)row * 16 + 8 * fq + 4) = v1; } } }
    }
};
struct EpiSwiglu {
    static constexpr bool PERM = true;
    bf16_t* O;
    DI void operator()(const f32x4 (&acc)[2][2][4][2], const Unit& u, int wr, int wc, int fr, int fq) const {
        const int row0 = u.pm * BM + wr * 64 + fr, col0 = u.pn * HALF + wc * 32 + 8 * fq;
#pragma unroll
        for (int ai = 0; ai < 2; ++ai)
#pragma unroll
            for (int m = 0; m < 4; ++m) { bf16_t* rowp = O + (size_t)(row0 + ai * HALF + m * 16) * DFF + col0;
                const f32x4 g0 = acc[ai][0][m][0], g1 = acc[ai][0][m][1], u0 = acc[ai][1][m][0], u1 = acc[ai][1][m][1];
                u32x4 pk;
                pk[0] = pk2(silu_f(g0[0]) * u0[0], silu_f(g0[1]) * u0[1]); pk[1] = pk2(silu_f(g0[2]) * u0[2], silu_f(g0[3]) * u0[3]);
                pk[2] = pk2(silu_f(g1[0]) * u1[0], silu_f(g1[1]) * u1[1]); pk[3] = pk2(silu_f(g1[2]) * u1[2], silu_f(g1[3]) * u1[3]);
                *(u32x4*)rowp = pk; }
    }
};

template <class Epi>
DI void gemm_phase(LAS unsigned char* lds, const Gemm g, const StaticOrder& S, const Epi& E) {
    const int tid = lthread(), wid = __builtin_amdgcn_readfirstlane(tid >> 6), lane = tid & 63, wr = wid >> 2, wc = wid & 3, fr = lane & 15, fq = lane >> 4;
    const int K = g.K, nt = K / BK;
    unsigned voffA[2], voffB[2];
#pragma unroll
    for (int i = 0; i < 2; ++i) { int R, C; stage_rc(tid * 16 + i * 8192, R, C); const int Rb = Epi::PERM ? ((R & ~31) + perm32(R & 31)) : R;
        voffA[i] = (unsigned)(R * K + C) * 2u; voffB[i] = (unsigned)(Rb * K + C) * 2u; }
    const size_t kstep = (size_t)(BK * 2);
    const size_t hstep = (size_t)HALF * K * 2;
    const size_t tstep = 2 * hstep;
    const unsigned ldsw = (unsigned)wid * 1024u;
    const int aoff = lds_byte(wr * 64 + fr, fq * 8), boff = lds_byte(wc * 32 + fr, fq * 8);
#define PG8_SA(b, h) (((b) * 2 + (h)) * HTB)
#define PG8_SB(b, h) ((4 + (b) * 2 + (h)) * HTB)
#define PG8_STAGE(bufoff, gbase, voff) do { _Pragma("unroll") for (int _i = 0; _i < 2; ++_i) \
        __builtin_amdgcn_global_load_lds((const unsigned*)((const char*)(gbase) + (voff)[_i]), (LAS unsigned*)(lds + (bufoff) + ldsw + _i * 8192), 16, 0, 0); } while (0)
#define PG8_LDA(dst, b, h) do { _Pragma("unroll") for (int m = 0; m < 4; ++m) _Pragma("unroll") for (int k = 0; k < 2; ++k) dst[m][k] = *(const LAS bf16x8*)(lds + PG8_SA(b, h) + aoff + m * 2048 + k * 1024); } while (0)
#define PG8_LDB(dst, b, h) do { _Pragma("unroll") for (int n = 0; n < 2; ++n) _Pragma("unroll") for (int k = 0; k < 2; ++k) dst[n][k] = *(const LAS bf16x8*)(lds + PG8_SB(b, h) + boff + n * 2048 + k * 1024); } while (0)
#define PG8_MMA(ai, bj, At, Bt) do { __builtin_amdgcn_s_setprio(1); _Pragma("unroll") for (int m = 0; m < 4; ++m) _Pragma("unroll") for (int n = 0; n < 2; ++n) _Pragma("unroll") for (int k = 0; k < 2; ++k) \
        acc[ai][bj][m][n] = __builtin_amdgcn_mfma_f32_16x16x32_bf16(Bt[n][k], At[m][k], acc[ai][bj][m][n], 0, 0, 0); __builtin_amdgcn_s_setprio(0); } while (0)
#define PG8_WAIT_V(n) asm volatile("s_waitcnt vmcnt(" #n ")" ::: "memory")
#define PG8_WAIT_L(n) asm volatile("s_waitcnt lgkmcnt(" #n ")" ::: "memory")
#define PG8_BAR __builtin_amdgcn_s_barrier()
#define PG8_SCHED __builtin_amdgcn_sched_barrier(0)
    Unit cur, nxt; int ui = 0;
    if (!S.next(0, cur)) return;
    f32x4 acc[2][2][4][2];
#pragma unroll
    for (int a = 0; a < 2; ++a)
#pragma unroll
        for (int b = 0; b < 2; ++b)
#pragma unroll
            for (int m = 0; m < 4; ++m)
#pragma unroll
                for (int n = 0; n < 2; ++n) acc[a][b][m][n] = (f32x4){0.f, 0.f, 0.f, 0.f};
    bf16x8 At[4][2], B0[2][2], B1[2][2];
    const char* cA = (const char*)g.A + (size_t)cur.pm * tstep; const char* cB = (const char*)g.Bt + (size_t)cur.pn * tstep;
    PG8_STAGE(PG8_SB(0, 0), cB, voffB); PG8_STAGE(PG8_SA(0, 0), cA, voffA); PG8_STAGE(PG8_SB(0, 1), cB + hstep, voffB); PG8_STAGE(PG8_SA(0, 1), cA + hstep, voffA);
    if (wr == 1) PG8_BAR;
    PG8_WAIT_V(4); PG8_BAR;
    PG8_STAGE(PG8_SB(1, 0), cB + kstep, voffB); PG8_STAGE(PG8_SA(1, 0), cA + kstep, voffA); PG8_STAGE(PG8_SB(1, 1), cB + hstep + kstep, voffB);
    PG8_WAIT_V(6); PG8_BAR;
    for (;;) {
        const bool has_next = S.next(ui + 1, nxt);
        const char* nA = has_next ? (const char*)g.A + (size_t)nxt.pm * tstep : cA; const char* nB = has_next ? (const char*)g.Bt + (size_t)nxt.pn * tstep : cB;
        for (int t = 0; t < nt; t += 2) {
            const bool last = (t == nt - 2);
            const char* a1 = cA + (size_t)(t + 1) * kstep;
            const char* a2 = last ? nA : cA + (size_t)(t + 2) * kstep; const char* b2 = last ? nB : cB + (size_t)(t + 2) * kstep;
            const char* a3 = a2 + kstep; const char* b3 = b2 + kstep;
            PG8_LDB(B0, 0, 0); PG8_SCHED; PG8_LDA(At, 0, 0); PG8_STAGE(PG8_SA(1, 1), a1 + hstep, voffA);
            PG8_WAIT_L(8); PG8_BAR; PG8_WAIT_L(0); PG8_MMA(0, 0, At, B0); PG8_BAR; PG8_SCHED;
            PG8_LDB(B1, 0, 1); PG8_STAGE(PG8_SB(0, 0), b2, voffB);
            PG8_BAR; PG8_WAIT_L(0); PG8_MMA(0, 1, At, B1); PG8_BAR;
            PG8_LDA(At, 0, 1); PG8_STAGE(PG8_SA(0, 0), a2, voffA);
            PG8_BAR; PG8_WAIT_L(0); PG8_MMA(1, 0, At, B0); PG8_BAR; PG8_SCHED;
            PG8_STAGE(PG8_SB(0, 1), b2 + hstep, voffB);
            PG8_WAIT_V(6); PG8_BAR; PG8_MMA(1, 1, At, B1); PG8_BAR;
            PG8_LDB(B0, 1, 0); PG8_SCHED; PG8_LDA(At, 1, 0); PG8_STAGE(PG8_SA(0, 1), a2 + hstep, voffA);
            PG8_WAIT_L(8); PG8_BAR; PG8_WAIT_L(0); PG8_MMA(0, 0, At, B0); PG8_BAR; PG8_SCHED;
            PG8_LDB(B1, 1, 1); PG8_STAGE(PG8_SB(1, 0), b3, voffB);
            PG8_BAR; PG8_WAIT_L(0); PG8_MMA(0, 1, At, B1); PG8_BAR;
            PG8_LDA(At, 1, 1); PG8_STAGE(PG8_SA(1, 0), a3, voffA);
            PG8_BAR; PG8_WAIT_L(0); PG8_MMA(1, 0, At, B0); PG8_BAR; PG8_SCHED;
            PG8_STAGE(PG8_SB(1, 1), b3 + hstep, voffB);
            PG8_WAIT_V(6); PG8_BAR; PG8_MMA(1, 1, At, B1); PG8_BAR;
        }
        E(acc, cur, wr, wc, fr, fq);
        if (!has_next) break;
#pragma unroll
        for (int a = 0; a < 2; ++a)
#pragma unroll
            for (int b = 0; b < 2; ++b)
#pragma unroll
                for (int m = 0; m < 4; ++m)
#pragma unroll
                    for (int n = 0; n < 2; ++n) acc[a][b][m][n] = (f32x4){0.f, 0.f, 0.f, 0.f};
        cur = nxt; cA = nA; cB = nB; ++ui;
    }
    PG8_WAIT_V(0);
    if (wr == 0) PG8_BAR;
    PG8_BAR;
#undef PG8_SA
#undef PG8_SB
#undef PG8_STAGE
#undef PG8_LDA
#undef PG8_LDB
#undef PG8_MMA
#undef PG8_WAIT_V
#undef PG8_WAIT_L
#undef PG8_BAR
#undef PG8_SCHED
}
}

enum { WM_ID = 0, WM_GU, WM_GIN, WM_LIM320, WM_LIM384 };
DI int wmap(int mode, int r) {
    switch (mode) {
        case WM_GU: { const int t = r >> 8, w = r & 255; return w < 128 ? t * 128 + w : DFF + t * 128 + (w - 128); }
        case WM_GIN: return r < 2048 ? r : (r < 3072 ? r + 16 : (r < 3088 ? r - 1024 : -1));
        case WM_LIM320: return r < 320 ? r : -1;
        case WM_LIM384: return r < 384 ? r : -1;
        default: return r;
    }
}
DI void convert_w(LAS unsigned char* lds, const float* __restrict__ src, int K, int N, bf16_t* __restrict__ dst, int Nd, int mode) {
    LAS float* tile = (LAS float*)lds;
    const int tid = lthread(), ntk = K >> 6, ntiles = (Nd >> 6) * ntk;
    const int lk = tid >> 3, lj = (tid & 7) * 8;
    const int sj = tid >> 3, sk = (tid & 7) * 8;
    for (int t = lblock(); t < ntiles; t += gridDim.x) {
        const int r0 = (t / ntk) << 6, k0 = (t % ntk) << 6;
        const int n0 = wmap(mode, r0 + lj), n7 = wmap(mode, r0 + lj + 7);
        const float* sp = src + (size_t)(k0 + lk) * N;
        if (n0 >= 0 && n7 == n0 + 7 && ((N & 3) == 0) && ((n0 & 3) == 0)) {
            const f32x4 a = *(const f32x4*)(sp + n0), b = *(const f32x4*)(sp + n0 + 4);
            tile[lk * 65 + lj] = a[0]; tile[lk * 65 + lj + 1] = a[1]; tile[lk * 65 + lj + 2] = a[2]; tile[lk * 65 + lj + 3] = a[3];
            tile[lk * 65 + lj + 4] = b[0]; tile[lk * 65 + lj + 5] = b[1]; tile[lk * 65 + lj + 6] = b[2]; tile[lk * 65 + lj + 7] = b[3];
        } else {
#pragma unroll
            for (int j = 0; j < 8; ++j) { const int n = wmap(mode, r0 + lj + j); tile[lk * 65 + lj + j] = (n >= 0) ? sp[n] : 0.f; }
        }
        __syncthreads();
        { u32x4 pk;
#pragma unroll
          for (int j2 = 0; j2 < 4; ++j2) pk[j2] = pk2(tile[(sk + 2 * j2) * 65 + sj], tile[(sk + 2 * j2 + 1) * 65 + sj]);
          *(u32x4*)(dst + (size_t)(r0 + sj) * K + k0 + sk) = pk; }
        __syncthreads();
    }
}
DI void convert_ffn(LAS unsigned char* lds, const Prm& p, int l, int f) {
    const int idx = l * 2 + f;
    convert_w(lds, p.ffn_gu + (size_t)idx * 1024 * 5632, 1024, 5632, (bf16_t*)(p.ws + OFF_WGU), 5632, WM_GU);
    convert_w(lds, p.ffn_dn + (size_t)idx * 2816 * 1024, 2816, 1024, (bf16_t*)(p.ws + OFF_WDN), 1024, WM_ID);
}

DI void mods_phase(LAS unsigned char* lds, const Prm& p) {
    LAS float* cact = (LAS float*)lds;
    LAS float* red = (LAS float*)(lds + 32768);
    const int tid = lthread();
    for (int i = tid; i < 8192; i += NTHREADS) cact[i] = silu_f(p.c[i]);
    __syncthreads();
    float* mods = (float*)(p.ws + OFF_MODS); float* kvm = (float*)(p.ws + OFF_KVMODS);
    for (int item = lblock(); item < 320; item += gridDim.x) {
        const int col0 = item * 64;
        const float* W; int N, cc; const float* bias; float* out; int obs;
        if (col0 < 18432) { const int l = col0 / 9216; cc = col0 - l * 9216; W = p.cond_w + (size_t)l * 1024 * 9216; N = 9216; bias = p.cond_b + l * 9216; out = mods + (size_t)l * 8 * 9216; obs = 9216; }
        else { cc = col0 - 18432; W = p.kv_cond_w; N = 2048; bias = p.kv_cond_b; out = kvm; obs = 2048; }
        const int j = tid & 63, kg = tid >> 6;
        float a0 = 0.f, a1 = 0.f, a2 = 0.f, a3 = 0.f, a4 = 0.f, a5 = 0.f, a6 = 0.f, a7 = 0.f;
        const float* wp = W + (size_t)(kg * 128) * N + cc + j;
#pragma unroll 4
        for (int k = 0; k < 128; ++k) { const float w = wp[(size_t)k * N]; const int kk = kg * 128 + k;
            a0 += cact[kk] * w; a1 += cact[1024 + kk] * w; a2 += cact[2048 + kk] * w; a3 += cact[3072 + kk] * w;
            a4 += cact[4096 + kk] * w; a5 += cact[5120 + kk] * w; a6 += cact[6144 + kk] * w; a7 += cact[7168 + kk] * w; }
        red[(kg * 8 + 0) * 64 + j] = a0; red[(kg * 8 + 1) * 64 + j] = a1; red[(kg * 8 + 2) * 64 + j] = a2; red[(kg * 8 + 3) * 64 + j] = a3;
        red[(kg * 8 + 4) * 64 + j] = a4; red[(kg * 8 + 5) * 64 + j] = a5; red[(kg * 8 + 6) * 64 + j] = a6; red[(kg * 8 + 7) * 64 + j] = a7;
        __syncthreads();
        { const int b = tid >> 6; float s = bias[cc + j];
#pragma unroll
          for (int q = 0; q < 8; ++q) s += red[(q * 8 + b) * 64 + j];
          out[(size_t)b * obs + cc + j] = s; }
        __syncthreads();
    }
}
DI void rope_tables(const Prm& p) {
    float* COS = (float*)(p.ws + OFF_COS); float* SIN = (float*)(p.ws + OFF_SIN);
    const int gt = lblock() * NTHREADS + lthread(), nth = gridDim.x * NTHREADS;
    for (int idx = gt; idx < T * 32; idx += nth) {
        const int t = idx >> 5, i = idx & 31;
        const float inv = powf(10000.f, -(float)(2 * i) / 64.f);
        const float ang = (float)p.pos[t] * inv;
        COS[idx] = cosf(ang); SIN[idx] = sinf(ang);
    }
}

struct RowP {
    const float* xin; const bf16_t* y; float* xout; float rw; const float* gate; int gate_bs; const float* g_post;
    const float* g1; const float* sh1; const float* sc1; int bs1; bf16_t* h1;
    const float* g2; const float* sh2; const float* sc2; int bs2; bf16_t* h2;
};
DI void rowwise_phase(const RowP& a) {
    const int tidx_ = lthread(); const int lane = tidx_ & 63, gw = lblock() * 8 + (tidx_ >> 6), nw = gridDim.x * 8;
    for (int row = gw; row < T; row += nw) {
        const int b = row >> 12;
        f32x4 xv[4];
#pragma unroll
        for (int i = 0; i < 4; ++i) xv[i] = *(const f32x4*)(a.xin + (size_t)row * D + i * 256 + lane * 4);
        if (a.y) {
            f32x4 yv[4]; float ss = 0.f;
#pragma unroll
            for (int i = 0; i < 4; ++i) { const u32x2 yr = *(const u32x2*)(a.y + (size_t)row * D + i * 256 + lane * 4);
                yv[i][0] = lo_f(yr[0]); yv[i][1] = hi_f(yr[0]); yv[i][2] = lo_f(yr[1]); yv[i][3] = hi_f(yr[1]);
                ss += yv[i][0] * yv[i][0] + yv[i][1] * yv[i][1] + yv[i][2] * yv[i][2] + yv[i][3] * yv[i][3]; }
            ss = wave_sum(ss);
            const float rstd = rsqrtf(ss * (1.f / D) + EPS) * a.rw;
#pragma unroll
            for (int i = 0; i < 4; ++i) { const int col = i * 256 + lane * 4;
                const f32x4 gt = *(const f32x4*)(a.gate + (size_t)b * a.gate_bs + col), gp = *(const f32x4*)(a.g_post + col);
                xv[i] = xv[i] + gt * (yv[i] * rstd) * gp;
                *(f32x4*)(a.xout + (size_t)row * D + col) = xv[i]; }
        }
        if (a.h1) {
            float ss = 0.f;
#pragma unroll
            for (int i = 0; i < 4; ++i) ss += xv[i][0] * xv[i][0] + xv[i][1] * xv[i][1] + xv[i][2] * xv[i][2] + xv[i][3] * xv[i][3];
            ss = wave_sum(ss);
            const float rstd = rsqrtf(ss * (1.f / D) + EPS);
#pragma unroll
            for (int i = 0; i < 4; ++i) { const int col = i * 256 + lane * 4;
                const f32x4 g = *(const f32x4*)(a.g1 + col), sc = *(const f32x4*)(a.sc1 + (size_t)b * a.bs1 + col), sh = *(const f32x4*)(a.sh1 + (size_t)b * a.bs1 + col);
                const f32x4 hv = (xv[i] * rstd) * g * (sc + 1.f) + sh;
                u32x2 pk; pk[0] = pk2(hv[0], hv[1]); pk[1] = pk2(hv[2], hv[3]);
                *(u32x2*)(a.h1 + (size_t)row * D + col) = pk; }
            if (a.h2) {
#pragma unroll
                for (int i = 0; i < 4; ++i) { const int col = i * 256 + lane * 4;
                    const f32x4 g = *(const f32x4*)(a.g2 + col), sc = *(const f32x4*)(a.sc2 + (size_t)b * a.bs2 + col), sh = *(const f32x4*)(a.sh2 + (size_t)b * a.bs2 + col);
                    const f32x4 hv = (xv[i] * rstd) * g * (sc + 1.f) + sh;
                    u32x2 pk; pk[0] = pk2(hv[0], hv[1]); pk[1] = pk2(hv[2], hv[3]);
                    *(u32x2*)(a.h2 + (size_t)row * D + col) = pk; }
            }
        }
    }
}

DI void ckv_phase(const Prm& p) {
    const float* raw = (const float*)(p.ws + OFF_Y); bf16_t* ckvn = (bf16_t*)(p.ws + OFF_CKVN); bf16_t* krope = (bf16_t*)(p.ws + OFF_KROPE);
    const float* COS = (const float*)(p.ws + OFF_COS); const float* SIN = (const float*)(p.ws + OFF_SIN);
    const int tidx_ = lthread(); const int lane = tidx_ & 63, gw = lblock() * 8 + (tidx_ >> 6), nw = gridDim.x * 8;
    for (int row = gw; row < T; row += nw) {
        const f32x4 v = *(const f32x4*)(raw + (size_t)row * 512 + lane * 4);
        float ss = wave_sum(v[0] * v[0] + v[1] * v[1] + v[2] * v[2] + v[3] * v[3]);
        const float rstd = rsqrtf(ss * (1.f / 256.f) + EPS);
        const f32x4 g = *(const f32x4*)(p.g_kv + lane * 4);
        u32x2 pk; pk[0] = pk2(v[0] * rstd * g[0], v[1] * rstd * g[1]); pk[1] = pk2(v[2] * rstd * g[2], v[3] * rstd * g[3]);
        *(u32x2*)(ckvn + (size_t)row * 256 + lane * 4) = pk;
        if (lane < 32) {
            const float x1 = raw[(size_t)row * 512 + 256 + lane], x2 = raw[(size_t)row * 512 + 288 + lane];
            const float c = COS[(size_t)row * 32 + lane], s = SIN[(size_t)row * 32 + lane];
            krope[(size_t)row * 64 + lane] = f2bf(x1 * c - x2 * s);
            krope[(size_t)row * 64 + 32 + lane] = f2bf(x1 * s + x2 * c);
        }
    }
}
DI void cq_phase(const Prm& p) {
    const float* raw = (const float*)(p.ws + OFF_Y); bf16_t* cqn = (bf16_t*)(p.ws + OFF_Y + (size_t)T * 512 * 4);
    const int tidx_ = lthread(); const int lane = tidx_ & 63, gw = lblock() * 8 + (tidx_ >> 6), nw = gridDim.x * 8;
    for (int row = gw; row < T; row += nw) {
        f32x2 v[3]; float ss = 0.f;
#pragma unroll
        for (int i = 0; i < 3; ++i) { v[i] = *(const f32x2*)(raw + (size_t)row * 512 + i * 128 + lane * 2); ss += v[i][0] * v[i][0] + v[i][1] * v[i][1]; }
        ss = wave_sum(ss);
        const float rstd = rsqrtf(ss * (1.f / 384.f) + EPS);
#pragma unroll
        for (int i = 0; i < 3; ++i) { const f32x2 g = *(const f32x2*)(p.g_q + i * 128 + lane * 2);
            *(unsigned*)(cqn + (size_t)row * 384 + i * 128 + lane * 2) = pk2(v[i][0] * rstd * g[0], v[i][1] * rstd * g[1]); }
    }
}
DI void gla_gate_phase(const Prm& p) {
    const float* og = (const float*)(p.ws + OFF_Y); const bf16_t* proj = (const bf16_t*)(p.ws + OFF_BIG); bf16_t* hout = (bf16_t*)(p.ws + OFF_H);
    const float* oint = (const float*)(p.ws + OFF_BIG);
    const int tidx_ = lthread(); const int lane = tidx_ & 63, gw = lblock() * 8 + (tidx_ >> 6), nw = gridDim.x * 8;
    for (int row = gw; row < T; row += nw) {
        f32x4 v[4]; float ss = 0.f;
#pragma unroll
        for (int i = 0; i < 4; ++i) { v[i] = *(const f32x4*)(og + (size_t)row * D + lane * 16 + i * 4) + *(const f32x4*)(oint + (size_t)row * 1664 + lane * 16 + i * 4);
            ss += v[i][0] * v[i][0] + v[i][1] * v[i][1] + v[i][2] * v[i][2] + v[i][3] * v[i][3]; }
#pragma unroll
        for (int o = 8; o > 0; o >>= 1) ss += __shfl_xor(ss, o);
        const float rstd = rsqrtf(ss * (1.f / 256.f) + EPS);
        const u32x4 r0 = *(const u32x4*)(proj + (size_t)row * 3328 + 2048 + lane * 16), r1 = *(const u32x4*)(proj + (size_t)row * 3328 + 2048 + lane * 16 + 8);
        const int gc = (lane & 15) * 16;
        u32x4 o0, o1;
#pragma unroll
        for (int i = 0; i < 4; ++i) {
            const f32x4 g = *(const f32x4*)(p.gla_g_out + gc + i * 4);
            const unsigned ra = (i < 2) ? r0[2 * i] : r1[2 * (i - 2)], rb = (i < 2) ? r0[2 * i + 1] : r1[2 * (i - 2) + 1];
            const float e0 = v[i][0] * rstd * g[0] * silu_f(lo_f(ra)), e1 = v[i][1] * rstd * g[1] * silu_f(hi_f(ra));
            const float e2 = v[i][2] * rstd * g[2] * silu_f(lo_f(rb)), e3 = v[i][3] * rstd * g[3] * silu_f(hi_f(rb));
            if (i < 2) { o0[2 * i] = pk2(e0, e1); o0[2 * i + 1] = pk2(e2, e3); } else { o1[2 * (i - 2)] = pk2(e0, e1); o1[2 * (i - 2) + 1] = pk2(e2, e3); }
        }
        *(u32x4*)(hout + (size_t)row * D + lane * 16) = o0; *(u32x4*)(hout + (size_t)row * D + lane * 16 + 8) = o1;
    }
}

DI bf16_t* gla_vt_ptr(unsigned char* ws, int ci) { return (bf16_t*)(ci < 1536 ? ws + OFF_VTA + (size_t)ci * 32768 : ws + OFF_CKVN + (size_t)(ci - 1536) * 32768); }
DI void gla_chunk_phase(LAS unsigned char* lds, const Prm& p) {
    const int tid = lthread(), wid = __builtin_amdgcn_readfirstlane(tid >> 6), lane = tid & 63, r = lane & 31, hf = lane >> 5;
    LAS float* GL = (LAS float*)(lds);
    LAS float* LA = (LAS float*)(lds + 4096);
    LAS unsigned char* ATT = lds + 4096;
    LAS float* SEG = (LAS float*)(lds + 36864);
    LAS float* BL = (LAS float*)(lds + 38912);
    LAS unsigned char* QD = lds + 39424;
    LAS unsigned char* KD = lds + 56832;
    LAS unsigned char* KUT = lds + 74240;
    LAS unsigned char* VTs = lds + 92672;
    const bf16_t* proj = (const bf16_t*)(p.ws + OFF_BIG); const float* glow = (const float*)(p.ws + OFF_GLOW); float* og = (float*)(p.ws + OFF_Y);
    bf16_t* QDg = (bf16_t*)(p.ws + OFF_H); bf16_t* KUTg = (bf16_t*)(p.ws + OFF_H + (size_t)2048 * 16384); float* DECg = (float*)(p.ws + OFF_DEC);
    const float qscale = 0.08838834764831845f;
    const int seg = tid >> 7, c = tid & 127;
    const int kp = tid >> 4, kc8 = tid & 15;
    const int vpp = tid >> 5, vc8 = tid & 31;
    const int grow = tid >> 2, gc4 = tid & 3;
    for (int ci = lblock(); ci < 2048; ci += gridDim.x) {
        const int b = ci >> 8, h = (ci >> 6) & 3, n = ci & 63;
        const size_t t0 = (size_t)b * SEQ + (size_t)n * 64;
        float wg[16];
#pragma unroll
        for (int q = 0; q < 16; ++q) wg[q] = p.gla_w_gate_up[q * 512 + h * 128 + c];
        const float bg = p.gla_b_gate[h * 128 + c];
        u32x4 qraw[2], kraw[2], vraw[4]; f32x4 glraw = {0.f, 0.f, 0.f, 0.f};
#pragma unroll
        for (int i = 0; i < 2; ++i) { const bf16_t* rp = proj + (t0 + 2 * kp + i) * 3328 + h * 128 + kc8 * 8; qraw[i] = *(const u32x4*)rp; kraw[i] = *(const u32x4*)(rp + 512); }
#pragma unroll
        for (int i = 0; i < 4; ++i) vraw[i] = *(const u32x4*)(proj + (t0 + 2 * vpp + (i & 1) + 32 * (i >> 1)) * 3328 + 1024 + h * 256 + vc8 * 8);
        if (tid < 256) glraw = *(const f32x4*)(glow + (t0 + grow) * 16 + gc4 * 4);
        if (tid < 256) *(LAS f32x4*)(GL + grow * 16 + gc4 * 4) = glraw;
        __syncthreads();
        float bs[16]; float run = 0.f;
#pragma unroll
        for (int i = 0; i < 16; ++i) { const int row = seg * 16 + i; float z = bg;
            const f32x4 g0 = *(const LAS f32x4*)(GL + row * 16), g1 = *(const LAS f32x4*)(GL + row * 16 + 4), g2 = *(const LAS f32x4*)(GL + row * 16 + 8), g3 = *(const LAS f32x4*)(GL + row * 16 + 12);
            z += g0[0] * wg[0] + g0[1] * wg[1] + g0[2] * wg[2] + g0[3] * wg[3] + g1[0] * wg[4] + g1[1] * wg[5] + g1[2] * wg[6] + g1[3] * wg[7]
               + g2[0] * wg[8] + g2[1] * wg[9] + g2[2] * wg[10] + g2[3] * wg[11] + g3[0] * wg[12] + g3[1] * wg[13] + g3[2] * wg[14] + g3[3] * wg[15];
            const float ls = fminf(z, 0.f) - __logf(1.f + __expf(-fabsf(z)));
            run += ls * 0.0625f; bs[i] = run; }
        SEG[seg * 128 + c] = run;
        __syncthreads();
        { float off = 0.f;
#pragma unroll
          for (int s = 0; s < 3; ++s) off += (s < seg) ? SEG[s * 128 + c] : 0.f;
#pragma unroll
          for (int i = 0; i < 16; ++i) LA[(seg * 16 + i) * 128 + c] = bs[i] + off;
          if (seg == 3) BL[c] = bs[15] + off; }
        __syncthreads();
        {
            const f32x4 l0 = *(const LAS f32x4*)(BL + kc8 * 8), l1 = *(const LAS f32x4*)(BL + kc8 * 8 + 4);
            f32x4 ba0 = *(const LAS f32x4*)(LA + (2 * kp) * 128 + kc8 * 8), ba1 = *(const LAS f32x4*)(LA + (2 * kp) * 128 + kc8 * 8 + 4);
            f32x4 bb0 = *(const LAS f32x4*)(LA + (2 * kp + 1) * 128 + kc8 * 8), bb1 = *(const LAS f32x4*)(LA + (2 * kp + 1) * 128 + kc8 * 8 + 4);
            u32x4 qd0, kd0, qd1, kd1;
            const int kcol = (kp ^ ((kc8 & 7) << 2)) * 4;
#pragma unroll
            for (int j2 = 0; j2 < 4; ++j2) {
                const float bl_a = (j2 < 2) ? l0[2 * j2] : l1[2 * (j2 - 2)], bl_b = (j2 < 2) ? l0[2 * j2 + 1] : l1[2 * (j2 - 2) + 1];
                const float a_a = (j2 < 2) ? ba0[2 * j2] : ba1[2 * (j2 - 2)], a_b = (j2 < 2) ? ba0[2 * j2 + 1] : ba1[2 * (j2 - 2) + 1];
                const float b_a = (j2 < 2) ? bb0[2 * j2] : bb1[2 * (j2 - 2)], b_b = (j2 < 2) ? bb0[2 * j2 + 1] : bb1[2 * (j2 - 2) + 1];
                const float q0a = lo_f(qraw[0][j2]), q0b = hi_f(qraw[0][j2]), k0a = lo_f(kraw[0][j2]), k0b = hi_f(kraw[0][j2]);
                const float q1a = lo_f(qraw[1][j2]), q1b = hi_f(qraw[1][j2]), k1a = lo_f(kraw[1][j2]), k1b = hi_f(kraw[1][j2]);
                qd0[j2] = pk2(q0a * qscale * __expf(a_a), q0b * qscale * __expf(a_b)); kd0[j2] = pk2(k0a * __expf(-a_a), k0b * __expf(-a_b));
                qd1[j2] = pk2(q1a * qscale * __expf(b_a), q1b * qscale * __expf(b_b)); kd1[j2] = pk2(k1a * __expf(-b_a), k1b * __expf(-b_b));
                *(LAS unsigned*)(KUT + (kc8 * 8 + 2 * j2) * 144 + kcol) = pk2(k0a * __expf(bl_a - a_a), k1a * __expf(bl_a - b_a));
                *(LAS unsigned*)(KUT + (kc8 * 8 + 2 * j2 + 1) * 144 + kcol) = pk2(k0b * __expf(bl_b - a_b), k1b * __expf(bl_b - b_b));
            }
            *(LAS u32x4*)(QD + ((2 * kp) * 136 + kc8 * 8) * 2) = qd0; *(LAS u32x4*)(KD + ((2 * kp) * 136 + kc8 * 8) * 2) = kd0;
            *(LAS u32x4*)(QD + ((2 * kp + 1) * 136 + kc8 * 8) * 2) = qd1; *(LAS u32x4*)(KD + ((2 * kp + 1) * 136 + kc8 * 8) * 2) = kd1;
        }
        {
            const int vcol0 = (vpp ^ ((vc8 & 7) << 2)) * 4, vcol1 = ((vpp + 16) ^ ((vc8 & 7) << 2)) * 4;
#pragma unroll
            for (int j2 = 0; j2 < 4; ++j2) {
                *(LAS unsigned*)(VTs + (vc8 * 8 + 2 * j2) * 144 + vcol0) = (vraw[0][j2] & 0xffffu) | (vraw[1][j2] << 16);
                *(LAS unsigned*)(VTs + (vc8 * 8 + 2 * j2 + 1) * 144 + vcol0) = (vraw[0][j2] >> 16) | (vraw[1][j2] & 0xffff0000u);
                *(LAS unsigned*)(VTs + (vc8 * 8 + 2 * j2) * 144 + vcol1) = (vraw[2][j2] & 0xffffu) | (vraw[3][j2] << 16);
                *(LAS unsigned*)(VTs + (vc8 * 8 + 2 * j2 + 1) * 144 + vcol1) = (vraw[2][j2] >> 16) | (vraw[3][j2] & 0xffff0000u); }
        }
        __syncthreads();
        if (wid < 4) {
            const int ti = wid >> 1, tj = wid & 1;
            f32x16 acc;
#pragma unroll
            for (int q = 0; q < 16; ++q) acc[q] = 0.f;
            if (tj <= ti) {
#pragma unroll
                for (int ks = 0; ks < 8; ++ks) {
                    const bf16x8 a = *(const LAS bf16x8*)(QD + ((32 * ti + r) * 136 + ks * 16 + 8 * hf) * 2);
                    const bf16x8 bb = *(const LAS bf16x8*)(KD + ((32 * tj + r) * 136 + ks * 16 + 8 * hf) * 2);
                    acc = MFMA32(a, bb, acc); }
            }
#pragma unroll
            for (int q = 0; q < 16; ++q) { const int i = 32 * ti + crow(q, hf), j = 32 * tj + r;
                const float v = (j <= i) ? acc[q] : 0.f;
                *(LAS bf16_t*)(ATT + (i * 72 + j) * 2) = f2bf(v); }
        }
        {
#pragma unroll
            for (int i = 0; i < 2; ++i) { const int e = tid + 512 * i, row = e >> 4, c8 = e & 15;
                *(u32x4*)(QDg + (size_t)ci * 8192 + row * 128 + c8 * 8) = *(const LAS u32x4*)(QD + (row * 136 + c8 * 8) * 2); }
#pragma unroll
            for (int i = 0; i < 2; ++i) { const int e = tid + 512 * i, row = e >> 3, c8 = e & 7;
                *(u32x4*)(KUTg + (size_t)ci * 8192 + row * 64 + c8 * 8) = *(const LAS u32x4*)(KUT + row * 144 + 16 * (c8 ^ ((row >> 3) & 7))); }
            bf16_t* vtg = gla_vt_ptr(p.ws, ci);
#pragma unroll
            for (int i = 0; i < 4; ++i) { const int e = tid + 512 * i, row = e >> 3, c8 = e & 7;
                *(u32x4*)(vtg + row * 64 + c8 * 8) = *(const LAS u32x4*)(VTs + row * 144 + 16 * (c8 ^ ((row >> 3) & 7))); }
            if (tid < 32) { const f32x4 bl = *(const LAS f32x4*)(BL + tid * 4); f32x4 d; d[0] = __expf(bl[0]); d[1] = __expf(bl[1]); d[2] = __expf(bl[2]); d[3] = __expf(bl[3]);
                *(f32x4*)(DECg + (size_t)ci * 128 + tid * 4) = d; }
        }
        __syncthreads();
        {
            f32x16 acc0, acc1;
#pragma unroll
            for (int q = 0; q < 16; ++q) { acc0[q] = 0.f; acc1[q] = 0.f; }
            const int dv = 32 * wid + r, sw = (dv >> 3) & 7;
#pragma unroll
            for (int ks = 0; ks < 4; ++ks) {
                const bf16x8 a0 = *(const LAS bf16x8*)(ATT + (r * 72 + ks * 16 + 8 * hf) * 2);
                const bf16x8 a1 = *(const LAS bf16x8*)(ATT + ((32 + r) * 72 + ks * 16 + 8 * hf) * 2);
                const bf16x8 bb = *(const LAS bf16x8*)(VTs + dv * 144 + 16 * ((2 * ks + hf) ^ sw));
                acc0 = MFMA32(a0, bb, acc0); acc1 = MFMA32(a1, bb, acc1); }
#pragma unroll
            for (int q = 0; q < 16; ++q) { og[(t0 + crow(q, hf)) * D + h * 256 + dv] = acc0[q]; og[(t0 + 32 + crow(q, hf)) * D + h * 256 + dv] = acc1[q]; }
        }
        __syncthreads();
    }
}

DI void gla_scan_phase(LAS unsigned char* lds, const Prm& p) {
    const int tid = lthread(), wid = __builtin_amdgcn_readfirstlane(tid >> 6), lane = tid & 63, r = lane & 31, hf = lane >> 5;
    constexpr int BUF = 36352;
    float* oint = (float*)(p.ws + OFF_BIG);
    const bf16_t* QDg = (const bf16_t*)(p.ws + OFF_H); const bf16_t* KUTg = (const bf16_t*)(p.ws + OFF_H + (size_t)2048 * 16384); const float* DECg = (const float*)(p.ws + OFF_DEC);
    for (int item = lblock(); item < 32; item += gridDim.x) {
        const int b = item >> 2, h = item & 3;
        const int ci0 = item * 64;
        const int dv = 32 * wid + r;
        f32x16 S[4];
#pragma unroll
        for (int t = 0; t < 4; ++t)
#pragma unroll
            for (int q = 0; q < 16; ++q) S[t][q] = 0.f;
        u32x4 sq[2], sk[2]; f32x4 sd = {0.f, 0.f, 0.f, 0.f}; bf16x8 vf[4], vfn[4];
        const int qrow = tid >> 4, qc8 = tid & 15;
        const int krow = tid >> 3, kc8 = tid & 7;
#define SCAN_LOAD(ci_) do { const bf16_t* qg_ = QDg + (size_t)(ci_) * 8192; const bf16_t* kg_ = KUTg + (size_t)(ci_) * 8192; \
        sq[0] = *(const u32x4*)(qg_ + qrow * 128 + qc8 * 8); sq[1] = *(const u32x4*)(qg_ + (qrow + 32) * 128 + qc8 * 8); \
        sk[0] = *(const u32x4*)(kg_ + krow * 64 + kc8 * 8); sk[1] = *(const u32x4*)(kg_ + (krow + 64) * 64 + kc8 * 8); \
        if (tid < 32) sd = *(const f32x4*)(DECg + (size_t)(ci_) * 128 + tid * 4); } while (0)
#define SCAN_STORE(buf_) do { LAS unsigned char* b_ = lds + (buf_) * BUF; \
        *(LAS u32x4*)(b_ + (qrow * 136 + qc8 * 8) * 2) = sq[0]; *(LAS u32x4*)(b_ + ((qrow + 32) * 136 + qc8 * 8) * 2) = sq[1]; \
        *(LAS u32x4*)(b_ + 17408 + (krow * 72 + kc8 * 8) * 2) = sk[0]; *(LAS u32x4*)(b_ + 17408 + ((krow + 64) * 72 + kc8 * 8) * 2) = sk[1]; \
        if (tid < 32) *(LAS f32x4*)(b_ + 35840 + tid * 16) = sd; } while (0)
#define SCAN_VLOAD(dst, ci_) do { const bf16_t* vg_ = gla_vt_ptr(p.ws, (ci_)) + dv * 64 + 8 * hf; \
        _Pragma("unroll") for (int ks = 0; ks < 4; ++ks) dst[ks] = *(const bf16x8*)(vg_ + ks * 16); } while (0)
        SCAN_LOAD(ci0); SCAN_VLOAD(vf, ci0); SCAN_STORE(0);
        __syncthreads();
        for (int n = 0; n < 64; ++n) {
            const int cur = n & 1;
            const bool more = (n + 1 < 64);
            if (more) { SCAN_LOAD(ci0 + n + 1); SCAN_VLOAD(vfn, ci0 + n + 1); }
            const LAS unsigned char* qb = lds + cur * BUF; const LAS unsigned char* kb = qb + 17408; const LAS float* db = (const LAS float*)(qb + 35840);
            const size_t t0 = (size_t)b * SEQ + (size_t)n * 64;
            float* op = oint + t0 * 1664 + h * 256 + dv;
            f32x16 a0, a1;
#pragma unroll
            for (int q = 0; q < 16; ++q) { a0[q] = 0.f; a1[q] = 0.f; }
#pragma unroll
            for (int t = 0; t < 4; ++t)
#pragma unroll
                for (int s = 0; s < 2; ++s) {
                    u32x4 sp;
#pragma unroll
                    for (int j2 = 0; j2 < 4; ++j2) sp[j2] = pk2(S[t][8 * s + 2 * j2], S[t][8 * s + 2 * j2 + 1]);
                    const int dk0 = 32 * t + 16 * s + 4 * hf;
                    const u32x2 l0 = *(const LAS u32x2*)(qb + (r * 136 + dk0) * 2), h0 = *(const LAS u32x2*)(qb + (r * 136 + dk0 + 8) * 2);
                    const u32x2 l1 = *(const LAS u32x2*)(qb + ((32 + r) * 136 + dk0) * 2), h1 = *(const LAS u32x2*)(qb + ((32 + r) * 136 + dk0 + 8) * 2);
                    u32x4 f0, f1; f0[0] = l0[0]; f0[1] = l0[1]; f0[2] = h0[0]; f0[3] = h0[1]; f1[0] = l1[0]; f1[1] = l1[1]; f1[2] = h1[0]; f1[3] = h1[1];
                    a0 = MFMA32(__builtin_bit_cast(bf16x8, f0), __builtin_bit_cast(bf16x8, sp), a0);
                    a1 = MFMA32(__builtin_bit_cast(bf16x8, f1), __builtin_bit_cast(bf16x8, sp), a1); }
#pragma unroll
            for (int q = 0; q < 16; ++q) { op[(size_t)crow(q, hf) * 1664] = a0[q]; op[(size_t)(32 + crow(q, hf)) * 1664] = a1[q]; }
#pragma unroll
            for (int t = 0; t < 4; ++t) {
#pragma unroll
                for (int g = 0; g < 4; ++g) { const f32x4 d4 = *(const LAS f32x4*)(db + 32 * t + 8 * g + 4 * hf);
                    S[t][4 * g] *= d4[0]; S[t][4 * g + 1] *= d4[1]; S[t][4 * g + 2] *= d4[2]; S[t][4 * g + 3] *= d4[3]; }
#pragma unroll
                for (int ks = 0; ks < 4; ++ks) {
                    const bf16x8 a = *(const LAS bf16x8*)(kb + ((32 * t + r) * 72 + ks * 16 + 8 * hf) * 2);
                    S[t] = MFMA32(a, vf[ks], S[t]); }
            }
            if (more) { SCAN_STORE(cur ^ 1);
#pragma unroll
                for (int ks = 0; ks < 4; ++ks) vf[ks] = vfn[ks]; }
            __syncthreads();
        }
#undef SCAN_LOAD
#undef SCAN_STORE
#undef SCAN_VLOAD
    }
}

DI void attn_phase(LAS unsigned char* lds, const Prm& p) {
    const int tid = lthread(), wid = __builtin_amdgcn_readfirstlane(tid >> 6), lane = tid & 63, r = lane & 31, hf = lane >> 5;
    constexpr int KT_STRIDE = 400, KT_BYTES = 64 * KT_STRIDE, VT_STRIDE = 144, VT_BYTES = 128 * VT_STRIDE;
    LAS unsigned char* KT = lds;
    LAS unsigned char* VT = lds + 2 * KT_BYTES;
    const bf16_t* Q = (const bf16_t*)(p.ws + OFF_BIG + (size_t)T * 2048 * 2); const bf16_t* KV = (const bf16_t*)(p.ws + OFF_BIG);
    const bf16_t* KR = (const bf16_t*)(p.ws + OFF_KROPE); bf16_t* AO = (bf16_t*)(p.ws + OFF_H);
    const float* COS = (const float*)(p.ws + OFF_COS); const float* SIN = (const float*)(p.ws + OFF_SIN);
    const float SC = 0.07216878364870322f * 1.4426950408889634f;
    for (int it = lblock(); it < 1024; it += gridDim.x) {
        const int pass = it >> 8, blk = it & 255, bh = blk & 63, g = blk >> 6;
        const int qt = (pass == 0) ? g : (pass == 1) ? 7 - g : (pass == 2) ? 8 + g : 15 - g;
        const int b = bh >> 3, h = bh & 7, q0 = qt * 256;
        const size_t tok0 = (size_t)b * SEQ;
        const int qpos = q0 + 32 * wid + r;
        const size_t qrow = tok0 + qpos;
        bf16x8 qf[12];
        { const bf16_t* qp = Q + qrow * 1536 + h * 192 + 8 * hf;
#pragma unroll
          for (int ks = 0; ks < 12; ++ks) qf[ks] = *(const bf16x8*)(qp + ks * 16);
#pragma unroll
          for (int pr = 0; pr < 2; ++pr) {
              const int i0 = 16 * pr + 8 * hf;
              const f32x4 c0 = *(const f32x4*)(COS + qrow * 32 + i0), c1 = *(const f32x4*)(COS + qrow * 32 + i0 + 4);
              const f32x4 s0 = *(const f32x4*)(SIN + qrow * 32 + i0), s1 = *(const f32x4*)(SIN + qrow * 32 + i0 + 4);
              bf16x8 x1v = qf[8 + pr], x2v = qf[10 + pr], o1, o2;
#pragma unroll
              for (int j = 0; j < 8; ++j) { const float cc = (j < 4) ? c0[j & 3] : c1[j & 3], ss = (j < 4) ? s0[j & 3] : s1[j & 3];
                  const float x1 = bf2f((unsigned short)x1v[j]), x2 = bf2f((unsigned short)x2v[j]);
                  o1[j] = (short)f2bf(x1 * cc - x2 * ss); o2[j] = (short)f2bf(x1 * ss + x2 * cc); }
              qf[8 + pr] = o1; qf[10 + pr] = o2; } }
        float m = -1e30f, l = 0.f;
        f32x16 O[4];
#pragma unroll
        for (int d = 0; d < 4; ++d)
#pragma unroll
            for (int q = 0; q < 16; ++q) O[d][q] = 0.f;
        const int nkt = 4 * (qt + 1);
        u32x4 kraw[3], vraw[2];
        const int kkey = tid >> 4, kc8 = tid & 15;
        const int rkey = tid >> 3, rc8 = tid & 7;
        const int vp = tid >> 4, vc8 = tid & 15;
        const int vrd0 = r * VT_STRIDE + 8 * ((hf) ^ (r >> 3)), vrd1 = r * VT_STRIDE + 8 * ((2 + hf) ^ (r >> 3));
const unsigned offk0 = (unsigned)(kkey * 2048 + kc8 * 8), offk1 = offk0 + 32u * 2048u, offr = (unsigned)(rkey * 64 + rc8 * 8);
        const unsigned offv0 = (unsigned)(2 * vp * 2048 + 128 + vc8 * 8), offv1 = offv0 + 2048u;
        const bf16_t* kvb0 = KV + tok0 * 2048 + h * 256; const bf16_t* krb0 = KR + tok0 * 64;
#define ATT_LOAD(kt_) do { const bf16_t* kvb_ = kvb0 + (size_t)(kt_) * 64 * 2048; const bf16_t* krb_ = krb0 + (size_t)(kt_) * 64 * 64; \
        kraw[0] = *(const u32x4*)(kvb_ + offk0); kraw[1] = *(const u32x4*)(kvb_ + offk1); \
        kraw[2] = *(const u32x4*)(krb_ + offr); \
        vraw[0] = *(const u32x4*)(kvb_ + offv0); vraw[1] = *(const u32x4*)(kvb_ + offv1); } while (0)
#define ATT_STORE(buf_) do { LAS unsigned char* kt_ = KT + (buf_) * KT_BYTES; LAS unsigned char* vt_ = VT + (buf_) * VT_BYTES; \
        *(LAS u32x4*)(kt_ + kkey * KT_STRIDE + kc8 * 16) = kraw[0]; *(LAS u32x4*)(kt_ + (kkey + 32) * KT_STRIDE + kc8 * 16) = kraw[1]; \
        *(LAS u32x4*)(kt_ + rkey * KT_STRIDE + 256 + rc8 * 16) = kraw[2]; \
        _Pragma("unroll") for (int j2 = 0; j2 < 4; ++j2) { \
            const unsigned lo_ = (vraw[0][j2] & 0xffffu) | (vraw[1][j2] << 16), hi_ = (vraw[0][j2] >> 16) | (vraw[1][j2] & 0xffff0000u); \
            *(LAS unsigned*)(vt_ + (vc8 * 8 + 2 * j2) * VT_STRIDE + 4 * (vp ^ (2 * vc8))) = lo_; \
            *(LAS unsigned*)(vt_ + (vc8 * 8 + 2 * j2 + 1) * VT_STRIDE + 4 * (vp ^ (2 * vc8))) = hi_; } } while (0)
        ATT_LOAD(0); ATT_STORE(0);
        __syncthreads();
        for (int kt = 0; kt < nkt; ++kt) {
            const int cur = kt & 1;
            const bool more = (kt + 1 < nkt);
            if (more) ATT_LOAD(kt + 1);
            const int kbase = kt * 64;
            if (kbase <= q0 + 32 * wid + 31) {
                const LAS unsigned char* ktb = KT + cur * KT_BYTES; const LAS unsigned char* vtb = VT + cur * VT_BYTES;
                f32x16 s0, s1;
#pragma unroll
                for (int q = 0; q < 16; ++q) { s0[q] = 0.f; s1[q] = 0.f; }
#pragma unroll
                for (int ks = 0; ks < 12; ++ks) {
                    const bf16x8 a0 = *(const LAS bf16x8*)(ktb + r * KT_STRIDE + ks * 32 + 16 * hf);
                    const bf16x8 a1 = *(const LAS bf16x8*)(ktb + (32 + r) * KT_STRIDE + ks * 32 + 16 * hf);
                    s0 = MFMA32(a0, qf[ks], s0); s1 = MFMA32(a1, qf[ks], s1);
                    }
                const bool diag = (kbase + 63 > q0 + 32 * wid);
                float mx = -1e30f;
#pragma unroll
                for (int q = 0; q < 16; ++q) {
                    float v0 = s0[q] * SC, v1 = s1[q] * SC;
                    if (diag) { const int key = kbase + crow(q, hf); if (key > qpos) v0 = -1e30f; if (key + 32 > qpos) v1 = -1e30f; }
                    s0[q] = v0; s1[q] = v1; mx = fmaxf(mx, fmaxf(v0, v1)); }
                mx = fmaxf(mx, __shfl_xor(mx, 32));
                const float mn = fmaxf(m, mx), alpha = __builtin_amdgcn_exp2f(m - mn);
                m = mn;
                float ls = 0.f;
#pragma unroll
                for (int q = 0; q < 16; ++q) { s0[q] = __builtin_amdgcn_exp2f(s0[q] - mn); s1[q] = __builtin_amdgcn_exp2f(s1[q] - mn); ls += s0[q] + s1[q]; }
                l = l * alpha + ls;
#pragma unroll
                for (int d = 0; d < 4; ++d)
#pragma unroll
                    for (int q = 0; q < 16; ++q) O[d][q] *= alpha;
                bf16x8 pb[2][2];
#pragma unroll
                for (int s = 0; s < 2; ++s) {
                    u32x4 t0, t1;
#pragma unroll
                    for (int j2 = 0; j2 < 4; ++j2) { t0[j2] = pk2(s0[8 * s + 2 * j2], s0[8 * s + 2 * j2 + 1]); t1[j2] = pk2(s1[8 * s + 2 * j2], s1[8 * s + 2 * j2 + 1]); }
                    pb[0][s] = __builtin_bit_cast(bf16x8, t0); pb[1][s] = __builtin_bit_cast(bf16x8, t1); }
#pragma unroll
                for (int d = 0; d < 4; ++d) {
#pragma unroll
                    for (int ksub = 0; ksub < 2; ++ksub)
#pragma unroll
                        for (int s = 0; s < 2; ++s) {
                            const int imm = d * 32 * VT_STRIDE + 32 * (((2 * ksub + s) ^ d) & 3);
                            const u32x2 lo = *(const LAS u32x2*)(vtb + vrd0 + imm);
                            const u32x2 hi = *(const LAS u32x2*)(vtb + vrd1 + imm);
                            u32x4 av; av[0] = lo[0]; av[1] = lo[1]; av[2] = hi[0]; av[3] = hi[1];
                            O[d] = MFMA32(__builtin_bit_cast(bf16x8, av), pb[ksub][s], O[d]); }
                }
            }
            if (more) ATT_STORE(cur ^ 1);
            __syncthreads();
        }
#undef ATT_LOAD
#undef ATT_STORE
        l += __shfl_xor(l, 32);
        const float inv = 1.f / l;
#pragma unroll
        for (int d = 0; d < 4; ++d)
#pragma unroll
            for (int g4 = 0; g4 < 4; ++g4) { u32x2 pk; pk[0] = pk2(O[d][4 * g4] * inv, O[d][4 * g4 + 1] * inv); pk[1] = pk2(O[d][4 * g4 + 2] * inv, O[d][4 * g4 + 3] * inv);
                *(u32x2*)(AO + qrow * D + h * 128 + 32 * d + 8 * g4 + 4 * hf) = pk; }
    }
}


#define XB_TMO      128
#define XB_XCNT(j)  (256  + 64 * (j))
#define XB_XSUB(j)  (1280 + 64 * (j))
#define XB_XGEN(j)  (2304 + 64 * (j))
#define XB_TOP      3328
#define XB_TOPGEN   3392
#define XCD_BAR_WORDS 3456
#define XB_SPIN_CAP (1u << 22)
DI unsigned xb_ld(unsigned* p)              { return __hip_atomic_load(p, __ATOMIC_RELAXED, __HIP_MEMORY_SCOPE_AGENT); }
DI unsigned xb_add(unsigned* p, unsigned v) { return __hip_atomic_fetch_add(p, v, __ATOMIC_RELAXED, __HIP_MEMORY_SCOPE_AGENT); }
DI unsigned xb_xcc_id() { return (unsigned)__builtin_amdgcn_s_getreg((3 << 11) | 20) & 0xFu; }
#define XB_SPIN(cond, bar) do { unsigned _sp = 0; while (cond) { __builtin_amdgcn_s_sleep(1); \
    if ((++_sp & 255u) == 0u) { if (xb_ld(&(bar)[XB_TMO])) break; if (_sp > XB_SPIN_CAP) { atomicAdd(&(bar)[XB_TMO], 1u); break; } } } } while (0)
struct XcdBarrier { unsigned* bar; unsigned x; volatile LAS unsigned* st; };
DI XcdBarrier xcd_barrier_post(unsigned* bar, volatile LAS unsigned* st) {
    XcdBarrier b; b.bar = bar; b.x = xb_xcc_id(); b.st = st;
    if (threadIdx.x == 0) (void)xb_add(&bar[XB_XCNT(b.x)], 1u);
    return b;
}
DI void xcd_barrier_complete(unsigned* bar, unsigned x, unsigned& nloc, unsigned& nx) {
    const unsigned G = gridDim.x * gridDim.y * gridDim.z;
    unsigned sum, cnt, mine, sp = 0u;
    for (;;) {
        sum = 0u; cnt = 0u; mine = 0u;
#pragma unroll
        for (unsigned j = 0; j < 16; ++j) { const unsigned c = xb_ld(&bar[XB_XCNT(j)]); sum += c; cnt += (c > 0u) ? 1u : 0u; mine = (j == x) ? c : mine; }
        if (sum == G) break;
        __builtin_amdgcn_s_sleep(1);
        if ((++sp & 255u) == 0u) { if (xb_ld(&bar[XB_TMO])) break; if (sp > XB_SPIN_CAP) { atomicAdd(&bar[XB_TMO], 1u); break; } }
    }
    nloc = mine > 0u ? mine : 1u; nx = cnt > 0u ? cnt : 1u;
}
DI void xcd_barrier(const XcdBarrier& b) {
    asm volatile("s_waitcnt vmcnt(0)" ::: "memory");
    __syncthreads();
    if (threadIdx.x == 0) {
        unsigned* bar = b.bar;
        __builtin_amdgcn_s_waitcnt(0);
        unsigned nloc = b.st[0], nx = b.st[1];
        if (nloc == 0u) { xcd_barrier_complete(bar, b.x, nloc, nx); b.st[0] = nloc; b.st[1] = nx; }
        const unsigned old = xb_add(&bar[XB_XSUB(b.x)], 1u);
        const unsigned gen = old / nloc;
        if (old + 1u == (gen + 1u) * nloc) {
            __builtin_amdgcn_fence(__ATOMIC_RELEASE, "agent");
            asm volatile("s_waitcnt vmcnt(0)" ::: "memory");
            const unsigned og = xb_add(&bar[XB_TOP], 1u);
            const unsigned tg = og / nx;
            if (og + 1u == (tg + 1u) * nx) xb_add(&bar[XB_TOPGEN], 1u);
            else XB_SPIN(xb_ld(&bar[XB_TOPGEN]) == tg, bar);
            __builtin_amdgcn_fence(__ATOMIC_ACQUIRE, "agent");
            xb_add(&bar[XB_XGEN(b.x)], 1u);
            asm volatile("s_waitcnt vmcnt(0)" ::: "memory");
        } else {
            XB_SPIN(xb_ld(&bar[XB_XGEN(b.x)]) == gen, bar);
            __builtin_amdgcn_fence(__ATOMIC_ACQUIRE, "agent");
            asm volatile("s_waitcnt vmcnt(0)" ::: "memory");
        }
    }
    __syncthreads();
}

__global__ void __launch_bounds__(NTHREADS) fwd_megakernel(Prm p) {
    extern __shared__ __attribute__((aligned(16))) unsigned char lds_raw[];
    LAS unsigned char* lds = (LAS unsigned char*)lds_raw;
    cg::grid_group grid = cg::this_grid();
    if (threadIdx.x < 4) ((LAS unsigned*)(lds + 131072))[threadIdx.x] = 0u;
    __syncthreads();
    XcdBarrier xbar = xcd_barrier_post((unsigned*)(p.ws + OFF_BAR), (volatile LAS unsigned*)(lds + 131072));
    unsigned char* ws = p.ws;
    float* mods = (float*)(ws + OFF_MODS); float* kvm = (float*)(ws + OFF_KVMODS);
    bf16_t* H = (bf16_t*)(ws + OFF_H); float* Y = (float*)(ws + OFF_Y); bf16_t* BIG = (bf16_t*)(ws + OFF_BIG);
    const int G = gridDim.x, cblk = lblock();
#pragma unroll 1
    for (int ph = p.ph_lo; ph < p.ph_hi; ++ph) {
#if DUP_MASK
      const int nrep = ((DUP_MASK >> ph) & 1u) ? 2 : 1;
#pragma unroll 1
      for (int rep = 0; rep < nrep; ++rep)
#endif
        switch (ph) {
        case PH_PRO: {
            mods_phase(lds, p);
            rope_tables(p);
            convert_w(lds, p.gla_w_in, 1024, 3088, (bf16_t*)(ws + OFF_WGIN), 3328, WM_GIN);
            convert_w(lds, p.gla_w_out, 1024, 1024, (bf16_t*)(ws + OFF_WGOUT), 1024, WM_ID);
            convert_w(lds, p.w_kv_a, 1024, 320, (bf16_t*)(ws + OFF_WKVA), 512, WM_LIM320);
            convert_w(lds, p.w_kv_b, 256, 2048, (bf16_t*)(ws + OFF_WKVB), 2048, WM_ID);
            convert_w(lds, p.w_dq, 1024, 384, (bf16_t*)(ws + OFF_WDQ), 512, WM_LIM384);
            convert_w(lds, p.w_uq, 384, 1536, (bf16_t*)(ws + OFF_WUQ), 1536, WM_ID);
            convert_w(lds, p.w_mout, 1024, 1024, (bf16_t*)(ws + OFF_WMOUT), 1024, WM_ID);
            convert_ffn(lds, p, 0, 0);
        } break;
        case PH_ROW0: case PH_ROW1: case PH_ROW2: case PH_ROW3: case PH_ROW4: case PH_ROW5: case PH_ROW6: {
            const int ps = (ph == PH_ROW0) ? -1 : (ph == PH_ROW1) ? 0 : (ph == PH_ROW2) ? 1 : (ph == PH_ROW3) ? 2 : (ph == PH_ROW4) ? 3 : (ph == PH_ROW5) ? 4 : 5;
            RowP a;
            a.xin = (ph <= PH_ROW1) ? p.x : p.out; a.y = nullptr; a.xout = p.out; a.rw = 0.f; a.gate = nullptr; a.gate_bs = 9216; a.g_post = nullptr;
            a.g1 = nullptr; a.sh1 = nullptr; a.sc1 = nullptr; a.bs1 = 9216; a.h1 = nullptr; a.g2 = nullptr; a.sh2 = nullptr; a.sc2 = nullptr; a.bs2 = 2048; a.h2 = nullptr;
            if (ps >= 0) { const int l = ps / 3, s = ps % 3; a.y = (const bf16_t*)Y; a.rw = (s == 1) ? 1.f : 0.5f;
                a.gate = mods + (size_t)l * 8 * 9216 + (3 * s + 2) * 1024; a.g_post = p.norm_g + ((l * 3 + s) * 2 + 1) * 1024; }
            const int pre = ps + 1;
            if (pre < 6) { const int l = pre / 3, s = pre % 3; a.h1 = H; a.g1 = p.norm_g + ((l * 3 + s) * 2) * 1024;
                a.sh1 = mods + (size_t)l * 8 * 9216 + (3 * s) * 1024; a.sc1 = mods + (size_t)l * 8 * 9216 + (3 * s + 1) * 1024; }
            if (ph == PH_ROW3) { a.h2 = BIG; a.g2 = p.kv_g_in; a.sh2 = kvm; a.sc2 = kvm + 1024; }
            rowwise_phase(a);
            if (ph == PH_ROW1) convert_ffn(lds, p, 0, 1);
            if (ph == PH_ROW3) convert_ffn(lds, p, 1, 0);
            if (ph == PH_ROW4) convert_ffn(lds, p, 1, 1);
        } break;
        case PH_A_G1: case PH_B_G1: case PH_C_G1: case PH_D_G1: {
            pg8::Gemm g{H, (const bf16_t*)(ws + OFF_WGU), T, 5632, 1024}; pg8::StaticOrder S; S.init(T, 5632, G, cblk);
            pg8::EpiSwiglu E{BIG};
            pg8::gemm_phase<pg8::EpiSwiglu>(lds, g, S, E);
        } break;
        case PH_KVA: {
            pg8::Gemm g{BIG, (const bf16_t*)(ws + OFF_WKVA), T, 512, 1024}; pg8::EpiF32 E{Y, 512}; pg8::StaticOrder S; S.init(T, 512, G, cblk);
            pg8::gemm_phase<pg8::EpiF32>(lds, g, S, E);
        } break;
        case PH_GIN: case PH_UQ: case PH_A_G2: case PH_B_G2: case PH_C_G2: case PH_D_G2: case PH_GOUT: case PH_MOUT: {
            pg8::Gemm g; pg8::EpiBf16 E;
            if (ph == PH_GIN) { g = pg8::Gemm{H, (const bf16_t*)(ws + OFF_WGIN), T, 3328, 1024}; E = pg8::EpiBf16{BIG, 3328, (float*)(ws + OFF_GLOW), 12}; }
            else if (ph == PH_UQ) { g = pg8::Gemm{(const bf16_t*)(ws + OFF_Y + (size_t)T * 512 * 4), (const bf16_t*)(ws + OFF_WUQ), T, 1536, 384}; E = pg8::EpiBf16{(bf16_t*)(ws + OFF_BIG + (size_t)T * 2048 * 2), 1536, nullptr, -1}; }
            else if (ph == PH_GOUT) { g = pg8::Gemm{H, (const bf16_t*)(ws + OFF_WGOUT), T, 1024, 1024}; E = pg8::EpiBf16{(bf16_t*)Y, 1024, nullptr, -1}; }
            else if (ph == PH_MOUT) { g = pg8::Gemm{H, (const bf16_t*)(ws + OFF_WMOUT), T, 1024, 1024}; E = pg8::EpiBf16{(bf16_t*)Y, 1024, nullptr, -1}; }
            else { g = pg8::Gemm{BIG, (const bf16_t*)(ws + OFF_WDN), T, 1024, 2816}; E = pg8::EpiBf16{(bf16_t*)Y, 1024, nullptr, -1}; }
            pg8::StaticOrder S; S.init(T, g.N, G, cblk);
            pg8::gemm_phase<pg8::EpiBf16>(lds, g, S, E);
        } break;
        case PH_GLA_CHUNK: gla_chunk_phase(lds, p); break;
        case PH_GLA_SCAN: gla_scan_phase(lds, p); break;
        case PH_GLA_GATE: gla_gate_phase(p); break;
        case PH_CKV: ckv_phase(p); break;
        case PH_DQ_KVB: {
            { pg8::Gemm g{H, (const bf16_t*)(ws + OFF_WDQ), T, 512, 1024}; pg8::EpiF32 E{Y, 512}; pg8::StaticOrder S; S.init(T, 512, G, cblk);
              pg8::gemm_phase<pg8::EpiF32>(lds, g, S, E); }
            { pg8::Gemm g{(const bf16_t*)(ws + OFF_CKVN), (const bf16_t*)(ws + OFF_WKVB), T, 2048, 256}; pg8::EpiBf16 E{BIG, 2048, nullptr, -1}; pg8::StaticOrder S; S.init(T, 2048, G, cblk);
              pg8::gemm_phase<pg8::EpiBf16>(lds, g, S, E); }
        } break;
        case PH_CQ: cq_phase(p); break;
        case PH_ATTN: attn_phase(lds, p); break;
        default: break;
        }
        if (ph + 1 < p.ph_hi) { if (p.ph_hi > NPH) grid.sync(); else xcd_barrier(xbar); }
    }
}

extern "C" void kernel_launch(void* const* d_in, const int* in_sizes, int n_in, void* d_out, int out_size, void* d_ws, size_t ws_size, hipStream_t stream) {
    static int grid_blocks = 0;
    if (grid_blocks == 0) {
        if (n_in != 23 || ws_size < WS_END) { fprintf(stderr, "kernel_launch: unexpected n_in %d / ws %zu (need %zu)\n", n_in, ws_size, (size_t)WS_END); grid_blocks = -1; return; }
        int dev = 0, cus = 0, per_cu = 0;
        (void)hipGetDevice(&dev);
        (void)hipDeviceGetAttribute(&cus, hipDeviceAttributeMultiprocessorCount, dev);
        if (hipFuncSetAttribute((const void*)fwd_megakernel, hipFuncAttributeMaxDynamicSharedMemorySize, LDS_BYTES) != hipSuccess) { fprintf(stderr, "kernel_launch: hipFuncSetAttribute failed\n"); grid_blocks = -1; return; }
        if (hipOccupancyMaxActiveBlocksPerMultiprocessor(&per_cu, (const void*)fwd_megakernel, NTHREADS, LDS_BYTES) != hipSuccess || per_cu < 1) { fprintf(stderr, "kernel_launch: occupancy query says %d\n", per_cu); per_cu = 1; }
        (void)hipGetLastError();
        grid_blocks = cus * 1;
        fprintf(stderr, "kernel_launch: cus %d per_cu %d grid %d\n", cus, per_cu, grid_blocks);
    }
    if (grid_blocks < 0) return;
    Prm p{};
    p.x = (const float*)d_in[0]; p.c = (const float*)d_in[1]; p.pos = (const int*)d_in[2]; p.cond_w = (const float*)d_in[3]; p.cond_b = (const float*)d_in[4];
    p.norm_g = (const float*)d_in[5]; p.ffn_gu = (const float*)d_in[6]; p.ffn_dn = (const float*)d_in[7]; p.gla_w_in = (const float*)d_in[8];
    p.gla_w_gate_up = (const float*)d_in[9]; p.gla_b_gate = (const float*)d_in[10]; p.gla_g_out = (const float*)d_in[11]; p.gla_w_out = (const float*)d_in[12];
    p.kv_g_in = (const float*)d_in[13]; p.kv_cond_w = (const float*)d_in[14]; p.kv_cond_b = (const float*)d_in[15]; p.w_kv_a = (const float*)d_in[16];
    p.g_kv = (const float*)d_in[17]; p.w_kv_b = (const float*)d_in[18]; p.w_dq = (const float*)d_in[19]; p.g_q = (const float*)d_in[20];
    p.w_uq = (const float*)d_in[21]; p.w_mout = (const float*)d_in[22];
    p.out = (float*)d_out; p.ws = (unsigned char*)d_ws;
    (void)hipMemsetAsync((unsigned char*)d_ws + OFF_BAR, 0, 16384, stream);
#if MULTI_LAUNCH
    for (int ph = 0; ph < NPH; ++ph) {
        p.ph_lo = ph; p.ph_hi = ph + 1;
        hipLaunchKernelGGL(fwd_megakernel, dim3(grid_blocks), dim3(NTHREADS), LDS_BYTES, stream, p);
    }
#else
    p.ph_lo = 0; p.ph_hi = NPH;
    void* args[] = {&p};
    hipError_t e = hipLaunchCooperativeKernel((const void*)fwd_megakernel, dim3(grid_blocks), dim3(NTHREADS), args, LDS_BYTES, stream);
    if (e != hipSuccess) fprintf(stderr, "cooperative launch failed: %s (grid %d)\n", hipGetErrorString(e), grid_blocks);
#endif
}
```

```cpp
#include <hip/hip_runtime.h>
#include <hip/hip_cooperative_groups.h>
#include <cstdio>
namespace cg = cooperative_groups;

#define LAS __attribute__((address_space(3)))
#define DI __device__ __forceinline__
typedef unsigned short bf16_t;
typedef short bf16x8 __attribute__((ext_vector_type(8)));
typedef float f32x2 __attribute__((ext_vector_type(2)));
typedef float f32x4 __attribute__((ext_vector_type(4)));
typedef float f32x16 __attribute__((ext_vector_type(16)));
typedef unsigned u32x2 __attribute__((ext_vector_type(2)));
typedef unsigned u32x4 __attribute__((ext_vector_type(4)));
typedef __bf16 bf16v2 __attribute__((ext_vector_type(2)));

#ifndef MULTI_LAUNCH
#define MULTI_LAUNCH 0
#endif
#ifndef DUP_MASK
#define DUP_MASK 0u
#endif

constexpr int T = 32768, D = 1024, SEQ = 4096, NB = 8, DFF = 2816;
constexpr int NTHREADS = 512;
constexpr int LDS_BYTES = 131072 + 16;
constexpr float EPS = 1e-6f;
enum { PH_PRO = 0, PH_ROW0, PH_A_G1, PH_A_G2, PH_ROW1, PH_GIN, PH_GLA_CHUNK, PH_GLA_SCAN, PH_GLA_GATE, PH_GOUT, PH_ROW2, PH_B_G1, PH_B_G2, PH_ROW3,
       PH_KVA, PH_C_G1, PH_C_G2, PH_ROW4, PH_DQ_KVB, PH_CQ, PH_UQ, PH_ATTN, PH_MOUT, PH_ROW5, PH_D_G1, PH_D_G2, PH_ROW6, NPH };

constexpr size_t SZ_WGU = (size_t)5632 * 1024 * 2, SZ_WDN = (size_t)1024 * 2816 * 2, SZ_WGIN = (size_t)3328 * 1024 * 2;
constexpr size_t OFF_BAR = 0;
constexpr size_t OFF_WGU = 16384;
constexpr size_t OFF_WDN = OFF_WGU + SZ_WGU;
constexpr size_t OFF_WGIN = OFF_WDN + SZ_WDN;
constexpr size_t OFF_WGOUT = OFF_WGIN + SZ_WGIN;
constexpr size_t OFF_WKVA = OFF_WGOUT + (size_t)1024 * 1024 * 2;
constexpr size_t OFF_WKVB = OFF_WKVA + (size_t)512 * 1024 * 2;
constexpr size_t OFF_WDQ = OFF_WKVB + (size_t)2048 * 256 * 2;
constexpr size_t OFF_WUQ = OFF_WDQ + (size_t)512 * 1024 * 2;
constexpr size_t OFF_WMOUT = OFF_WUQ + (size_t)1536 * 384 * 2;
constexpr size_t OFF_MODS = OFF_WMOUT + (size_t)1024 * 1024 * 2;
constexpr size_t OFF_KVMODS = OFF_MODS + (size_t)2 * 8 * 9216 * 4;
constexpr size_t OFF_COS = OFF_KVMODS + (size_t)8 * 2048 * 4;
constexpr size_t OFF_SIN = OFF_COS + (size_t)T * 32 * 4;
constexpr size_t OFF_GLOW = OFF_SIN + (size_t)T * 32 * 4;
constexpr size_t OFF_CKVN = OFF_GLOW + (size_t)T * 16 * 4;
constexpr size_t OFF_KROPE = OFF_CKVN + (size_t)T * 256 * 2;
constexpr size_t OFF_H = OFF_KROPE + (size_t)T * 64 * 2;
constexpr size_t OFF_Y = OFF_H + (size_t)T * 1024 * 2;
constexpr size_t OFF_BIG = OFF_Y + (size_t)T * 1024 * 4;
constexpr size_t SZ_BIG = (size_t)T * 2048 * 2 + (size_t)T * 1536 * 2;
constexpr size_t OFF_VTA = OFF_BIG + (size_t)T * 3328 * 2;
constexpr size_t OFF_DEC = OFF_VTA + (size_t)1536 * 32768;
constexpr size_t WS_END = (OFF_DEC + (size_t)2048 * 512 > OFF_BIG + SZ_BIG) ? OFF_DEC + (size_t)2048 * 512 : OFF_BIG + SZ_BIG;
static_assert(WS_END <= (size_t)536870912, "workspace");
static_assert(SZ_BIG >= (size_t)T * 3328 * 2 && SZ_BIG >= (size_t)T * 2816 * 2, "big");

struct Prm {
    const float* x; const float* c; const int* pos; const float* cond_w; const float* cond_b; const float* norm_g;
    const float* ffn_gu; const float* ffn_dn; const float* gla_w_in; const float* gla_w_gate_up; const float* gla_b_gate;
    const float* gla_g_out; const float* gla_w_out; const float* kv_g_in; const float* kv_cond_w; const float* kv_cond_b;
    const float* w_kv_a; const float* g_kv; const float* w_kv_b; const float* w_dq; const float* g_q; const float* w_uq; const float* w_mout;
    float* out; unsigned char* ws; int ph_lo, ph_hi;
};

DI float bf2f(unsigned short b) { return __uint_as_float(((unsigned)b) << 16); }
DI unsigned pk2(float lo, float hi) { f32x2 v = {lo, hi}; bf16v2 b = __builtin_convertvector(v, bf16v2); return __builtin_bit_cast(unsigned, b); }
DI bf16_t f2bf(float f) { return (bf16_t)(pk2(f, 0.f) & 0xffffu); }
DI float lo_f(unsigned u) { return __uint_as_float(u << 16); }
DI float hi_f(unsigned u) { return __uint_as_float(u & 0xffff0000u); }
DI float wave_sum(float v) {
#pragma unroll
    for (int o = 32; o > 0; o >>= 1) v += __shfl_xor(v, o);
    return v;
}
DI float silu_f(float v) { return v / (1.f + __expf(-v)); }
DI int crow(int reg, int hf) { return (reg & 3) + 8 * (reg >> 2) + 4 * hf; }
DI int lthread() { int t = threadIdx.x; asm volatile("" : "+v"(t)); return t; }
DI int lblock() { int t = blockIdx.x; asm volatile("" : "+s"(t)); return t; }
#define MFMA32(a, b, c) __builtin_amdgcn_mfma_f32_32x32x16_bf16((a), (b), (c), 0, 0, 0)

namespace pg8 {
constexpr int BM = 256, BK = 64, HALF = 128, HTB = HALF * BK * 2, STAGE_BYTES = 8 * HTB, NXCD = 8, WGM = 8;
DI int lds_byte(int r, int c) { const int st = (r >> 4) * 2 + (c >> 5), rr = r & 15, cc = c & 31, ob = rr * 64 + cc * 2; return st * 1024 + (ob ^ (((ob >> 9) & 1) << 5)); }
DI void stage_rc(int b, int& R, int& C) { const int st = b / 1024, sb = b % 1024, swz = sb ^ (((sb >> 9) & 1) << 5); R = (st >> 1) * 16 + swz / 64; C = (st & 1) * 32 + (swz % 64) / 2; }
DI int perm32(int rho) { const int n = rho >> 4, i = rho & 15; return 8 * (i >> 2) + 4 * n + (i & 3); }

struct Unit { int pm, pn; };
struct Gemm { const bf16_t* A; const bf16_t* Bt; int M, N, K; };

struct StaticOrder {
    int nM, nN, nwg, G, c;
    DI void init(int M, int N, int G_, int c_) { nM = M / BM; nN = N / BM; nwg = nM * nN; G = G_; c = c_; }
    DI bool next(int i, Unit& u) const {
        const long L = (long)i * G + c; if (L >= nwg) return false;
        int wgid = (int)L; { const int q = nwg / NXCD, r = nwg % NXCD, xcd = wgid % NXCD, off = wgid / NXCD; wgid = (xcd < r ? xcd * (q + 1) : r * (q + 1) + (xcd - r) * q) + off; }
        const int nig = WGM * nN, gid = wgid / nig, fm = gid * WGM, gsz = (nM - fm) < WGM ? (nM - fm) : WGM;
        u.pm = fm + ((wgid % nig) % gsz); u.pn = (wgid % nig) / gsz; return true;
    }
};

struct EpiF32 {
    static constexpr bool PERM = false;
    float* C; int ldc;
    DI void operator()(const f32x4 (&acc)[2][2][4][2], const Unit& u, int wr, int wc, int fr, int fq) const {
        const int row0 = u.pm * BM + wr * 64 + fr, col0 = u.pn * BM + wc * 32 + 4 * fq;
#pragma unroll
        for (int ai = 0; ai < 2; ++ai)
#pragma unroll
            for (int m = 0; m < 4; ++m) { float* rowp = C + (size_t)(row0 + ai * HALF + m * 16) * ldc + col0;
#pragma unroll
                for (int bj = 0; bj < 2; ++bj)
#pragma unroll
                    for (int n = 0; n < 2; ++n) *(f32x4*)(rowp + bj * HALF + n * 16) = acc[ai][bj][m][n]; }
    }
};
struct EpiBf16 {
    static constexpr bool PERM = true;
    bf16_t* O; int ldc; float* glow; int glow_pn;
    DI void operator()(const f32x4 (&acc)[2][2][4][2], const Unit& u, int wr, int wc, int fr, int fq) const {
        const int row0 = u.pm * BM + wr * 64 + fr, col0 = u.pn * BM + wc * 32 + 8 * fq;
        const bool gl = (glow != nullptr) && (u.pn == glow_pn) && (wc == 0) && (fq < 2);
#pragma unroll
        for (int ai = 0; ai < 2; ++ai)
#pragma unroll
            for (int m = 0; m < 4; ++m) { const int row = row0 + ai * HALF + m * 16; bf16_t* rowp = O + (size_t)row * ldc + col0;
#pragma unroll
                for (int bj = 0; bj < 2; ++bj) { const f32x4 v0 = acc[ai][bj][m][0], v1 = acc[ai][bj][m][1];
                    u32x4 pk; pk[0] = pk2(v0[0], v0[1]); pk[1] = pk2(v0[2], v0[3]); pk[2] = pk2(v1[0], v1[1]); pk[3] = pk2(v1[2], v1[3]);
                    *(u32x4*)(rowp + bj * HALF) = pk;
                    if (bj == 0 && gl) { *(f32x4*)(glow + (size_t)row * 16 + 8 * fq) = v0; *(f32x4*)(glow + (size_t)row * 16 + 8 * fq + 4) = v1; } } }
    }
};
struct EpiSwiglu {
    static constexpr bool PERM = true;
    bf16_t* O;
    DI void operator()(const f32x4 (&acc)[2][2][4][2], const Unit& u, int wr, int wc, int fr, int fq) const {
        const int row0 = u.pm * BM + wr * 64 + fr, col0 = u.pn * HALF + wc * 32 + 8 * fq;
#pragma unroll
        for (int ai = 0; ai < 2; ++ai)
#pragma unroll
            for (int m = 0; m < 4; ++m) { bf16_t* rowp = O + (size_t)(row0 + ai * HALF + m * 16) * DFF + col0;
                const f32x4 g0 = acc[ai][0][m][0], g1 = acc[ai][0][m][1], u0 = acc[ai][1][m][0], u1 = acc[ai][1][m][1];
                u32x4 pk;
                pk[0] = pk2(silu_f(g0[0]) * u0[0], silu_f(g0[1]) * u0[1]); pk[1] = pk2(silu_f(g0[2]) * u0[2], silu_f(g0[3]) * u0[3]);
                pk[2] = pk2(silu_f(g1[0]) * u1[0], silu_f(g1[1]) * u1[1]); pk[3] = pk2(silu_f(g1[2]) * u1[2], silu_f(g1[3]) * u1[3]);
                *(u32x4*)rowp = pk; }
    }
};

template <class Epi>
DI void gemm_phase(LAS unsigned char* lds, const Gemm g, const StaticOrder& S, const Epi& E) {
    const int tid = lthread(), wid = __builtin_amdgcn_readfirstlane(tid >> 6), lane = tid & 63, wr = wid >> 2, wc = wid & 3, fr = lane & 15, fq = lane >> 4;
    const int K = g.K, nt = K / BK;
    unsigned voffA[2], voffB[2];
#pragma unroll
    for (int i = 0; i < 2; ++i) { int R, C; stage_rc(tid * 16 + i * 8192, R, C); const int Rb = Epi::PERM ? ((R & ~31) + perm32(R & 31)) : R;
        voffA[i] = (unsigned)(R * K + C) * 2u; voffB[i] = (unsigned)(Rb * K + C) * 2u; }
    const size_t kstep = (size_t)(BK * 2);
    const size_t hstep = (size_t)HALF * K * 2;
    const size_t tstep = 2 * hstep;
    const unsigned ldsw = (unsigned)wid * 1024u;
    const int aoff = lds_byte(wr * 64 + fr, fq * 8), boff = lds_byte(wc * 32 + fr, fq * 8);
#define PG8_SA(b, h) (((b) * 2 + (h)) * HTB)
#define PG8_SB(b, h) ((4 + (b) * 2 + (h)) * HTB)
#define PG8_STAGE(bufoff, gbase, voff) do { _Pragma("unroll") for (int _i = 0; _i < 2; ++_i) \
        __builtin_amdgcn_global_load_lds((const unsigned*)((const char*)(gbase) + (voff)[_i]), (LAS unsigned*)(lds + (bufoff) + ldsw + _i * 8192), 16, 0, 0); } while (0)
#define PG8_LDA(dst, b, h) do { _Pragma("unroll") for (int m = 0; m < 4; ++m) _Pragma("unroll") for (int k = 0; k < 2; ++k) dst[m][k] = *(const LAS bf16x8*)(lds + PG8_SA(b, h) + aoff + m * 2048 + k * 1024); } while (0)
#define PG8_LDB(dst, b, h) do { _Pragma("unroll") for (int n = 0; n < 2; ++n) _Pragma("unroll") for (int k = 0; k < 2; ++k) dst[n][k] = *(const LAS bf16x8*)(lds + PG8_SB(b, h) + boff + n * 2048 + k * 1024); } while (0)
#define PG8_MMA(ai, bj, At, Bt) do { __builtin_amdgcn_s_setprio(1); _Pragma("unroll") for (int m = 0; m < 4; ++m) _Pragma("unroll") for (int n = 0; n < 2; ++n) _Pragma("unroll") for (int k = 0; k < 2; ++k) \
        acc[ai][bj][m][n] = __builtin_amdgcn_mfma_f32_16x16x32_bf16(Bt[n][k], At[m][k], acc[ai][bj][m][n], 0, 0, 0); __builtin_amdgcn_s_setprio(0); } while (0)
#define PG8_WAIT_V(n) asm volatile("s_waitcnt vmcnt(" #n ")" ::: "memory")
#define PG8_WAIT_L(n) asm volatile("s_waitcnt lgkmcnt(" #n ")" ::: "memory")
#define PG8_BAR __builtin_amdgcn_s_barrier()
#define PG8_SCHED __builtin_amdgcn_sched_barrier(0)
    Unit cur, nxt; int ui = 0;
    if (!S.next(0, cur)) return;
    f32x4 acc[2][2][4][2];
#pragma unroll
    for (int a = 0; a < 2; ++a)
#pragma unroll
        for (int b = 0; b < 2; ++b)
#pragma unroll
            for (int m = 0; m < 4; ++m)
#pragma unroll
                for (int n = 0; n < 2; ++n) acc[a][b][m][n] = (f32x4){0.f, 0.f, 0.f, 0.f};
    bf16x8 At[4][2], B0[2][2], B1[2][2];
    const char* cA = (const char*)g.A + (size_t)cur.pm * tstep; const char* cB = (const char*)g.Bt + (size_t)cur.pn * tstep;
    PG8_STAGE(PG8_SB(0, 0), cB, voffB); PG8_STAGE(PG8_SA(0, 0), cA, voffA); PG8_STAGE(PG8_SB(0, 1), cB + hstep, voffB); PG8_STAGE(PG8_SA(0, 1), cA + hstep, voffA);
    if (wr == 1) PG8_BAR;
    PG8_WAIT_V(4); PG8_BAR;
    PG8_STAGE(PG8_SB(1, 0), cB + kstep, voffB); PG8_STAGE(PG8_SA(1, 0), cA + kstep, voffA); PG8_STAGE(PG8_SB(1, 1), cB + hstep + kstep, voffB);
    PG8_WAIT_V(6); PG8_BAR;
    for (;;) {
        const bool has_next = S.next(ui + 1, nxt);
        const char* nA = has_next ? (const char*)g.A + (size_t)nxt.pm * tstep : cA; const char* nB = has_next ? (const char*)g.Bt + (size_t)nxt.pn * tstep : cB;
        for (int t = 0; t < nt; t += 2) {
            const bool last = (t == nt - 2);
            const char* a1 = cA + (size_t)(t + 1) * kstep;
            const char* a2 = last ? nA : cA + (size_t)(t + 2) * kstep; const char* b2 = last ? nB : cB + (size_t)(t + 2) * kstep;
            const char* a3 = a2 + kstep; const char* b3 = b2 + kstep;
            PG8_LDB(B0, 0, 0); PG8_SCHED; PG8_LDA(At, 0, 0); PG8_STAGE(PG8_SA(1, 1), a1 + hstep, voffA);
            PG8_WAIT_L(8); PG8_BAR; PG8_WAIT_L(0); PG8_MMA(0, 0, At, B0); PG8_BAR; PG8_SCHED;
            PG8_LDB(B1, 0, 1); PG8_STAGE(PG8_SB(0, 0), b2, voffB);
            PG8_BAR; PG8_WAIT_L(0); PG8_MMA(0, 1, At, B1); PG8_BAR;
            PG8_LDA(At, 0, 1); PG8_STAGE(PG8_SA(0, 0), a2, voffA);
            PG8_BAR; PG8_WAIT_L(0); PG8_MMA(1, 0, At, B0); PG8_BAR; PG8_SCHED;
            PG8_STAGE(PG8_SB(0, 1), b2 + hstep, voffB);
            PG8_WAIT_V(6); PG8_BAR; PG8_MMA(1, 1, At, B1); PG8_BAR;
            PG8_LDB(B0, 1, 0); PG8_SCHED; PG8_LDA(At, 1, 0); PG8_STAGE(PG8_SA(0, 1), a2 + hstep, voffA);
            PG8_WAIT_L(8); PG8_BAR; PG8_WAIT_L(0); PG8_MMA(0, 0, At, B0); PG8_BAR; PG8_SCHED;
            PG8_LDB(B1, 1, 1); PG8_STAGE(PG8_SB(1, 0), b3, voffB);
            PG8_BAR; PG8_WAIT_L(0); PG8_MMA(0, 1, At, B1); PG8_BAR;
            PG8_LDA(At, 1, 1); PG8_STAGE(PG8_SA(1, 0), a3, voffA);
            PG8_BAR; PG8_WAIT_L(0); PG8_MMA(1, 0, At, B0); PG8_BAR; PG8_SCHED;
            PG8_STAGE(PG8_SB(1, 1), b3 + hstep, voffB);
            PG8_WAIT_V(6); PG8_BAR; PG8_MMA(1, 1, At, B1); PG8_BAR;
        }
        E(acc, cur, wr, wc, fr, fq);
        if (!has_next) break;
#pragma unroll
        for (int a = 0; a < 2; ++a)
#pragma unroll
            for (int b = 0; b < 2; ++b)
#pragma unroll
                for (int m = 0; m < 4; ++m)
#pragma unroll
                    for (int n = 0; n < 2; ++n) acc[a][b][m][n] = (f32x4){0.f, 0.f, 0.f, 0.f};
        cur = nxt; cA = nA; cB = nB; ++ui;
    }
    PG8_WAIT_V(0);
    if (wr == 0) PG8_BAR;
    PG8_BAR;
#undef PG8_SA
#undef PG8_SB
#undef PG8_STAGE
#undef PG8_LDA
#undef PG8_LDB
#undef PG8_MMA
#undef PG8_WAIT_V
#undef PG8_WAIT_L
#undef PG8_BAR
#undef PG8_SCHED
}
}

enum { WM_ID = 0, WM_GU, WM_GIN, WM_LIM320, WM_LIM384 };
DI int wmap(int mode, int r) {
    switch (mode) {
        case WM_GU: { const int t = r >> 8, w = r & 255; return w < 128 ? t * 128 + w : DFF + t * 128 + (w - 128); }
        case WM_GIN: return r < 2048 ? r : (r < 3072 ? r + 16 : (r < 3088 ? r - 1024 : -1));
        case WM_LIM320: return r < 320 ? r : -1;
        case WM_LIM384: return r < 384 ? r : -1;
        default: return r;
    }
}
DI void convert_w(LAS unsigned char* lds, const float* __restrict__ src, int K, int N, bf16_t* __restrict__ dst, int Nd, int mode) {
    LAS float* tile = (LAS float*)lds;
    const int tid = lthread(), ntk = K >> 6, ntiles = (Nd >> 6) * ntk;
    const int lk = tid >> 3, lj = (tid & 7) * 8;
    const int sj = tid >> 3, sk = (tid & 7) * 8;
    for (int t = lblock(); t < ntiles; t += gridDim.x) {
        const int r0 = (t / ntk) << 6, k0 = (t % ntk) << 6;
        const int n0 = wmap(mode, r0 + lj), n7 = wmap(mode, r0 + lj + 7);
        const float* sp = src + (size_t)(k0 + lk) * N;
        if (n0 >= 0 && n7 == n0 + 7 && ((N & 3) == 0) && ((n0 & 3) == 0)) {
            const f32x4 a = *(const f32x4*)(sp + n0), b = *(const f32x4*)(sp + n0 + 4);
            tile[lk * 65 + lj] = a[0]; tile[lk * 65 + lj + 1] = a[1]; tile[lk * 65 + lj + 2] = a[2]; tile[lk * 65 + lj + 3] = a[3];
            tile[lk * 65 + lj + 4] = b[0]; tile[lk * 65 + lj + 5] = b[1]; tile[lk * 65 + lj + 6] = b[2]; tile[lk * 65 + lj + 7] = b[3];
        } else {
#pragma unroll
            for (int j = 0; j < 8; ++j) { const int n = wmap(mode, r0 + lj + j); tile[lk * 65 + lj + j] = (n >= 0) ? sp[n] : 0.f; }
        }
        __syncthreads();
        { u32x4 pk;
#pragma unroll
          for (int j2 = 0; j2 < 4; ++j2) pk[j2] = pk2(tile[(sk + 2 * j2) * 65 + sj], tile[(sk + 2 * j2 + 1) * 65 + sj]);
          *(u32x4*)(dst + (size_t)(r0 + sj) * K + k0 + sk) = pk; }
        __syncthreads();
    }
}
DI void convert_ffn(LAS unsigned char* lds, const Prm& p, int l, int f) {
    const int idx = l * 2 + f;
    convert_w(lds, p.ffn_gu + (size_t)idx * 1024 * 5632, 1024, 5632, (bf16_t*)(p.ws + OFF_WGU), 5632, WM_GU);
    convert_w(lds, p.ffn_dn + (size_t)idx * 2816 * 1024, 2816, 1024, (bf16_t*)(p.ws + OFF_WDN), 1024, WM_ID);
}

DI void mods_phase(LAS unsigned char* lds, const Prm& p) {
    LAS float* cact = (LAS float*)lds;
    LAS float* red = (LAS float*)(lds + 32768);
    const int tid = lthread();
    for (int i = tid; i < 8192; i += NTHREADS) cact[i] = silu_f(p.c[i]);
    __syncthreads();
    float* mods = (float*)(p.ws + OFF_MODS); float* kvm = (float*)(p.ws + OFF_KVMODS);
    for (int item = lblock(); item < 320; item += gridDim.x) {
        const int col0 = item * 64;
        const float* W; int N, cc; const float* bias; float* out; int obs;
        if (col0 < 18432) { const int l = col0 / 9216; cc = col0 - l * 9216; W = p.cond_w + (size_t)l * 1024 * 9216; N = 9216; bias = p.cond_b + l * 9216; out = mods + (size_t)l * 8 * 9216; obs = 9216; }
        else { cc = col0 - 18432; W = p.kv_cond_w; N = 2048; bias = p.kv_cond_b; out = kvm; obs = 2048; }
        const int j = tid & 63, kg = tid >> 6;
        float a0 = 0.f, a1 = 0.f, a2 = 0.f, a3 = 0.f, a4 = 0.f, a5 = 0.f, a6 = 0.f, a7 = 0.f;
        const float* wp = W + (size_t)(kg * 128) * N + cc + j;
#pragma unroll 4
        for (int k = 0; k < 128; ++k) { const float w = wp[(size_t)k * N]; const int kk = kg * 128 + k;
            a0 += cact[kk] * w; a1 += cact[1024 + kk] * w; a2 += cact[2048 + kk] * w; a3 += cact[3072 + kk] * w;
            a4 += cact[4096 + kk] * w; a5 += cact[5120 + kk] * w; a6 += cact[6144 + kk] * w; a7 += cact[7168 + kk] * w; }
        red[(kg * 8 + 0) * 64 + j] = a0; red[(kg * 8 + 1) * 64 + j] = a1; red[(kg * 8 + 2) * 64 + j] = a2; red[(kg * 8 + 3) * 64 + j] = a3;
        red[(kg * 8 + 4) * 64 + j] = a4; red[(kg * 8 + 5) * 64 + j] = a5; red[(kg * 8 + 6) * 64 + j] = a6; red[(kg * 8 + 7) * 64 + j] = a7;
        __syncthreads();
        { const int b = tid >> 6; float s = bias[cc + j];
#pragma unroll
          for (int q = 0; q < 8; ++q) s += red[(q * 8 + b) * 64 + j];
          out[(size_t)b * obs + cc + j] = s; }
        __syncthreads();
    }
}
DI void rope_tables(const Prm& p) {
    float* COS = (float*)(p.ws + OFF_COS); float* SIN = (float*)(p.ws + OFF_SIN);
    const int gt = lblock() * NTHREADS + lthread(), nth = gridDim.x * NTHREADS;
    for (int idx = gt; idx < T * 32; idx += nth) {
        const int t = idx >> 5, i = idx & 31;
        const float inv = powf(10000.f, -(float)(2 * i) / 64.f);
        const float ang = (float)p.pos[t] * inv;
        COS[idx] = cosf(ang); SIN[idx] = sinf(ang);
    }
}

struct RowP {
    const float* xin; const bf16_t* y; float* xout; float rw; const float* gate; int gate_bs; const float* g_post;
    const float* g1; const float* sh1; const float* sc1; int bs1; bf16_t* h1;
    const float* g2; const float* sh2; const float* sc2; int bs2; bf16_t* h2;
};
DI void rowwise_phase(const RowP& a) {
    const int tidx_ = lthread(); const int lane = tidx_ & 63, gw = lblock() * 8 + (tidx_ >> 6), nw = gridDim.x * 8;
    for (int row = gw; row < T; row += nw) {
        const int b = row >> 12;
        f32x4 xv[4];
#pragma unroll
        for (int i = 0; i < 4; ++i) xv[i] = *(const f32x4*)(a.xin + (size_t)row * D + i * 256 + lane * 4);
        if (a.y) {
            f32x4 yv[4]; float ss = 0.f;
#pragma unroll
            for (int i = 0; i < 4; ++i) { const u32x2 yr = *(const u32x2*)(a.y + (size_t)row * D + i * 256 + lane * 4);
                yv[i][0] = lo_f(yr[0]); yv[i][1] = hi_f(yr[0]); yv[i][2] = lo_f(yr[1]); yv[i][3] = hi_f(yr[1]);
                ss += yv[i][0] * yv[i][0] + yv[i][1] * yv[i][1] + yv[i][2] * yv[i][2] + yv[i][3] * yv[i][3]; }
            ss = wave_sum(ss);
            const float rstd = rsqrtf(ss * (1.f / D) + EPS) * a.rw;
#pragma unroll
            for (int i = 0; i < 4; ++i) { const int col = i * 256 + lane * 4;
                const f32x4 gt = *(const f32x4*)(a.gate + (size_t)b * a.gate_bs + col), gp = *(const f32x4*)(a.g_post + col);
                xv[i] = xv[i] + gt * (yv[i] * rstd) * gp;
                *(f32x4*)(a.xout + (size_t)row * D + col) = xv[i]; }
        }
        if (a.h1) {
            float ss = 0.f;
#pragma unroll
            for (int i = 0; i < 4; ++i) ss += xv[i][0] * xv[i][0] + xv[i][1] * xv[i][1] + xv[i][2] * xv[i][2] + xv[i][3] * xv[i][3];
            ss = wave_sum(ss);
            const float rstd = rsqrtf(ss * (1.f / D) + EPS);
#pragma unroll
            for (int i = 0; i < 4; ++i) { const int col = i * 256 + lane * 4;
                const f32x4 g = *(const f32x4*)(a.g1 + col), sc = *(const f32x4*)(a.sc1 + (size_t)b * a.bs1 + col), sh = *(const f32x4*)(a.sh1 + (size_t)b * a.bs1 + col);
                const f32x4 hv = (xv[i] * rstd) * g * (sc + 1.f) + sh;
                u32x2 pk; pk[0] = pk2(hv[0], hv[1]); pk[1] = pk2(hv[2], hv[3]);
                *(u32x2*)(a.h1 + (size_t)row * D + col) = pk; }
            if (a.h2) {
#pragma unroll
                for (int i = 0; i < 4; ++i) { const int col = i * 256 + lane * 4;
                    const f32x4 g = *(const f32x4*)(a.g2 + col), sc = *(const f32x4*)(a.sc2 + (size_t)b * a.bs2 + col), sh = *(const f32x4*)(a.sh2 + (size_t)b * a.bs2 + col);
                    const f32x4 hv = (xv[i] * rstd) * g * (sc + 1.f) + sh;
                    u32x2 pk; pk[0] = pk2(hv[0], hv[1]); pk[1] = pk2(hv[2], hv[3]);
                    *(u32x2*)(a.h2 + (size_t)row * D + col) = pk; }
            }
        }
    }
}

DI void ckv_phase(const Prm& p) {
    const float* raw = (const float*)(p.ws + OFF_Y); bf16_t* ckvn = (bf16_t*)(p.ws + OFF_CKVN); bf16_t* krope = (bf16_t*)(p.ws + OFF_KROPE);
    const float* COS = (const float*)(p.ws + OFF_COS); const float* SIN = (const float*)(p.ws + OFF_SIN);
    const int tidx_ = lthread(); const int lane = tidx_ & 63, gw = lblock() * 8 + (tidx_ >> 6), nw = gridDim.x * 8;
    for (int row = gw; row < T; row += nw) {
        const f32x4 v = *(const f32x4*)(raw + (size_t)row * 512 + lane * 4);
        float ss = wave_sum(v[0] * v[0] + v[1] * v[1] + v[2] * v[2] + v[3] * v[3]);
        const float rstd = rsqrtf(ss * (1.f / 256.f) + EPS);
        const f32x4 g = *(const f32x4*)(p.g_kv + lane * 4);
        u32x2 pk; pk[0] = pk2(v[0] * rstd * g[0], v[1] * rstd * g[1]); pk[1] = pk2(v[2] * rstd * g[2], v[3] * rstd * g[3]);
        *(u32x2*)(ckvn + (size_t)row * 256 + lane * 4) = pk;
        if (lane < 32) {
            const float x1 = raw[(size_t)row * 512 + 256 + lane], x2 = raw[(size_t)row * 512 + 288 + lane];
            const float c = COS[(size_t)row * 32 + lane], s = SIN[(size_t)row * 32 + lane];
            krope[(size_t)row * 64 + lane] = f2bf(x1 * c - x2 * s);
            krope[(size_t)row * 64 + 32 + lane] = f2bf(x1 * s + x2 * c);
        }
    }
}
DI void cq_phase(const Prm& p) {
    const float* raw = (const float*)(p.ws + OFF_Y); bf16_t* cqn = (bf16_t*)(p.ws + OFF_Y + (size_t)T * 512 * 4);
    const int tidx_ = lthread(); const int lane = tidx_ & 63, gw = lblock() * 8 + (tidx_ >> 6), nw = gridDim.x * 8;
    for (int row = gw; row < T; row += nw) {
        f32x2 v[3]; float ss = 0.f;
#pragma unroll
        for (int i = 0; i < 3; ++i) { v[i] = *(const f32x2*)(raw + (size_t)row * 512 + i * 128 + lane * 2); ss += v[i][0] * v[i][0] + v[i][1] * v[i][1]; }
        ss = wave_sum(ss);
        const float rstd = rsqrtf(ss * (1.f / 384.f) + EPS);
#pragma unroll
        for (int i = 0; i < 3; ++i) { const f32x2 g = *(const f32x2*)(p.g_q + i * 128 + lane * 2);
            *(unsigned*)(cqn + (size_t)row * 384 + i * 128 + lane * 2) = pk2(v[i][0] * rstd * g[0], v[i][1] * rstd * g[1]); }
    }
}
DI void gla_gate_phase(const Prm& p) {
    const float* og = (const float*)(p.ws + OFF_Y); const bf16_t* proj = (const bf16_t*)(p.ws + OFF_BIG); bf16_t* hout = (bf16_t*)(p.ws + OFF_H);
    const float* oint = (const float*)(p.ws + OFF_BIG);
    const int tidx_ = lthread(); const int lane = tidx_ & 63, gw = lblock() * 8 + (tidx_ >> 6), nw = gridDim.x * 8;
    for (int row = gw; row < T; row += nw) {
        f32x4 v[4]; float ss = 0.f;
#pragma unroll
        for (int i = 0; i < 4; ++i) { v[i] = *(const f32x4*)(og + (size_t)row * D + lane * 16 + i * 4) + *(const f32x4*)(oint + (size_t)row * 1664 + lane * 16 + i * 4);
            ss += v[i][0] * v[i][0] + v[i][1] * v[i][1] + v[i][2] * v[i][2] + v[i][3] * v[i][3]; }
#pragma unroll
        for (int o = 8; o > 0; o >>= 1) ss += __shfl_xor(ss, o);
        const float rstd = rsqrtf(ss * (1.f / 256.f) + EPS);
        const u32x4 r0 = *(const u32x4*)(proj + (size_t)row * 3328 + 2048 + lane * 16), r1 = *(const u32x4*)(proj + (size_t)row * 3328 + 2048 + lane * 16 + 8);
        const int gc = (lane & 15) * 16;
        u32x4 o0, o1;
#pragma unroll
        for (int i = 0; i < 4; ++i) {
            const f32x4 g = *(const f32x4*)(p.gla_g_out + gc + i * 4);
            const unsigned ra = (i < 2) ? r0[2 * i] : r1[2 * (i - 2)], rb = (i < 2) ? r0[2 * i + 1] : r1[2 * (i - 2) + 1];
            const float e0 = v[i][0] * rstd * g[0] * silu_f(lo_f(ra)), e1 = v[i][1] * rstd * g[1] * silu_f(hi_f(ra));
            const float e2 = v[i][2] * rstd * g[2] * silu_f(lo_f(rb)), e3 = v[i][3] * rstd * g[3] * silu_f(hi_f(rb));
            if (i < 2) { o0[2 * i] = pk2(e0, e1); o0[2 * i + 1] = pk2(e2, e3); } else { o1[2 * (i - 2)] = pk2(e0, e1); o1[2 * (i - 2) + 1] = pk2(e2, e3); }
        }
        *(u32x4*)(hout + (size_t)row * D + lane * 16) = o0; *(u32x4*)(hout + (size_t)row * D + lane * 16 + 8) = o1;
    }
}

DI bf16_t* gla_vt_ptr(unsigned char* ws, int ci) { return (bf16_t*)(ci < 1536 ? ws + OFF_VTA + (size_t)ci * 32768 : ws + OFF_CKVN + (size_t)(ci - 1536) * 32768); }
DI void gla_chunk_phase(LAS unsigned char* lds, const Prm& p) {
    const int tid = lthread(), wid = __builtin_amdgcn_readfirstlane(tid >> 6), lane = tid & 63, r = lane & 31, hf = lane >> 5;
    LAS float* GL = (LAS float*)(lds);
    LAS float* LA = (LAS float*)(lds + 4096);
    LAS unsigned char* ATT = lds + 4096;
    LAS float* SEG = (LAS float*)(lds + 36864);
    LAS float* BL = (LAS float*)(lds + 38912);
    LAS unsigned char* QD = lds + 39424;
    LAS unsigned char* KD = lds + 56832;
    LAS unsigned char* KUT = lds + 74240;
    LAS unsigned char* VTs = lds + 92672;
    const bf16_t* proj = (const bf16_t*)(p.ws + OFF_BIG); const float* glow = (const float*)(p.ws + OFF_GLOW); float* og = (float*)(p.ws + OFF_Y);
    bf16_t* QDg = (bf16_t*)(p.ws + OFF_H); bf16_t* KUTg = (bf16_t*)(p.ws + OFF_H + (size_t)2048 * 16384); float* DECg = (float*)(p.ws + OFF_DEC);
    const float qscale = 0.08838834764831845f;
    const int seg = tid >> 7, c = tid & 127;
    const int kp = tid >> 4, kc8 = tid & 15;
    const int vpp = tid >> 5, vc8 = tid & 31;
    const int grow = tid >> 2, gc4 = tid & 3;
    for (int ci = lblock(); ci < 2048; ci += gridDim.x) {
        const int b = ci >> 8, h = (ci >> 6) & 3, n = ci & 63;
        const size_t t0 = (size_t)b * SEQ + (size_t)n * 64;
        float wg[16];
#pragma unroll
        for (int q = 0; q < 16; ++q) wg[q] = p.gla_w_gate_up[q * 512 + h * 128 + c];
        const float bg = p.gla_b_gate[h * 128 + c];
        u32x4 qraw[2], kraw[2], vraw[4]; f32x4 glraw = {0.f, 0.f, 0.f, 0.f};
#pragma unroll
        for (int i = 0; i < 2; ++i) { const bf16_t* rp = proj + (t0 + 2 * kp + i) * 3328 + h * 128 + kc8 * 8; qraw[i] = *(const u32x4*)rp; kraw[i] = *(const u32x4*)(rp + 512); }
#pragma unroll
        for (int i = 0; i < 4; ++i) vraw[i] = *(const u32x4*)(proj + (t0 + 2 * vpp + (i & 1) + 32 * (i >> 1)) * 3328 + 1024 + h * 256 + vc8 * 8);
        if (tid < 256) glraw = *(const f32x4*)(glow + (t0 + grow) * 16 + gc4 * 4);
        if (tid < 256) *(LAS f32x4*)(GL + grow * 16 + gc4 * 4) = glraw;
        __syncthreads();
        float bs[16]; float run = 0.f;
#pragma unroll
        for (int i = 0; i < 16; ++i) { const int row = seg * 16 + i; float z = bg;
            const f32x4 g0 = *(const LAS f32x4*)(GL + row * 16), g1 = *(const LAS f32x4*)(GL + row * 16 + 4), g2 = *(const LAS f32x4*)(GL + row * 16 + 8), g3 = *(const LAS f32x4*)(GL + row * 16 + 12);
            z += g0[0] * wg[0] + g0[1] * wg[1] + g0[2] * wg[2] + g0[3] * wg[3] + g1[0] * wg[4] + g1[1] * wg[5] + g1[2] * wg[6] + g1[3] * wg[7]
               + g2[0] * wg[8] + g2[1] * wg[9] + g2[2] * wg[10] + g2[3] * wg[11] + g3[0] * wg[12] + g3[1] * wg[13] + g3[2] * wg[14] + g3[3] * wg[15];
            const float ls = fminf(z, 0.f) - __logf(1.f + __expf(-fabsf(z)));
            run += ls * 0.0625f; bs[i] = run; }
        SEG[seg * 128 + c] = run;
        __syncthreads();
        { float off = 0.f;
#pragma unroll
          for (int s = 0; s < 3; ++s) off += (s < seg) ? SEG[s * 128 + c] : 0.f;
#pragma unroll
          for (int i = 0; i < 16; ++i) LA[(seg * 16 + i) * 128 + c] = bs[i] + off;
          if (seg == 3) BL[c] = bs[15] + off; }
        __syncthreads();
        {
            const f32x4 l0 = *(const LAS f32x4*)(BL + kc8 * 8), l1 = *(const LAS f32x4*)(BL + kc8 * 8 + 4);
            f32x4 ba0 = *(const LAS f32x4*)(LA + (2 * kp) * 128 + kc8 * 8), ba1 = *(const LAS f32x4*)(LA + (2 * kp) * 128 + kc8 * 8 + 4);
            f32x4 bb0 = *(const LAS f32x4*)(LA + (2 * kp + 1) * 128 + kc8 * 8), bb1 = *(const LAS f32x4*)(LA + (2 * kp + 1) * 128 + kc8 * 8 + 4);
            u32x4 qd0, kd0, qd1, kd1;
            const int kcol = (kp ^ ((kc8 & 7) << 2)) * 4;
#pragma unroll
            for (int j2 = 0; j2 < 4; ++j2) {
                const float bl_a = (j2 < 2) ? l0[2 * j2] : l1[2 * (j2 - 2)], bl_b = (j2 < 2) ? l0[2 * j2 + 1] : l1[2 * (j2 - 2) + 1];
                const float a_a = (j2 < 2) ? ba0[2 * j2] : ba1[2 * (j2 - 2)], a_b = (j2 < 2) ? ba0[2 * j2 + 1] : ba1[2 * (j2 - 2) + 1];
                const float b_a = (j2 < 2) ? bb0[2 * j2] : bb1[2 * (j2 - 2)], b_b = (j2 < 2) ? bb0[2 * j2 + 1] : bb1[2 * (j2 - 2) + 1];
                const float q0a = lo_f(qraw[0][j2]), q0b = hi_f(qraw[0][j2]), k0a = lo_f(kraw[0][j2]), k0b = hi_f(kraw[0][j2]);
                const float q1a = lo_f(qraw[1][j2]), q1b = hi_f(qraw[1][j2]), k1a = lo_f(kraw[1][j2]), k1b = hi_f(kraw[1][j2]);
                qd0[j2] = pk2(q0a * qscale * __expf(a_a), q0b * qscale * __expf(a_b)); kd0[j2] = pk2(k0a * __expf(-a_a), k0b * __expf(-a_b));
                qd1[j2] = pk2(q1a * qscale * __expf(b_a), q1b * qscale * __expf(b_b)); kd1[j2] = pk2(k1a * __expf(-b_a), k1b * __expf(-b_b));
                *(LAS unsigned*)(KUT + (kc8 * 8 + 2 * j2) * 144 + kcol) = pk2(k0a * __expf(bl_a - a_a), k1a * __expf(bl_a - b_a));
                *(LAS unsigned*)(KUT + (kc8 * 8 + 2 * j2 + 1) * 144 + kcol) = pk2(k0b * __expf(bl_b - a_b), k1b * __expf(bl_b - b_b));
            }
            *(LAS u32x4*)(QD + ((2 * kp) * 136 + kc8 * 8) * 2) = qd0; *(LAS u32x4*)(KD + ((2 * kp) * 136 + kc8 * 8) * 2) = kd0;
            *(LAS u32x4*)(QD + ((2 * kp + 1) * 136 + kc8 * 8) * 2) = qd1; *(LAS u32x4*)(KD + ((2 * kp + 1) * 136 + kc8 * 8) * 2) = kd1;
        }
        {
            const int vcol0 = (vpp ^ ((vc8 & 7) << 2)) * 4, vcol1 = ((vpp + 16) ^ ((vc8 & 7) << 2)) * 4;
#pragma unroll
            for (int j2 = 0; j2 < 4; ++j2) {
                *(LAS unsigned*)(VTs + (vc8 * 8 + 2 * j2) * 144 + vcol0) = (vraw[0][j2] & 0xffffu) | (vraw[1][j2] << 16);
                *(LAS unsigned*)(VTs + (vc8 * 8 + 2 * j2 + 1) * 144 + vcol0) = (vraw[0][j2] >> 16) | (vraw[1][j2] & 0xffff0000u);
                *(LAS unsigned*)(VTs + (vc8 * 8 + 2 * j2) * 144 + vcol1) = (vraw[2][j2] & 0xffffu) | (vraw[3][j2] << 16);
                *(LAS unsigned*)(VTs + (vc8 * 8 + 2 * j2 + 1) * 144 + vcol1) = (vraw[2][j2] >> 16) | (vraw[3][j2] & 0xffff0000u); }
        }
        __syncthreads();
        if (wid < 4) {
            const int ti = wid >> 1, tj = wid & 1;
            f32x16 acc;
#pragma unroll
            for (int q = 0; q < 16; ++q) acc[q] = 0.f;
            if (tj <= ti) {
#pragma unroll
                for (int ks = 0; ks < 8; ++ks) {
                    const bf16x8 a = *(const LAS bf16x8*)(QD + ((32 * ti + r) * 136 + ks * 16 + 8 * hf) * 2);
                    const bf16x8 bb = *(const LAS bf16x8*)(KD + ((32 * tj + r) * 136 + ks * 16 + 8 * hf) * 2);
                    acc = MFMA32(a, bb, acc); }
            }
#pragma unroll
            for (int q = 0; q < 16; ++q) { const int i = 32 * ti + crow(q, hf), j = 32 * tj + r;
                const float v = (j <= i) ? acc[q] : 0.f;
                *(LAS bf16_t*)(ATT + (i * 72 + j) * 2) = f2bf(v); }
        }
        {
#pragma unroll
            for (int i = 0; i < 2; ++i) { const int e = tid + 512 * i, row = e >> 4, c8 = e & 15;
                *(u32x4*)(QDg + (size_t)ci * 8192 + row * 128 + c8 * 8) = *(const LAS u32x4*)(QD + (row * 136 + c8 * 8) * 2); }
#pragma unroll
            for (int i = 0; i < 2; ++i) { const int e = tid + 512 * i, row = e >> 3, c8 = e & 7;
                *(u32x4*)(KUTg + (size_t)ci * 8192 + row * 64 + c8 * 8) = *(const LAS u32x4*)(KUT + row * 144 + 16 * (c8 ^ ((row >> 3) & 7))); }
            bf16_t* vtg = gla_vt_ptr(p.ws, ci);
#pragma unroll
            for (int i = 0; i < 4; ++i) { const int e = tid + 512 * i, row = e >> 3, c8 = e & 7;
                *(u32x4*)(vtg + row * 64 + c8 * 8) = *(const LAS u32x4*)(VTs + row * 144 + 16 * (c8 ^ ((row >> 3) & 7))); }
            if (tid < 32) { const f32x4 bl = *(const LAS f32x4*)(BL + tid * 4); f32x4 d; d[0] = __expf(bl[0]); d[1] = __expf(bl[1]); d[2] = __expf(bl[2]); d[3] = __expf(bl[3]);
                *(f32x4*)(DECg + (size_t)ci * 128 + tid * 4) = d; }
        }
        __syncthreads();
        {
            f32x16 acc0, acc1;
#pragma unroll
            for (int q = 0; q < 16; ++q) { acc0[q] = 0.f; acc1[q] = 0.f; }
            const int dv = 32 * wid + r, sw = (dv >> 3) & 7;
#pragma unroll
            for (int ks = 0; ks < 4; ++ks) {
                const bf16x8 a0 = *(const LAS bf16x8*)(ATT + (r * 72 + ks * 16 + 8 * hf) * 2);
                const bf16x8 a1 = *(const LAS bf16x8*)(ATT + ((32 + r) * 72 + ks * 16 + 8 * hf) * 2);
                const bf16x8 bb = *(const LAS bf16x8*)(VTs + dv * 144 + 16 * ((2 * ks + hf) ^ sw));
                acc0 = MFMA32(a0, bb, acc0); acc1 = MFMA32(a1, bb, acc1); }
#pragma unroll
            for (int q = 0; q < 16; ++q) { og[(t0 + crow(q, hf)) * D + h * 256 + dv] = acc0[q]; og[(t0 + 32 + crow(q, hf)) * D + h * 256 + dv] = acc1[q]; }
        }
        __syncthreads();
    }
}

DI void gla_scan_phase(LAS unsigned char* lds, const Prm& p) {
    const int tid = lthread(), wid = __builtin_amdgcn_readfirstlane(tid >> 6), lane = tid & 63, r = lane & 31, hf = lane >> 5;
    constexpr int BUF = 36352;
    float* oint = (float*)(p.ws + OFF_BIG);
    const bf16_t* QDg = (const bf16_t*)(p.ws + OFF_H); const bf16_t* KUTg = (const bf16_t*)(p.ws + OFF_H + (size_t)2048 * 16384); const float* DECg = (const float*)(p.ws + OFF_DEC);
    for (int item = lblock(); item < 256; item += gridDim.x) {
        const int bh = item >> 3, sl = item & 7;
        const int b = bh >> 2, h = bh & 3;
        const int ci0 = bh * 64;
        const int dv = 32 * sl + r;
        f32x16 S[4];
#pragma unroll
        for (int t = 0; t < 4; ++t)
#pragma unroll
            for (int q = 0; q < 16; ++q) S[t][q] = 0.f;
        u32x4 sq[2], sk[2]; f32x4 sd = {0.f, 0.f, 0.f, 0.f}; bf16x8 vf[4], vfn[4];
        const int qrow = tid >> 4, qc8 = tid & 15;
        const int krow = tid >> 3, kc8 = tid & 7;
#define SCAN_LOAD(ci_) do { const bf16_t* qg_ = QDg + (size_t)(ci_) * 8192; const bf16_t* kg_ = KUTg + (size_t)(ci_) * 8192; \
        sq[0] = *(const u32x4*)(qg_ + qrow * 128 + qc8 * 8); sq[1] = *(const u32x4*)(qg_ + (qrow + 32) * 128 + qc8 * 8); \
        sk[0] = *(const u32x4*)(kg_ + krow * 64 + kc8 * 8); sk[1] = *(const u32x4*)(kg_ + (krow + 64) * 64 + kc8 * 8); \
        if (tid < 32) sd = *(const f32x4*)(DECg + (size_t)(ci_) * 128 + tid * 4); } while (0)
#define SCAN_STORE(buf_) do { LAS unsigned char* b_ = lds + (buf_) * BUF; \
        *(LAS u32x4*)(b_ + (qrow * 136 + qc8 * 8) * 2) = sq[0]; *(LAS u32x4*)(b_ + ((qrow + 32) * 136 + qc8 * 8) * 2) = sq[1]; \
        *(LAS u32x4*)(b_ + 17408 + (krow * 72 + kc8 * 8) * 2) = sk[0]; *(LAS u32x4*)(b_ + 17408 + ((krow + 64) * 72 + kc8 * 8) * 2) = sk[1]; \
        if (tid < 32) *(LAS f32x4*)(b_ + 35840 + tid * 16) = sd; } while (0)
#define SCAN_VLOAD(dst, ci_) do { const bf16_t* vg_ = gla_vt_ptr(p.ws, (ci_)) + dv * 64 + 8 * hf; \
        _Pragma("unroll") for (int ks = 0; ks < 4; ++ks) dst[ks] = *(const bf16x8*)(vg_ + ks * 16); } while (0)
        SCAN_LOAD(ci0); if (wid == 0) SCAN_VLOAD(vf, ci0); SCAN_STORE(0);
        __syncthreads();
        for (int n = 0; n < 64; ++n) {
            const int cur = n & 1;
            const bool more = (n + 1 < 64);
            if (more) { SCAN_LOAD(ci0 + n + 1); if (wid == 0) SCAN_VLOAD(vfn, ci0 + n + 1); }
            if (wid == 0) {
            const LAS unsigned char* qb = lds + cur * BUF; const LAS unsigned char* kb = qb + 17408; const LAS float* db = (const LAS float*)(qb + 35840);
            const size_t t0 = (size_t)b * SEQ + (size_t)n * 64;
            float* op = oint + t0 * 1664 + h * 256 + dv;
            f32x16 a0, a1;
#pragma unroll
            for (int q = 0; q < 16; ++q) { a0[q] = 0.f; a1[q] = 0.f; }
#pragma unroll
            for (int t = 0; t < 4; ++t)
#pragma unroll
                for (int s = 0; s < 2; ++s) {
                    u32x4 sp;
#pragma unroll
                    for (int j2 = 0; j2 < 4; ++j2) sp[j2] = pk2(S[t][8 * s + 2 * j2], S[t][8 * s + 2 * j2 + 1]);
                    const int dk0 = 32 * t + 16 * s + 4 * hf;
                    const u32x2 l0 = *(const LAS u32x2*)(qb + (r * 136 + dk0) * 2), h0 = *(const LAS u32x2*)(qb + (r * 136 + dk0 + 8) * 2);
                    const u32x2 l1 = *(const LAS u32x2*)(qb + ((32 + r) * 136 + dk0) * 2), h1 = *(const LAS u32x2*)(qb + ((32 + r) * 136 + dk0 + 8) * 2);
                    u32x4 f0, f1; f0[0] = l0[0]; f0[1] = l0[1]; f0[2] = h0[0]; f0[3] = h0[1]; f1[0] = l1[0]; f1[1] = l1[1]; f1[2] = h1[0]; f1[3] = h1[1];
                    a0 = MFMA32(__builtin_bit_cast(bf16x8, f0), __builtin_bit_cast(bf16x8, sp), a0);
                    a1 = MFMA32(__builtin_bit_cast(bf16x8, f1), __builtin_bit_cast(bf16x8, sp), a1); }
#pragma unroll
            for (int q = 0; q < 16; ++q) { op[(size_t)crow(q, hf) * 1664] = a0[q]; op[(size_t)(32 + crow(q, hf)) * 1664] = a1[q]; }
#pragma unroll
            for (int t = 0; t < 4; ++t) {
#pragma unroll
                for (int g = 0; g < 4; ++g) { const f32x4 d4 = *(const LAS f32x4*)(db + 32 * t + 8 * g + 4 * hf);
                    S[t][4 * g] *= d4[0]; S[t][4 * g + 1] *= d4[1]; S[t][4 * g + 2] *= d4[2]; S[t][4 * g + 3] *= d4[3]; }
#pragma unroll
                for (int ks = 0; ks < 4; ++ks) {
                    const bf16x8 a = *(const LAS bf16x8*)(kb + ((32 * t + r) * 72 + ks * 16 + 8 * hf) * 2);
                    S[t] = MFMA32(a, vf[ks], S[t]); }
            }
            }
            if (more) { SCAN_STORE(cur ^ 1);
#pragma unroll
                for (int ks = 0; ks < 4; ++ks) vf[ks] = vfn[ks]; }
            __syncthreads();
        }
#undef SCAN_LOAD
#undef SCAN_STORE
#undef SCAN_VLOAD
    }
}

DI void attn_phase(LAS unsigned char* lds, const Prm& p) {
    const int tid = lthread(), wid = __builtin_amdgcn_readfirstlane(tid >> 6), lane = tid & 63, r = lane & 31, hf = lane >> 5;
    constexpr int KT_STRIDE = 400, KT_BYTES = 64 * KT_STRIDE, VT_STRIDE = 144, VT_BYTES = 128 * VT_STRIDE;
    LAS unsigned char* KT = lds;
    LAS unsigned char* VT = lds + 2 * KT_BYTES;
    const bf16_t* Q = (const bf16_t*)(p.ws + OFF_BIG + (size_t)T * 2048 * 2); const bf16_t* KV = (const bf16_t*)(p.ws + OFF_BIG);
    const bf16_t* KR = (const bf16_t*)(p.ws + OFF_KROPE); bf16_t* AO = (bf16_t*)(p.ws + OFF_H);
    const float* COS = (const float*)(p.ws + OFF_COS); const float* SIN = (const float*)(p.ws + OFF_SIN);
    const float SC = 0.07216878364870322f * 1.4426950408889634f;
    for (int it = lblock(); it < 1024; it += gridDim.x) {
        const int pass = it >> 8, blk = it & 255, bh = blk & 63, g = blk >> 6;
        const int qt = (pass == 0) ? g : (pass == 1) ? 7 - g : (pass == 2) ? 8 + g : 15 - g;
        const int b = bh >> 3, h = bh & 7, q0 = qt * 256;
        const size_t tok0 = (size_t)b * SEQ;
        const int qpos = q0 + 32 * wid + r;
        const size_t qrow = tok0 + qpos;
        bf16x8 qf[12];
        { const bf16_t* qp = Q + qrow * 1536 + h * 192 + 8 * hf;
#pragma unroll
          for (int ks = 0; ks < 12; ++ks) qf[ks] = *(const bf16x8*)(qp + ks * 16);
#pragma unroll
          for (int pr = 0; pr < 2; ++pr) {
              const int i0 = 16 * pr + 8 * hf;
              const f32x4 c0 = *(const f32x4*)(COS + qrow * 32 + i0), c1 = *(const f32x4*)(COS + qrow * 32 + i0 + 4);
              const f32x4 s0 = *(const f32x4*)(SIN + qrow * 32 + i0), s1 = *(const f32x4*)(SIN + qrow * 32 + i0 + 4);
              bf16x8 x1v = qf[8 + pr], x2v = qf[10 + pr], o1, o2;
#pragma unroll
              for (int j = 0; j < 8; ++j) { const float cc = (j < 4) ? c0[j & 3] : c1[j & 3], ss = (j < 4) ? s0[j & 3] : s1[j & 3];
                  const float x1 = bf2f((unsigned short)x1v[j]), x2 = bf2f((unsigned short)x2v[j]);
                  o1[j] = (short)f2bf(x1 * cc - x2 * ss); o2[j] = (short)f2bf(x1 * ss + x2 * cc); }
              qf[8 + pr] = o1; qf[10 + pr] = o2; } }
        float m = -1e30f, l = 0.f;
        f32x16 O[4];
#pragma unroll
        for (int d = 0; d < 4; ++d)
#pragma unroll
            for (int q = 0; q < 16; ++q) O[d][q] = 0.f;
        const int nkt = 4 * (qt + 1);
        u32x4 kraw[3], vraw[2];
        const int kkey = tid >> 4, kc8 = tid & 15;
        const int rkey = tid >> 3, rc8 = tid & 7;
        const int vp = tid >> 4, vc8 = tid & 15;
        const int vrd0 = r * VT_STRIDE + 8 * ((hf) ^ (r >> 3)), vrd1 = r * VT_STRIDE + 8 * ((2 + hf) ^ (r >> 3));
const unsigned offk0 = (unsigned)(kkey * 2048 + kc8 * 8), offk1 = offk0 + 32u * 2048u, offr = (unsigned)(rkey * 64 + rc8 * 8);
        const unsigned offv0 = (unsigned)(2 * vp * 2048 + 128 + vc8 * 8), offv1 = offv0 + 2048u;
        const bf16_t* kvb0 = KV + tok0 * 2048 + h * 256; const bf16_t* krb0 = KR + tok0 * 64;
#define ATT_LOAD(kt_) do { const bf16_t* kvb_ = kvb0 + (size_t)(kt_) * 64 * 2048; const bf16_t* krb_ = krb0 + (size_t)(kt_) * 64 * 64; \
        kraw[0] = *(const u32x4*)(kvb_ + offk0); kraw[1] = *(const u32x4*)(kvb_ + offk1); \
        kraw[2] = *(const u32x4*)(krb_ + offr); \
        vraw[0] = *(const u32x4*)(kvb_ + offv0); vraw[1] = *(const u32x4*)(kvb_ + offv1); } while (0)
#define ATT_STORE(buf_) do { LAS unsigned char* kt_ = KT + (buf_) * KT_BYTES; LAS unsigned char* vt_ = VT + (buf_) * VT_BYTES; \
        *(LAS u32x4*)(kt_ + kkey * KT_STRIDE + kc8 * 16) = kraw[0]; *(LAS u32x4*)(kt_ + (kkey + 32) * KT_STRIDE + kc8 * 16) = kraw[1]; \
        *(LAS u32x4*)(kt_ + rkey * KT_STRIDE + 256 + rc8 * 16) = kraw[2]; \
        _Pragma("unroll") for (int j2 = 0; j2 < 4; ++j2) { \
            const unsigned lo_ = (vraw[0][j2] & 0xffffu) | (vraw[1][j2] << 16), hi_ = (vraw[0][j2] >> 16) | (vraw[1][j2] & 0xffff0000u); \
            *(LAS unsigned*)(vt_ + (vc8 * 8 + 2 * j2) * VT_STRIDE + 4 * (vp ^ (2 * vc8))) = lo_; \
            *(LAS unsigned*)(vt_ + (vc8 * 8 + 2 * j2 + 1) * VT_STRIDE + 4 * (vp ^ (2 * vc8))) = hi_; } } while (0)
        ATT_LOAD(0); ATT_STORE(0);
        __syncthreads();
        for (int kt = 0; kt < nkt; ++kt) {
            const int cur = kt & 1;
            const bool more = (kt + 1 < nkt);
            if (more) ATT_LOAD(kt + 1);
            const int kbase = kt * 64;
            if (kbase <= q0 + 32 * wid + 31) {
                const LAS unsigned char* ktb = KT + cur * KT_BYTES; const LAS unsigned char* vtb = VT + cur * VT_BYTES;
                f32x16 s0, s1;
#pragma unroll
                for (int q = 0; q < 16; ++q) { s0[q] = 0.f; s1[q] = 0.f; }
#pragma unroll
                for (int ks = 0; ks < 12; ++ks) {
                    const bf16x8 a0 = *(const LAS bf16x8*)(ktb + r * KT_STRIDE + ks * 32 + 16 * hf);
                    const bf16x8 a1 = *(const LAS bf16x8*)(ktb + (32 + r) * KT_STRIDE + ks * 32 + 16 * hf);
                    s0 = MFMA32(a0, qf[ks], s0); s1 = MFMA32(a1, qf[ks], s1);
                    }
                const bool diag = (kbase + 63 > q0 + 32 * wid);
                float mx = -1e30f;
#pragma unroll
                for (int q = 0; q < 16; ++q) {
                    float v0 = s0[q], v1 = s1[q];
                    if (diag) { const int key = kbase + crow(q, hf); if (key > qpos) v0 = -1e30f; if (key + 32 > qpos) v1 = -1e30f; }
                    s0[q] = v0; s1[q] = v1; mx = fmaxf(mx, fmaxf(v0, v1)); }
                mx = fmaxf(mx, __shfl_xor(mx, 32)) * SC;
                const float mn = fmaxf(m, mx), alpha = __builtin_amdgcn_exp2f(m - mn);
                const bool changed = __builtin_amdgcn_ballot_w64(mn > m) != 0ull;
                m = mn;
                float ls = 0.f;
#pragma unroll
                for (int q = 0; q < 16; ++q) { s0[q] = __builtin_amdgcn_exp2f(__builtin_fmaf(s0[q], SC, -mn)); s1[q] = __builtin_amdgcn_exp2f(__builtin_fmaf(s1[q], SC, -mn)); ls += s0[q] + s1[q]; }
                l = l * alpha + ls;
                if (changed) {
#pragma unroll
                    for (int d = 0; d < 4; ++d)
#pragma unroll
                        for (int q = 0; q < 16; ++q) O[d][q] *= alpha;
                }
                bf16x8 pb[2][2];
#pragma unroll
                for (int s = 0; s < 2; ++s) {
                    u32x4 t0, t1;
#pragma unroll
                    for (int j2 = 0; j2 < 4; ++j2) { t0[j2] = pk2(s0[8 * s + 2 * j2], s0[8 * s + 2 * j2 + 1]); t1[j2] = pk2(s1[8 * s + 2 * j2], s1[8 * s + 2 * j2 + 1]); }
                    pb[0][s] = __builtin_bit_cast(bf16x8, t0); pb[1][s] = __builtin_bit_cast(bf16x8, t1); }
#pragma unroll
                for (int d = 0; d < 4; ++d) {
#pragma unroll
                    for (int ksub = 0; ksub < 2; ++ksub)
#pragma unroll
                        for (int s = 0; s < 2; ++s) {
                            const int imm = d * 32 * VT_STRIDE + 32 * (((2 * ksub + s) ^ d) & 3);
                            const u32x2 lo = *(const LAS u32x2*)(vtb + vrd0 + imm);
                            const u32x2 hi = *(const LAS u32x2*)(vtb + vrd1 + imm);
                            u32x4 av; av[0] = lo[0]; av[1] = lo[1]; av[2] = hi[0]; av[3] = hi[1];
                            O[d] = MFMA32(__builtin_bit_cast(bf16x8, av), pb[ksub][s], O[d]); }
                }
            }
            if (more) ATT_STORE(cur ^ 1);
            __syncthreads();
        }
#undef ATT_LOAD
#undef ATT_STORE
        l += __shfl_xor(l, 32);
        const float inv = 1.f / l;
#pragma unroll
        for (int d = 0; d < 4; ++d)
#pragma unroll
            for (int g4 = 0; g4 < 4; ++g4) { u32x2 pk; pk[0] = pk2(O[d][4 * g4] * inv, O[d][4 * g4 + 1] * inv); pk[1] = pk2(O[d][4 * g4 + 2] * inv, O[d][4 * g4 + 3] * inv);
                *(u32x2*)(AO + qrow * D + h * 128 + 32 * d + 8 * g4 + 4 * hf) = pk; }
    }
}


#define XB_TMO      128
#define XB_XCNT(j)  (256  + 64 * (j))
#define XB_XSUB(j)  (1280 + 64 * (j))
#define XB_XGEN(j)  (2304 + 64 * (j))
#define XB_TOP      3328
#define XB_TOPGEN   3392
#define XCD_BAR_WORDS 3456
#define XB_SPIN_CAP (1u << 22)
DI unsigned xb_ld(unsigned* p)              { return __hip_atomic_load(p, __ATOMIC_RELAXED, __HIP_MEMORY_SCOPE_AGENT); }
DI unsigned xb_add(unsigned* p, unsigned v) { return __hip_atomic_fetch_add(p, v, __ATOMIC_RELAXED, __HIP_MEMORY_SCOPE_AGENT); }
DI unsigned xb_xcc_id() { return (unsigned)__builtin_amdgcn_s_getreg((3 << 11) | 20) & 0xFu; }
#define XB_SPIN(cond, bar) do { unsigned _sp = 0; while (cond) { __builtin_amdgcn_s_sleep(1); \
    if ((++_sp & 255u) == 0u) { if (xb_ld(&(bar)[XB_TMO])) break; if (_sp > XB_SPIN_CAP) { atomicAdd(&(bar)[XB_TMO], 1u); break; } } } } while (0)
struct XcdBarrier { unsigned* bar; unsigned x; volatile LAS unsigned* st; };
DI XcdBarrier xcd_barrier_post(unsigned* bar, volatile LAS unsigned* st) {
    XcdBarrier b; b.bar = bar; b.x = xb_xcc_id(); b.st = st;
    if (threadIdx.x == 0) (void)xb_add(&bar[XB_XCNT(b.x)], 1u);
    return b;
}
DI void xcd_barrier_complete(unsigned* bar, unsigned x, unsigned& nloc, unsigned& nx) {
    const unsigned G = gridDim.x * gridDim.y * gridDim.z;
    unsigned sum, cnt, mine, sp = 0u;
    for (;;) {
        sum = 0u; cnt = 0u; mine = 0u;
#pragma unroll
        for (unsigned j = 0; j < 16; ++j) { const unsigned c = xb_ld(&bar[XB_XCNT(j)]); sum += c; cnt += (c > 0u) ? 1u : 0u; mine = (j == x) ? c : mine; }
        if (sum == G) break;
        __builtin_amdgcn_s_sleep(1);
        if ((++sp & 255u) == 0u) { if (xb_ld(&bar[XB_TMO])) break; if (sp > XB_SPIN_CAP) { atomicAdd(&bar[XB_TMO], 1u); break; } }
    }
    nloc = mine > 0u ? mine : 1u; nx = cnt > 0u ? cnt : 1u;
}
DI void xcd_barrier(const XcdBarrier& b) {
    asm volatile("s_waitcnt vmcnt(0)" ::: "memory");
    __syncthreads();
    if (threadIdx.x == 0) {
        unsigned* bar = b.bar;
        __builtin_amdgcn_s_waitcnt(0);
        unsigned nloc = b.st[0], nx = b.st[1];
        if (nloc == 0u) { xcd_barrier_complete(bar, b.x, nloc, nx); b.st[0] = nloc; b.st[1] = nx; }
        const unsigned old = xb_add(&bar[XB_XSUB(b.x)], 1u);
        const unsigned gen = old / nloc;
        if (old + 1u == (gen + 1u) * nloc) {
            __builtin_amdgcn_fence(__ATOMIC_RELEASE, "agent");
            asm volatile("s_waitcnt vmcnt(0)" ::: "memory");
            const unsigned og = xb_add(&bar[XB_TOP], 1u);
            const unsigned tg = og / nx;
            if (og + 1u == (tg + 1u) * nx) xb_add(&bar[XB_TOPGEN], 1u);
            else XB_SPIN(xb_ld(&bar[XB_TOPGEN]) == tg, bar);
            __builtin_amdgcn_fence(__ATOMIC_ACQUIRE, "agent");
            xb_add(&bar[XB_XGEN(b.x)], 1u);
            asm volatile("s_waitcnt vmcnt(0)" ::: "memory");
        } else {
            XB_SPIN(xb_ld(&bar[XB_XGEN(b.x)]) == gen, bar);
            __builtin_amdgcn_fence(__ATOMIC_ACQUIRE, "agent");
            asm volatile("s_waitcnt vmcnt(0)" ::: "memory");
        }
    }
    __syncthreads();
}

__global__ void __launch_bounds__(NTHREADS) fwd_megakernel(Prm p) {
    extern __shared__ __attribute__((aligned(16))) unsigned char lds_raw[];
    LAS unsigned char* lds = (LAS unsigned char*)lds_raw;
    cg::grid_group grid = cg::this_grid();
    if (threadIdx.x < 4) ((LAS unsigned*)(lds + 131072))[threadIdx.x] = 0u;
    __syncthreads();
    XcdBarrier xbar = xcd_barrier_post((unsigned*)(p.ws + OFF_BAR), (volatile LAS unsigned*)(lds + 131072));
    unsigned char* ws = p.ws;
    float* mods = (float*)(ws + OFF_MODS); float* kvm = (float*)(ws + OFF_KVMODS);
    bf16_t* H = (bf16_t*)(ws + OFF_H); float* Y = (float*)(ws + OFF_Y); bf16_t* BIG = (bf16_t*)(ws + OFF_BIG);
    const int G = gridDim.x, cblk = lblock();
#pragma unroll 1
    for (int ph = p.ph_lo; ph < p.ph_hi; ++ph) {
#if DUP_MASK
      const int nrep = ((DUP_MASK >> ph) & 1u) ? 2 : 1;
#pragma unroll 1
      for (int rep = 0; rep < nrep; ++rep)
#endif
        switch (ph) {
        case PH_PRO: {
            mods_phase(lds, p);
            rope_tables(p);
            convert_w(lds, p.gla_w_in, 1024, 3088, (bf16_t*)(ws + OFF_WGIN), 3328, WM_GIN);
            convert_w(lds, p.gla_w_out, 1024, 1024, (bf16_t*)(ws + OFF_WGOUT), 1024, WM_ID);
            convert_w(lds, p.w_kv_a, 1024, 320, (bf16_t*)(ws + OFF_WKVA), 512, WM_LIM320);
            convert_w(lds, p.w_kv_b, 256, 2048, (bf16_t*)(ws + OFF_WKVB), 2048, WM_ID);
            convert_w(lds, p.w_dq, 1024, 384, (bf16_t*)(ws + OFF_WDQ), 512, WM_LIM384);
            convert_w(lds, p.w_uq, 384, 1536, (bf16_t*)(ws + OFF_WUQ), 1536, WM_ID);
            convert_w(lds, p.w_mout, 1024, 1024, (bf16_t*)(ws + OFF_WMOUT), 1024, WM_ID);
            convert_ffn(lds, p, 0, 0);
        } break;
        case PH_ROW0: case PH_ROW1: case PH_ROW2: case PH_ROW3: case PH_ROW4: case PH_ROW5: case PH_ROW6: {
            const int ps = (ph == PH_ROW0) ? -1 : (ph == PH_ROW1) ? 0 : (ph == PH_ROW2) ? 1 : (ph == PH_ROW3) ? 2 : (ph == PH_ROW4) ? 3 : (ph == PH_ROW5) ? 4 : 5;
            RowP a;
            a.xin = (ph <= PH_ROW1) ? p.x : p.out; a.y = nullptr; a.xout = p.out; a.rw = 0.f; a.gate = nullptr; a.gate_bs = 9216; a.g_post = nullptr;
            a.g1 = nullptr; a.sh1 = nullptr; a.sc1 = nullptr; a.bs1 = 9216; a.h1 = nullptr; a.g2 = nullptr; a.sh2 = nullptr; a.sc2 = nullptr; a.bs2 = 2048; a.h2 = nullptr;
            if (ps >= 0) { const int l = ps / 3, s = ps % 3; a.y = (const bf16_t*)Y; a.rw = (s == 1) ? 1.f : 0.5f;
                a.gate = mods + (size_t)l * 8 * 9216 + (3 * s + 2) * 1024; a.g_post = p.norm_g + ((l * 3 + s) * 2 + 1) * 1024; }
            const int pre = ps + 1;
            if (pre < 6) { const int l = pre / 3, s = pre % 3; a.h1 = H; a.g1 = p.norm_g + ((l * 3 + s) * 2) * 1024;
                a.sh1 = mods + (size_t)l * 8 * 9216 + (3 * s) * 1024; a.sc1 = mods + (size_t)l * 8 * 9216 + (3 * s + 1) * 1024; }
            if (ph == PH_ROW3) { a.h2 = BIG; a.g2 = p.kv_g_in; a.sh2 = kvm; a.sc2 = kvm + 1024; }
            rowwise_phase(a);
            if (ph == PH_ROW1) convert_ffn(lds, p, 0, 1);
            if (ph == PH_ROW3) convert_ffn(lds, p, 1, 0);
            if (ph == PH_ROW4) convert_ffn(lds, p, 1, 1);
        } break;
        case PH_A_G1: case PH_B_G1: case PH_C_G1: case PH_D_G1: {
            if (ph == PH_C_G1) ckv_phase(p);
            pg8::Gemm g{H, (const bf16_t*)(ws + OFF_WGU), T, 5632, 1024}; pg8::StaticOrder S; S.init(T, 5632, G, cblk);
            pg8::EpiSwiglu E{BIG};
            pg8::gemm_phase<pg8::EpiSwiglu>(lds, g, S, E);
        } break;
        case PH_KVA: {
            pg8::Gemm g{BIG, (const bf16_t*)(ws + OFF_WKVA), T, 512, 1024}; pg8::EpiF32 E{Y, 512}; pg8::StaticOrder S; S.init(T, 512, G, cblk);
            pg8::gemm_phase<pg8::EpiF32>(lds, g, S, E);
        } break;
        case PH_GIN: case PH_UQ: case PH_A_G2: case PH_B_G2: case PH_C_G2: case PH_D_G2: case PH_GOUT: case PH_MOUT: {
            pg8::Gemm g; pg8::EpiBf16 E;
            if (ph == PH_GIN) { g = pg8::Gemm{H, (const bf16_t*)(ws + OFF_WGIN), T, 3328, 1024}; E = pg8::EpiBf16{BIG, 3328, (float*)(ws + OFF_GLOW), 12}; }
            else if (ph == PH_UQ) { g = pg8::Gemm{(const bf16_t*)(ws + OFF_Y + (size_t)T * 512 * 4), (const bf16_t*)(ws + OFF_WUQ), T, 1536, 384}; E = pg8::EpiBf16{(bf16_t*)(ws + OFF_BIG + (size_t)T * 2048 * 2), 1536, nullptr, -1}; }
            else if (ph == PH_GOUT) { g = pg8::Gemm{H, (const bf16_t*)(ws + OFF_WGOUT), T, 1024, 1024}; E = pg8::EpiBf16{(bf16_t*)Y, 1024, nullptr, -1}; }
            else if (ph == PH_MOUT) { g = pg8::Gemm{H, (const bf16_t*)(ws + OFF_WMOUT), T, 1024, 1024}; E = pg8::EpiBf16{(bf16_t*)Y, 1024, nullptr, -1}; }
            else { g = pg8::Gemm{BIG, (const bf16_t*)(ws + OFF_WDN), T, 1024, 2816}; E = pg8::EpiBf16{(bf16_t*)Y, 1024, nullptr, -1}; }
            pg8::StaticOrder S; S.init(T, g.N, G, cblk);
            pg8::gemm_phase<pg8::EpiBf16>(lds, g, S, E);
        } break;
        case PH_GLA_CHUNK: gla_chunk_phase(lds, p); break;
        case PH_GLA_SCAN: gla_scan_phase(lds, p); break;
        case PH_GLA_GATE: gla_gate_phase(p); break;
        case PH_DQ_KVB: {
            { pg8::Gemm g{H, (const bf16_t*)(ws + OFF_WDQ), T, 512, 1024}; pg8::EpiF32 E{Y, 512}; pg8::StaticOrder S; S.init(T, 512, G, cblk);
              pg8::gemm_phase<pg8::EpiF32>(lds, g, S, E); }
            { pg8::Gemm g{(const bf16_t*)(ws + OFF_CKVN), (const bf16_t*)(ws + OFF_WKVB), T, 2048, 256}; pg8::EpiBf16 E{BIG, 2048, nullptr, -1}; pg8::StaticOrder S; S.init(T, 2048, G, cblk);
              pg8::gemm_phase<pg8::EpiBf16>(lds, g, S, E); }
        } break;
        case PH_CQ: cq_phase(p); break;
        case PH_ATTN: attn_phase(lds, p); break;
        default: break;
        }
        if (ph + 1 < p.ph_hi) { if (p.ph_hi > NPH) grid.sync(); else xcd_barrier(xbar); }
    }
}

extern "C" void kernel_launch(void* const* d_in, const int* in_sizes, int n_in, void* d_out, int out_size, void* d_ws, size_t ws_size, hipStream_t stream) {
    static int grid_blocks = 0;
    if (grid_blocks == 0) {
        if (n_in != 23 || ws_size < WS_END) { fprintf(stderr, "kernel_launch: unexpected n_in %d / ws %zu (need %zu)\n", n_in, ws_size, (size_t)WS_END); grid_blocks = -1; return; }
        int dev = 0, cus = 0, per_cu = 0;
        (void)hipGetDevice(&dev);
        (void)hipDeviceGetAttribute(&cus, hipDeviceAttributeMultiprocessorCount, dev);
        if (hipFuncSetAttribute((const void*)fwd_megakernel, hipFuncAttributeMaxDynamicSharedMemorySize, LDS_BYTES) != hipSuccess) { fprintf(stderr, "kernel_launch: hipFuncSetAttribute failed\n"); grid_blocks = -1; return; }
        if (hipOccupancyMaxActiveBlocksPerMultiprocessor(&per_cu, (const void*)fwd_megakernel, NTHREADS, LDS_BYTES) != hipSuccess || per_cu < 1) { fprintf(stderr, "kernel_launch: occupancy query says %d\n", per_cu); per_cu = 1; }
        (void)hipGetLastError();
        grid_blocks = cus * 1;
        fprintf(stderr, "kernel_launch: cus %d per_cu %d grid %d\n", cus, per_cu, grid_blocks);
    }
    if (grid_blocks < 0) return;
    Prm p{};
    p.x = (const float*)d_in[0]; p.c = (const float*)d_in[1]; p.pos = (const int*)d_in[2]; p.cond_w = (const float*)d_in[3]; p.cond_b = (const float*)d_in[4];
    p.norm_g = (const float*)d_in[5]; p.ffn_gu = (const float*)d_in[6]; p.ffn_dn = (const float*)d_in[7]; p.gla_w_in = (const float*)d_in[8];
    p.gla_w_gate_up = (const float*)d_in[9]; p.gla_b_gate = (const float*)d_in[10]; p.gla_g_out = (const float*)d_in[11]; p.gla_w_out = (const float*)d_in[12];
    p.kv_g_in = (const float*)d_in[13]; p.kv_cond_w = (const float*)d_in[14]; p.kv_cond_b = (const float*)d_in[15]; p.w_kv_a = (const float*)d_in[16];
    p.g_kv = (const float*)d_in[17]; p.w_kv_b = (const float*)d_in[18]; p.w_dq = (const float*)d_in[19]; p.g_q = (const float*)d_in[20];
    p.w_uq = (const float*)d_in[21]; p.w_mout = (const float*)d_in[22];
    p.out = (float*)d_out; p.ws = (unsigned char*)d_ws;
    (void)hipMemsetAsync((unsigned char*)d_ws + OFF_BAR, 0, 16384, stream);
#if MULTI_LAUNCH
    for (int ph = 0; ph < NPH; ++ph) {
        p.ph_lo = ph; p.ph_hi = ph + 1;
        hipLaunchKernelGGL(fwd_megakernel, dim3(grid_blocks), dim3(NTHREADS), LDS_BYTES, stream, p);
    }
#else
    p.ph_lo = 0; p.ph_hi = NPH;
    void* args[] = {&p};
    hipError_t e = hipLaunchCooperativeKernel((const void*)fwd_megakernel, dim3(grid_blocks), dim3(NTHREADS), args, LDS_BYTES, stream);
    if (e != hipSuccess) fprintf(stderr, "cooperative launch failed: %s (grid %d)\n", hipGetErrorString(e), grid_blocks);
#endif
}
```

```cpp
#include <hip/hip_runtime.h>
#include <hip/hip_cooperative_groups.h>
#include <cstdio>
namespace cg = cooperative_groups;

#define LAS __attribute__((address_space(3)))
#define DI __device__ __forceinline__
typedef unsigned short bf16_t;
typedef short bf16x8 __attribute__((ext_vector_type(8)));
typedef float f32x2 __attribute__((ext_vector_type(2)));
typedef float f32x4 __attribute__((ext_vector_type(4)));
typedef float f32x16 __attribute__((ext_vector_type(16)));
typedef unsigned u32x2 __attribute__((ext_vector_type(2)));
typedef unsigned u32x4 __attribute__((ext_vector_type(4)));
typedef __bf16 bf16v2 __attribute__((ext_vector_type(2)));

#ifndef MULTI_LAUNCH
#define MULTI_LAUNCH 0
#endif
#ifndef STAGGER_US
#define STAGGER_US 0
#endif
#ifndef DUP_MASK
#define DUP_MASK 0u
#endif

constexpr int T = 32768, D = 1024, SEQ = 4096, NB = 8, DFF = 2816;
constexpr int NTHREADS = 512;
constexpr int LDS_BYTES = 131072 + 16;
constexpr float EPS = 1e-6f;
enum { PH_PRO = 0, PH_ROW0, PH_A_G1, PH_A_G2, PH_ROW1, PH_GIN, PH_GLA_CHUNK, PH_GLA_SCAN, PH_GLA_GATE, PH_GOUT, PH_ROW2, PH_B_G1, PH_B_G2, PH_ROW3,
       PH_KVA, PH_C_G1, PH_C_G2, PH_ROW4, PH_DQ_KVB, PH_CQ, PH_UQ, PH_ATTN, PH_MOUT, PH_ROW5, PH_D_G1, PH_D_G2, PH_ROW6, NPH };

constexpr size_t SZ_WGU = (size_t)5632 * 1024 * 2, SZ_WDN = (size_t)1024 * 2816 * 2, SZ_WGIN = (size_t)3328 * 1024 * 2;
constexpr size_t OFF_BAR = 0;
constexpr size_t OFF_WGU = 16384;
constexpr size_t OFF_WDN = OFF_WGU + SZ_WGU;
constexpr size_t OFF_WGIN = OFF_WDN + SZ_WDN;
constexpr size_t OFF_WGOUT = OFF_WGIN + SZ_WGIN;
constexpr size_t OFF_WKVA = OFF_WGOUT + (size_t)1024 * 1024 * 2;
constexpr size_t OFF_WKVB = OFF_WKVA + (size_t)512 * 1024 * 2;
constexpr size_t OFF_WDQ = OFF_WKVB + (size_t)2048 * 256 * 2;
constexpr size_t OFF_WUQ = OFF_WDQ + (size_t)512 * 1024 * 2;
constexpr size_t OFF_WMOUT = OFF_WUQ + (size_t)1536 * 384 * 2;
constexpr size_t OFF_MODS = OFF_WMOUT + (size_t)1024 * 1024 * 2;
constexpr size_t OFF_KVMODS = OFF_MODS + (size_t)2 * 8 * 9216 * 4;
constexpr size_t OFF_COS = OFF_KVMODS + (size_t)8 * 2048 * 4;
constexpr size_t OFF_SIN = OFF_COS + (size_t)T * 32 * 4;
constexpr size_t OFF_GLOW = OFF_SIN + (size_t)T * 32 * 4;
constexpr size_t OFF_CKVN = OFF_GLOW + (size_t)T * 16 * 4;
constexpr size_t OFF_KROPE = OFF_CKVN + (size_t)T * 256 * 2;
constexpr size_t OFF_H = OFF_KROPE + (size_t)T * 64 * 2;
constexpr size_t OFF_Y = OFF_H + (size_t)T * 1024 * 2;
constexpr size_t OFF_BIG = OFF_Y + (size_t)T * 1024 * 4;
constexpr size_t SZ_BIG = (size_t)T * 2048 * 2 + (size_t)T * 1536 * 2;
constexpr size_t OFF_VTA = OFF_BIG + (size_t)T * 3328 * 2;
constexpr size_t OFF_DEC = OFF_VTA + (size_t)1536 * 32768;
constexpr size_t WS_END = (OFF_DEC + (size_t)2048 * 512 > OFF_BIG + SZ_BIG) ? OFF_DEC + (size_t)2048 * 512 : OFF_BIG + SZ_BIG;
static_assert(WS_END <= (size_t)536870912, "workspace");
static_assert(SZ_BIG >= (size_t)T * 3328 * 2 && SZ_BIG >= (size_t)T * 2816 * 2, "big");

struct Prm {
    const float* x; const float* c; const int* pos; const float* cond_w; const float* cond_b; const float* norm_g;
    const float* ffn_gu; const float* ffn_dn; const float* gla_w_in; const float* gla_w_gate_up; const float* gla_b_gate;
    const float* gla_g_out; const float* gla_w_out; const float* kv_g_in; const float* kv_cond_w; const float* kv_cond_b;
    const float* w_kv_a; const float* g_kv; const float* w_kv_b; const float* w_dq; const float* g_q; const float* w_uq; const float* w_mout;
    float* out; unsigned char* ws; int ph_lo, ph_hi;
};

DI float bf2f(unsigned short b) { return __uint_as_float(((unsigned)b) << 16); }
DI unsigned pk2(float lo, float hi) { f32x2 v = {lo, hi}; bf16v2 b = __builtin_convertvector(v, bf16v2); return __builtin_bit_cast(unsigned, b); }
DI bf16_t f2bf(float f) { return (bf16_t)(pk2(f, 0.f) & 0xffffu); }
DI float lo_f(unsigned u) { return __uint_as_float(u << 16); }
DI float hi_f(unsigned u) { return __uint_as_float(u & 0xffff0000u); }
DI float wave_sum(float v) {
#pragma unroll
    for (int o = 32; o > 0; o >>= 1) v += __shfl_xor(v, o);
    return v;
}
DI float xmax32(float v) { const auto r = __builtin_amdgcn_permlane32_swap(__float_as_uint(v), __float_as_uint(v), false, false); return fmaxf(__uint_as_float(r[0]), __uint_as_float(r[1])); }
DI float xsum32(float v) { const auto r = __builtin_amdgcn_permlane32_swap(__float_as_uint(v), __float_as_uint(v), false, false); return __uint_as_float(r[0]) + __uint_as_float(r[1]); }
DI float silu_f(float v) { return v * __builtin_amdgcn_rcpf(1.f + __expf(-v)); }
DI int crow(int reg, int hf) { return (reg & 3) + 8 * (reg >> 2) + 4 * hf; }
DI int lthread() { int t = threadIdx.x; asm volatile("" : "+v"(t)); return t; }
DI int lblock() { int t = blockIdx.x; asm volatile("" : "+s"(t)); return t; }
#define MFMA32(a, b, c) __builtin_amdgcn_mfma_f32_32x32x16_bf16((a), (b), (c), 0, 0, 0)

namespace pg8 {
constexpr int BM = 256, BK = 64, HALF = 128, HTB = HALF * BK * 2, STAGE_BYTES = 8 * HTB, NXCD = 8, WGM = 8;
DI int lds_byte(int r, int c) { const int st = (r >> 4) * 2 + (c >> 5), rr = r & 15, cc = c & 31, ob = rr * 64 + cc * 2; return st * 1024 + (ob ^ (((ob >> 9) & 1) << 5)); }
DI void stage_rc(int b, int& R, int& C) { const int st = b / 1024, sb = b % 1024, swz = sb ^ (((sb >> 9) & 1) << 5); R = (st >> 1) * 16 + swz / 64; C = (st & 1) * 32 + (swz % 64) / 2; }
DI int perm32(int rho) { const int n = rho >> 4, i = rho & 15; return 8 * (i >> 2) + 4 * n + (i & 3); }

struct Unit { int pm, pn; };
struct Gemm { const bf16_t* A; const bf16_t* Bt; int M, N, K; };

struct StaticOrder {
    int nM, nN, nwg, G, c;
    DI void init(int M, int N, int G_, int c_) { nM = M / BM; nN = N / BM; nwg = nM * nN; G = G_; c = c_; }
    DI bool next(int i, Unit& u) const {
        const long L = (long)i * G + c; if (L >= nwg) return false;
        int wgid = (int)L; { const int q = nwg / NXCD, r = nwg % NXCD, xcd = wgid % NXCD, off = wgid / NXCD; wgid = (xcd < r ? xcd * (q + 1) : r * (q + 1) + (xcd - r) * q) + off; }
        const int nig = WGM * nN, gid = wgid / nig, fm = gid * WGM, gsz = (nM - fm) < WGM ? (nM - fm) : WGM;
        u.pm = fm + ((wgid % nig) % gsz); u.pn = (wgid % nig) / gsz; return true;
    }
};

struct EpiF32 {
    static constexpr bool PERM = false;
    float* C; int ldc;
    DI void operator()(const f32x4 (&acc)[2][2][4][2], const Unit& u, int wr, int wc, int fr, int fq) const {
        const int row0 = u.pm * BM + wr * 64 + fr, col0 = u.pn * BM + wc * 32 + 4 * fq;
#pragma unroll
        for (int ai = 0; ai < 2; ++ai)
#pragma unroll
            for (int m = 0; m < 4; ++m) { float* rowp = C + (size_t)(row0 + ai * HALF + m * 16) * ldc + col0;
#pragma unroll
                for (int bj = 0; bj < 2; ++bj)
#pragma unroll
                    for (int n = 0; n < 2; ++n) *(f32x4*)(rowp + bj * HALF + n * 16) = acc[ai][bj][m][n]; }
    }
};
struct EpiBf16 {
    static constexpr bool PERM = true;
    bf16_t* O; int ldc; float* glow; int glow_pn;
    DI void operator()(const f32x4 (&acc)[2][2][4][2], const Unit& u, int wr, int wc, int fr, int fq) const {
        const int row0 = u.pm * BM + wr * 64 + fr, col0 = u.pn * BM + wc * 32 + 8 * fq;
        const bool gl = (glow != nullptr) && (u.pn == glow_pn) && (wc == 0) && (fq < 2);
#pragma unroll
        for (int ai = 0; ai < 2; ++ai)
#pragma unroll
            for (int m = 0; m < 4; ++m) { const int row = row0 + ai * HALF + m * 16; bf16_t* rowp = O + (size_t)row * ldc + col0;
#pragma unroll
                for (int bj = 0; bj < 2; ++bj) { const f32x4 v0 = acc[ai][bj][m][0], v1 = acc[ai][bj][m][1];
                    u32x4 pk; pk[0] = pk2(v0[0], v0[1]); pk[1] = pk2(v0[2], v0[3]); pk[2] = pk2(v1[0], v1[1]); pk[3] = pk2(v1[2], v1[3]);
                    *(u32x4*)(rowp + bj * HALF) = pk;
                    if (bj == 0 && gl) { *(f32x4*)(glow + (size_t)row * 16 + 8 * fq) = v0; *(f32x4*)(glow + (size_t)row * 16 + 8 * fq + 4) = v1; } } }
    }
};
struct EpiSwiglu {
    static constexpr bool PERM = true;
    bf16_t* O;
    DI void operator()(const f32x4 (&acc)[2][2][4][2], const Unit& u, int wr, int wc, int fr, int fq) const {
        const int row0 = u.pm * BM + wr * 64 + fr, col0 = u.pn * HALF + wc * 32 + 8 * fq;
#pragma unroll
        for (int ai = 0; ai < 2; ++ai)
#pragma unroll
            for (int m = 0; m < 4; ++m) { bf16_t* rowp = O + (size_t)(row0 + ai * HALF + m * 16) * DFF + col0;
                const f32x4 g0 = acc[ai][0][m][0], g1 = acc[ai][0][m][1], u0 = acc[ai][1][m][0], u1 = acc[ai][1][m][1];
                u32x4 pk;
                pk[0] = pk2(silu_f(g0[0]) * u0[0], silu_f(g0[1]) * u0[1]); pk[1] = pk2(silu_f(g0[2]) * u0[2], silu_f(g0[3]) * u0[3]);
                pk[2] = pk2(silu_f(g1[0]) * u1[0], silu_f(g1[1]) * u1[1]); pk[3] = pk2(silu_f(g1[2]) * u1[2], silu_f(g1[3]) * u1[3]);
                *(u32x4*)rowp = pk; }
    }
};

template <class Epi>
DI void gemm_phase(LAS unsigned char* lds, const Gemm g, const StaticOrder& S, const Epi& E) {
    const int tid = lthread(), wid = __builtin_amdgcn_readfirstlane(tid >> 6), lane = tid & 63, wr = wid >> 2, wc = wid & 3, fr = lane & 15, fq = lane >> 4;
    const int K = g.K, nt = K / BK;
    unsigned voffA[2], voffB[2];
#pragma unroll
    for (int i = 0; i < 2; ++i) { int R, C; stage_rc(tid * 16 + i * 8192, R, C); const int Rb = Epi::PERM ? ((R & ~31) + perm32(R & 31)) : R;
        voffA[i] = (unsigned)(R * K + C) * 2u; voffB[i] = (unsigned)(Rb * K + C) * 2u; }
    const size_t kstep = (size_t)(BK * 2);
    const size_t hstep = (size_t)HALF * K * 2;
    const size_t tstep = 2 * hstep;
    const unsigned ldsw = (unsigned)wid * 1024u;
    const int aoff = lds_byte(wr * 64 + fr, fq * 8), boff = lds_byte(wc * 32 + fr, fq * 8);
#define PG8_SA(b, h) (((b) * 2 + (h)) * HTB)
#define PG8_SB(b, h) ((4 + (b) * 2 + (h)) * HTB)
#define PG8_STAGE(bufoff, gbase, voff) do { _Pragma("unroll") for (int _i = 0; _i < 2; ++_i) \
        __builtin_amdgcn_global_load_lds((const unsigned*)((const char*)(gbase) + (voff)[_i]), (LAS unsigned*)(lds + (bufoff) + ldsw + _i * 8192), 16, 0, 0); } while (0)
#define PG8_LDA(dst, b, h) do { _Pragma("unroll") for (int m = 0; m < 4; ++m) _Pragma("unroll") for (int k = 0; k < 2; ++k) dst[m][k] = *(const LAS bf16x8*)(lds + PG8_SA(b, h) + aoff + m * 2048 + k * 1024); } while (0)
#define PG8_LDB(dst, b, h) do { _Pragma("unroll") for (int n = 0; n < 2; ++n) _Pragma("unroll") for (int k = 0; k < 2; ++k) dst[n][k] = *(const LAS bf16x8*)(lds + PG8_SB(b, h) + boff + n * 2048 + k * 1024); } while (0)
#define PG8_MMA(ai, bj, At, Bt) do { __builtin_amdgcn_s_setprio(1); _Pragma("unroll") for (int m = 0; m < 4; ++m) _Pragma("unroll") for (int n = 0; n < 2; ++n) _Pragma("unroll") for (int k = 0; k < 2; ++k) \
        acc[ai][bj][m][n] = __builtin_amdgcn_mfma_f32_16x16x32_bf16(Bt[n][k], At[m][k], acc[ai][bj][m][n], 0, 0, 0); __builtin_amdgcn_s_setprio(0); } while (0)
#define PG8_WAIT_V(n) asm volatile("s_waitcnt vmcnt(" #n ")" ::: "memory")
#define PG8_WAIT_L(n) asm volatile("s_waitcnt lgkmcnt(" #n ")" ::: "memory")
#define PG8_BAR __builtin_amdgcn_s_barrier()
#define PG8_SCHED __builtin_amdgcn_sched_barrier(0)
    Unit cur, nxt; int ui = 0;
    if (!S.next(0, cur)) return;
    f32x4 acc[2][2][4][2];
#pragma unroll
    for (int a = 0; a < 2; ++a)
#pragma unroll
        for (int b = 0; b < 2; ++b)
#pragma unroll
            for (int m = 0; m < 4; ++m)
#pragma unroll
                for (int n = 0; n < 2; ++n) acc[a][b][m][n] = (f32x4){0.f, 0.f, 0.f, 0.f};
    bf16x8 At[4][2], B0[2][2], B1[2][2];
    const char* cA = (const char*)g.A + (size_t)cur.pm * tstep; const char* cB = (const char*)g.Bt + (size_t)cur.pn * tstep;
    PG8_STAGE(PG8_SB(0, 0), cB, voffB); PG8_STAGE(PG8_SA(0, 0), cA, voffA); PG8_STAGE(PG8_SB(0, 1), cB + hstep, voffB); PG8_STAGE(PG8_SA(0, 1), cA + hstep, voffA);
    if (wr == 1) PG8_BAR;
    PG8_WAIT_V(4); PG8_BAR;
    PG8_STAGE(PG8_SB(1, 0), cB + kstep, voffB); PG8_STAGE(PG8_SA(1, 0), cA + kstep, voffA); PG8_STAGE(PG8_SB(1, 1), cB + hstep + kstep, voffB);
    PG8_WAIT_V(6); PG8_BAR;
    for (;;) {
        const bool has_next = S.next(ui + 1, nxt);
        const char* nA = has_next ? (const char*)g.A + (size_t)nxt.pm * tstep : cA; const char* nB = has_next ? (const char*)g.Bt + (size_t)nxt.pn * tstep : cB;
        for (int t = 0; t < nt; t += 2) {
            const bool last = (t == nt - 2);
            const char* a1 = cA + (size_t)(t + 1) * kstep;
            const char* a2 = last ? nA : cA + (size_t)(t + 2) * kstep; const char* b2 = last ? nB : cB + (size_t)(t + 2) * kstep;
            const char* a3 = a2 + kstep; const char* b3 = b2 + kstep;
            PG8_LDB(B0, 0, 0); PG8_SCHED; PG8_LDA(At, 0, 0); PG8_STAGE(PG8_SA(1, 1), a1 + hstep, voffA);
            PG8_WAIT_L(8); PG8_BAR; PG8_WAIT_L(0); PG8_MMA(0, 0, At, B0); PG8_BAR; PG8_SCHED;
            PG8_LDB(B1, 0, 1); PG8_STAGE(PG8_SB(0, 0), b2, voffB);
            PG8_BAR; PG8_WAIT_L(0); PG8_MMA(0, 1, At, B1); PG8_BAR;
            PG8_LDA(At, 0, 1); PG8_STAGE(PG8_SA(0, 0), a2, voffA);
            PG8_BAR; PG8_WAIT_L(0); PG8_MMA(1, 0, At, B0); PG8_BAR; PG8_SCHED;
            PG8_STAGE(PG8_SB(0, 1), b2 + hstep, voffB);
            PG8_WAIT_V(6); PG8_BAR; PG8_MMA(1, 1, At, B1); PG8_BAR;
            PG8_LDB(B0, 1, 0); PG8_SCHED; PG8_LDA(At, 1, 0); PG8_STAGE(PG8_SA(0, 1), a2 + hstep, voffA);
            PG8_WAIT_L(8); PG8_BAR; PG8_WAIT_L(0); PG8_MMA(0, 0, At, B0); PG8_BAR; PG8_SCHED;
            PG8_LDB(B1, 1, 1); PG8_STAGE(PG8_SB(1, 0), b3, voffB);
            PG8_BAR; PG8_WAIT_L(0); PG8_MMA(0, 1, At, B1); PG8_BAR;
            PG8_LDA(At, 1, 1); PG8_STAGE(PG8_SA(1, 0), a3, voffA);
            PG8_BAR; PG8_WAIT_L(0); PG8_MMA(1, 0, At, B0); PG8_BAR; PG8_SCHED;
            PG8_STAGE(PG8_SB(1, 1), b3 + hstep, voffB);
            PG8_WAIT_V(6); PG8_BAR; PG8_MMA(1, 1, At, B1); PG8_BAR;
        }
        E(acc, cur, wr, wc, fr, fq);
        if (!has_next) break;
#pragma unroll
        for (int a = 0; a < 2; ++a)
#pragma unroll
            for (int b = 0; b < 2; ++b)
#pragma unroll
                for (int m = 0; m < 4; ++m)
#pragma unroll
                    for (int n = 0; n < 2; ++n) acc[a][b][m][n] = (f32x4){0.f, 0.f, 0.f, 0.f};
        cur = nxt; cA = nA; cB = nB; ++ui;
    }
    PG8_WAIT_V(0);
    if (wr == 0) PG8_BAR;
    PG8_BAR;
#undef PG8_SA
#undef PG8_SB
#undef PG8_STAGE
#undef PG8_LDA
#undef PG8_LDB
#undef PG8_MMA
#undef PG8_WAIT_V
#undef PG8_WAIT_L
#undef PG8_BAR
#undef PG8_SCHED
}
}

enum { WM_ID = 0, WM_GU, WM_GIN, WM_LIM320, WM_LIM384 };
DI int wmap(int mode, int r) {
    switch (mode) {
        case WM_GU: { const int t = r >> 8, w = r & 255; return w < 128 ? t * 128 + w : DFF + t * 128 + (w - 128); }
        case WM_GIN: return r < 2048 ? r : (r < 3072 ? r + 16 : (r < 3088 ? r - 1024 : -1));
        case WM_LIM320: return r < 320 ? r : -1;
        case WM_LIM384: return r < 384 ? r : -1;
        default: return r;
    }
}
DI void convert_w(LAS unsigned char* lds, const float* __restrict__ src, int K, int N, bf16_t* __restrict__ dst, int Nd, int mode) {
    LAS float* tile = (LAS float*)lds;
    const int tid = lthread(), ntk = K >> 6, ntiles = (Nd >> 6) * ntk;
    const int lk = tid >> 3, lj = (tid & 7) * 8;
    const int sj = tid >> 3, sk = (tid & 7) * 8;
    for (int t = lblock(); t < ntiles; t += gridDim.x) {
        const int r0 = (t / ntk) << 6, k0 = (t % ntk) << 6;
        const int n0 = wmap(mode, r0 + lj), n7 = wmap(mode, r0 + lj + 7);
        const float* sp = src + (size_t)(k0 + lk) * N;
        if (n0 >= 0 && n7 == n0 + 7 && ((N & 3) == 0) && ((n0 & 3) == 0)) {
            const f32x4 a = *(const f32x4*)(sp + n0), b = *(const f32x4*)(sp + n0 + 4);
            tile[lk * 65 + lj] = a[0]; tile[lk * 65 + lj + 1] = a[1]; tile[lk * 65 + lj + 2] = a[2]; tile[lk * 65 + lj + 3] = a[3];
            tile[lk * 65 + lj + 4] = b[0]; tile[lk * 65 + lj + 5] = b[1]; tile[lk * 65 + lj + 6] = b[2]; tile[lk * 65 + lj + 7] = b[3];
        } else {
#pragma unroll
            for (int j = 0; j < 8; ++j) { const int n = wmap(mode, r0 + lj + j); tile[lk * 65 + lj + j] = (n >= 0) ? sp[n] : 0.f; }
        }
        __syncthreads();
        { u32x4 pk;
#pragma unroll
          for (int j2 = 0; j2 < 4; ++j2) pk[j2] = pk2(tile[(sk + 2 * j2) * 65 + sj], tile[(sk + 2 * j2 + 1) * 65 + sj]);
          *(u32x4*)(dst + (size_t)(r0 + sj) * K + k0 + sk) = pk; }
        __syncthreads();
    }
}
DI void convert_ffn(LAS unsigned char* lds, const Prm& p, int l, int f) {
    const int idx = l * 2 + f;
    convert_w(lds, p.ffn_gu + (size_t)idx * 1024 * 5632, 1024, 5632, (bf16_t*)(p.ws + OFF_WGU), 5632, WM_GU);
    convert_w(lds, p.ffn_dn + (size_t)idx * 2816 * 1024, 2816, 1024, (bf16_t*)(p.ws + OFF_WDN), 1024, WM_ID);
}

DI void mods_phase(LAS unsigned char* lds, const Prm& p) {
    LAS float* cact = (LAS float*)lds;
    LAS float* red = (LAS float*)(lds + 32768);
    const int tid = lthread();
    for (int i = tid; i < 8192; i += NTHREADS) cact[i] = silu_f(p.c[i]);
    __syncthreads();
    float* mods = (float*)(p.ws + OFF_MODS); float* kvm = (float*)(p.ws + OFF_KVMODS);
    for (int item = lblock(); item < 320; item += gridDim.x) {
        const int col0 = item * 64;
        const float* W; int N, cc; const float* bias; float* out; int obs;
        if (col0 < 18432) { const int l = col0 / 9216; cc = col0 - l * 9216; W = p.cond_w + (size_t)l * 1024 * 9216; N = 9216; bias = p.cond_b + l * 9216; out = mods + (size_t)l * 8 * 9216; obs = 9216; }
        else { cc = col0 - 18432; W = p.kv_cond_w; N = 2048; bias = p.kv_cond_b; out = kvm; obs = 2048; }
        const int j = tid & 63, kg = tid >> 6;
        float a0 = 0.f, a1 = 0.f, a2 = 0.f, a3 = 0.f, a4 = 0.f, a5 = 0.f, a6 = 0.f, a7 = 0.f;
        const float* wp = W + (size_t)(kg * 128) * N + cc + j;
#pragma unroll 16
        for (int k = 0; k < 128; ++k) { const float w = wp[(size_t)k * N]; const int kk = kg * 128 + k;
            a0 += cact[kk] * w; a1 += cact[1024 + kk] * w; a2 += cact[2048 + kk] * w; a3 += cact[3072 + kk] * w;
            a4 += cact[4096 + kk] * w; a5 += cact[5120 + kk] * w; a6 += cact[6144 + kk] * w; a7 += cact[7168 + kk] * w; }
        red[(kg * 8 + 0) * 64 + j] = a0; red[(kg * 8 + 1) * 64 + j] = a1; red[(kg * 8 + 2) * 64 + j] = a2; red[(kg * 8 + 3) * 64 + j] = a3;
        red[(kg * 8 + 4) * 64 + j] = a4; red[(kg * 8 + 5) * 64 + j] = a5; red[(kg * 8 + 6) * 64 + j] = a6; red[(kg * 8 + 7) * 64 + j] = a7;
        __syncthreads();
        { const int b = tid >> 6; float s = bias[cc + j];
#pragma unroll
          for (int q = 0; q < 8; ++q) s += red[(q * 8 + b) * 64 + j];
          out[(size_t)b * obs + cc + j] = s; }
        __syncthreads();
    }
}
DI void rope_tables(const Prm& p) {
    float* COS = (float*)(p.ws + OFF_COS); float* SIN = (float*)(p.ws + OFF_SIN);
    const int gt = lblock() * NTHREADS + lthread(), nth = gridDim.x * NTHREADS;
    for (int idx = gt; idx < T * 32; idx += nth) {
        const int t = idx >> 5, i = idx & 31;
        const float inv = powf(10000.f, -(float)(2 * i) / 64.f);
        const float ang = (float)p.pos[t] * inv;
        COS[idx] = cosf(ang); SIN[idx] = sinf(ang);
    }
}

struct RowP {
    const float* xin_f; const bf16_t* xin_b; const bf16_t* y; float* xout_f; bf16_t* xout_b; float rw; const float* gate; int gate_bs; const float* g_post;
    const float* g1; const float* sh1; const float* sc1; int bs1; bf16_t* h1;
    const float* g2; const float* sh2; const float* sc2; int bs2; bf16_t* h2;
};
DI void rowwise_phase(const RowP& a) {
    const int tidx_ = lthread(); const int lane = tidx_ & 63, gw = lblock() * 8 + (tidx_ >> 6), nw = gridDim.x * 8;
    u32x2 xr[4], yr[4];
#pragma unroll
    for (int i = 0; i < 4; ++i) { xr[i] = (u32x2){0u, 0u}; yr[i] = (u32x2){0u, 0u}; }
    f32x4 xf[4];
#pragma unroll
    for (int i = 0; i < 4; ++i) xf[i] = (f32x4){0.f, 0.f, 0.f, 0.f};
#define ROW_LOADF(row_, xfd) do { if (a.xin_f) { _Pragma("unroll") for (int i = 0; i < 4; ++i) xfd[i] = *(const f32x4*)(a.xin_f + (size_t)(row_) * D + i * 256 + lane * 4); } } while (0)
#define ROW_LOAD(row_, xd, yd) do { \
        if (!a.xin_f) { _Pragma("unroll") for (int i = 0; i < 4; ++i) xd[i] = *(const u32x2*)(a.xin_b + (size_t)(row_) * D + i * 256 + lane * 4); } \
        if (a.y) { _Pragma("unroll") for (int i = 0; i < 4; ++i) yd[i] = *(const u32x2*)(a.y + (size_t)(row_) * D + i * 256 + lane * 4); } } while (0)
    if (gw < T) { ROW_LOAD(gw, xr, yr); ROW_LOADF(gw, xf); }
    for (int row = gw; row < T; row += nw) {
        const int b = row >> 12;
        u32x2 xn[4], yn[4];
#pragma unroll
        for (int i = 0; i < 4; ++i) { xn[i] = (u32x2){0u, 0u}; yn[i] = (u32x2){0u, 0u}; }
        f32x4 xfn[4];
#pragma unroll
        for (int i = 0; i < 4; ++i) xfn[i] = (f32x4){0.f, 0.f, 0.f, 0.f};
        if (row + nw < T) { ROW_LOAD(row + nw, xn, yn); ROW_LOADF(row + nw, xfn); }
        f32x4 xv[4];
        if (a.xin_f) {
#pragma unroll
            for (int i = 0; i < 4; ++i) xv[i] = xf[i];
        } else {
#pragma unroll
            for (int i = 0; i < 4; ++i) { xv[i][0] = lo_f(xr[i][0]); xv[i][1] = hi_f(xr[i][0]); xv[i][2] = lo_f(xr[i][1]); xv[i][3] = hi_f(xr[i][1]); }
        }
        if (a.y) {
            f32x4 yv[4]; float ss = 0.f;
#pragma unroll
            for (int i = 0; i < 4; ++i) {
                yv[i][0] = lo_f(yr[i][0]); yv[i][1] = hi_f(yr[i][0]); yv[i][2] = lo_f(yr[i][1]); yv[i][3] = hi_f(yr[i][1]);
                ss += yv[i][0] * yv[i][0] + yv[i][1] * yv[i][1] + yv[i][2] * yv[i][2] + yv[i][3] * yv[i][3]; }
            ss = wave_sum(ss);
            const float rstd = rsqrtf(ss * (1.f / D) + EPS) * a.rw;
#pragma unroll
            for (int i = 0; i < 4; ++i) { const int col = i * 256 + lane * 4;
                const f32x4 gt = *(const f32x4*)(a.gate + (size_t)b * a.gate_bs + col), gp = *(const f32x4*)(a.g_post + col);
                xv[i] = xv[i] + gt * (yv[i] * rstd) * gp;
                if (a.xout_f) *(f32x4*)(a.xout_f + (size_t)row * D + col) = xv[i];
                else { u32x2 pk; pk[0] = pk2(xv[i][0], xv[i][1]); pk[1] = pk2(xv[i][2], xv[i][3]); *(u32x2*)(a.xout_b + (size_t)row * D + col) = pk; } }
        }
        if (a.h1) {
            float ss = 0.f;
#pragma unroll
            for (int i = 0; i < 4; ++i) ss += xv[i][0] * xv[i][0] + xv[i][1] * xv[i][1] + xv[i][2] * xv[i][2] + xv[i][3] * xv[i][3];
            ss = wave_sum(ss);
            const float rstd = rsqrtf(ss * (1.f / D) + EPS);
#pragma unroll
            for (int i = 0; i < 4; ++i) { const int col = i * 256 + lane * 4;
                const f32x4 g = *(const f32x4*)(a.g1 + col), sc = *(const f32x4*)(a.sc1 + (size_t)b * a.bs1 + col), sh = *(const f32x4*)(a.sh1 + (size_t)b * a.bs1 + col);
                const f32x4 hv = (xv[i] * rstd) * g * (sc + 1.f) + sh;
                u32x2 pk; pk[0] = pk2(hv[0], hv[1]); pk[1] = pk2(hv[2], hv[3]);
                *(u32x2*)(a.h1 + (size_t)row * D + col) = pk; }
            if (a.h2) {
#pragma unroll
                for (int i = 0; i < 4; ++i) { const int col = i * 256 + lane * 4;
                    const f32x4 g = *(const f32x4*)(a.g2 + col), sc = *(const f32x4*)(a.sc2 + (size_t)b * a.bs2 + col), sh = *(const f32x4*)(a.sh2 + (size_t)b * a.bs2 + col);
                    const f32x4 hv = (xv[i] * rstd) * g * (sc + 1.f) + sh;
                    u32x2 pk; pk[0] = pk2(hv[0], hv[1]); pk[1] = pk2(hv[2], hv[3]);
                    *(u32x2*)(a.h2 + (size_t)row * D + col) = pk; }
            }
        }
#pragma unroll
        for (int i = 0; i < 4; ++i) { xr[i] = xn[i]; yr[i] = yn[i]; xf[i] = xfn[i]; }
    }
#undef ROW_LOAD
#undef ROW_LOADF
}

DI void ckv_phase(const Prm& p) {
    const float* raw = (const float*)(p.ws + OFF_Y); bf16_t* ckvn = (bf16_t*)(p.ws + OFF_CKVN); bf16_t* krope = (bf16_t*)(p.ws + OFF_KROPE);
    const float* COS = (const float*)(p.ws + OFF_COS); const float* SIN = (const float*)(p.ws + OFF_SIN);
    const int tidx_ = lthread(); const int lane = tidx_ & 63, gw = lblock() * 8 + (tidx_ >> 6), nw = gridDim.x * 8;
    for (int row = gw; row < T; row += nw) {
        const f32x4 v = *(const f32x4*)(raw + (size_t)row * 512 + lane * 4);
        float ss = wave_sum(v[0] * v[0] + v[1] * v[1] + v[2] * v[2] + v[3] * v[3]);
        const float rstd = rsqrtf(ss * (1.f / 256.f) + EPS);
        const f32x4 g = *(const f32x4*)(p.g_kv + lane * 4);
        u32x2 pk; pk[0] = pk2(v[0] * rstd * g[0], v[1] * rstd * g[1]); pk[1] = pk2(v[2] * rstd * g[2], v[3] * rstd * g[3]);
        *(u32x2*)(ckvn + (size_t)row * 256 + lane * 4) = pk;
        if (lane < 32) {
            const float x1 = raw[(size_t)row * 512 + 256 + lane], x2 = raw[(size_t)row * 512 + 288 + lane];
            const float c = COS[(size_t)row * 32 + lane], s = SIN[(size_t)row * 32 + lane];
            krope[(size_t)row * 64 + lane] = f2bf(x1 * c - x2 * s);
            krope[(size_t)row * 64 + 32 + lane] = f2bf(x1 * s + x2 * c);
        }
    }
}
DI void cq_phase(const Prm& p) {
    const float* raw = (const float*)(p.ws + OFF_Y); bf16_t* cqn = (bf16_t*)(p.ws + OFF_H);
    const int tidx_ = lthread(); const int lane = tidx_ & 63, gw = lblock() * 8 + (tidx_ >> 6), nw = gridDim.x * 8;
    for (int row = gw; row < T; row += nw) {
        f32x2 v[3]; float ss = 0.f;
#pragma unroll
        for (int i = 0; i < 3; ++i) { v[i] = *(const f32x2*)(raw + (size_t)row * 512 + i * 128 + lane * 2); ss += v[i][0] * v[i][0] + v[i][1] * v[i][1]; }
        ss = wave_sum(ss);
        const float rstd = rsqrtf(ss * (1.f / 384.f) + EPS);
#pragma unroll
        for (int i = 0; i < 3; ++i) { const f32x2 g = *(const f32x2*)(p.g_q + i * 128 + lane * 2);
            *(unsigned*)(cqn + (size_t)row * 384 + i * 128 + lane * 2) = pk2(v[i][0] * rstd * g[0], v[i][1] * rstd * g[1]); }
    }
}
DI void gla_gate_phase(const Prm& p) {
    const bf16_t* og = (const bf16_t*)(p.ws + OFF_Y); const bf16_t* proj = (const bf16_t*)(p.ws + OFF_BIG); bf16_t* hout = (bf16_t*)(p.ws + OFF_H);
    const bf16_t* oint = (const bf16_t*)(p.ws + OFF_BIG);
    const int tidx_ = lthread(); const int lane = tidx_ & 63, gw = lblock() * 8 + (tidx_ >> 6), nw = gridDim.x * 8;
    u32x4 nx[6];
#pragma unroll
    for (int i = 0; i < 6; ++i) nx[i] = (u32x4){0u, 0u, 0u, 0u};
#define GATE_LOAD(row_) do { nx[0] = *(const u32x4*)(og + (size_t)(row_) * D + lane * 16); nx[1] = *(const u32x4*)(og + (size_t)(row_) * D + lane * 16 + 8); \
        nx[2] = *(const u32x4*)(oint + (size_t)(row_) * 3328 + lane * 16); nx[3] = *(const u32x4*)(oint + (size_t)(row_) * 3328 + lane * 16 + 8); \
        nx[4] = *(const u32x4*)(proj + (size_t)(row_) * 3328 + 2048 + lane * 16); nx[5] = *(const u32x4*)(proj + (size_t)(row_) * 3328 + 2048 + lane * 16 + 8); } while (0)
    if (gw < T) GATE_LOAD(gw);
    for (int row = gw; row < T; row += nw) {
        f32x4 v[4]; float ss = 0.f;
        const u32x4 og0 = nx[0], og1 = nx[1], oi0 = nx[2], oi1 = nx[3], r0 = nx[4], r1 = nx[5];
        if (row + nw < T) GATE_LOAD(row + nw);
#pragma unroll
        for (int i = 0; i < 4; ++i) { const unsigned ga = (i < 2) ? og0[2 * i] : og1[2 * (i - 2)], gb = (i < 2) ? og0[2 * i + 1] : og1[2 * (i - 2) + 1];
            f32x4 oi; oi[0] = lo_f(ga); oi[1] = hi_f(ga); oi[2] = lo_f(gb); oi[3] = hi_f(gb);
            const unsigned ia = (i < 2) ? oi0[2 * i] : oi1[2 * (i - 2)], ib = (i < 2) ? oi0[2 * i + 1] : oi1[2 * (i - 2) + 1];
            f32x4 oj; oj[0] = lo_f(ia); oj[1] = hi_f(ia); oj[2] = lo_f(ib); oj[3] = hi_f(ib);
            v[i] = oi + oj;
            ss += v[i][0] * v[i][0] + v[i][1] * v[i][1] + v[i][2] * v[i][2] + v[i][3] * v[i][3]; }
#pragma unroll
        for (int o = 8; o > 0; o >>= 1) ss += __shfl_xor(ss, o);
        const float rstd = rsqrtf(ss * (1.f / 256.f) + EPS);
        const int gc = (lane & 15) * 16;
        u32x4 o0, o1;
#pragma unroll
        for (int i = 0; i < 4; ++i) {
            const f32x4 g = *(const f32x4*)(p.gla_g_out + gc + i * 4);
            const unsigned ra = (i < 2) ? r0[2 * i] : r1[2 * (i - 2)], rb = (i < 2) ? r0[2 * i + 1] : r1[2 * (i - 2) + 1];
            const float e0 = v[i][0] * rstd * g[0] * silu_f(lo_f(ra)), e1 = v[i][1] * rstd * g[1] * silu_f(hi_f(ra));
            const float e2 = v[i][2] * rstd * g[2] * silu_f(lo_f(rb)), e3 = v[i][3] * rstd * g[3] * silu_f(hi_f(rb));
            if (i < 2) { o0[2 * i] = pk2(e0, e1); o0[2 * i + 1] = pk2(e2, e3); } else { o1[2 * (i - 2)] = pk2(e0, e1); o1[2 * (i - 2) + 1] = pk2(e2, e3); }
        }
        *(u32x4*)(hout + (size_t)row * D + lane * 16) = o0; *(u32x4*)(hout + (size_t)row * D + lane * 16 + 8) = o1;
    }
#undef GATE_LOAD
}

DI bf16_t* gla_vt_ptr(unsigned char* ws, int ci) { return (bf16_t*)(ci < 1536 ? ws + OFF_VTA + (size_t)ci * 32768 : ws + OFF_CKVN + (size_t)(ci - 1536) * 32768); }
DI void gla_chunk_phase(LAS unsigned char* lds, const Prm& p) {
    const int tid = lthread(), wid = __builtin_amdgcn_readfirstlane(tid >> 6), lane = tid & 63, r = lane & 31, hf = lane >> 5;
    LAS float* GL = (LAS float*)(lds);
    LAS float* LA = (LAS float*)(lds + 4096);
    LAS unsigned char* ATT = lds + 4096;
    LAS float* SEG = (LAS float*)(lds + 36864);
    LAS float* BL = (LAS float*)(lds + 38912);
    LAS unsigned char* QD = lds + 39424;
    LAS unsigned char* KD = lds + 56832;
    LAS unsigned char* KUT = lds + 74240;
    LAS unsigned char* VTs = lds + 92672;
    const bf16_t* proj = (const bf16_t*)(p.ws + OFF_BIG); const float* glow = (const float*)(p.ws + OFF_GLOW); bf16_t* og = (bf16_t*)(p.ws + OFF_Y);
    bf16_t* QDg = (bf16_t*)(p.ws + OFF_H); bf16_t* KUTg = (bf16_t*)(p.ws + OFF_H + (size_t)2048 * 16384); float* DECg = (float*)(p.ws + OFF_DEC);
    const float qscale = 0.08838834764831845f;
    const int seg = tid >> 7, c = tid & 127;
    const int kp = tid >> 4, kc8 = tid & 15;
    const int vpp = tid >> 5, vc8 = tid & 31;
    const int grow = tid >> 2, gc4 = tid & 3;
    for (int ci = lblock(); ci < 2048; ci += gridDim.x) {
        const int b = ci >> 8, h = (ci >> 6) & 3, n = ci & 63;
        const size_t t0 = (size_t)b * SEQ + (size_t)n * 64;
        float wg[16];
#pragma unroll
        for (int q = 0; q < 16; ++q) wg[q] = p.gla_w_gate_up[q * 512 + h * 128 + c];
        const float bg = p.gla_b_gate[h * 128 + c];
        u32x4 qraw[2], kraw[2], vraw[4]; f32x4 glraw = {0.f, 0.f, 0.f, 0.f};
#pragma unroll
        for (int i = 0; i < 2; ++i) { const bf16_t* rp = proj + (t0 + 2 * kp + i) * 3328 + h * 128 + kc8 * 8; qraw[i] = *(const u32x4*)rp; kraw[i] = *(const u32x4*)(rp + 512); }
#pragma unroll
        for (int i = 0; i < 4; ++i) vraw[i] = *(const u32x4*)(proj + (t0 + 2 * vpp + (i & 1) + 32 * (i >> 1)) * 3328 + 1024 + h * 256 + vc8 * 8);
        if (tid < 256) glraw = *(const f32x4*)(glow + (t0 + grow) * 16 + gc4 * 4);
        if (tid < 256) *(LAS f32x4*)(GL + grow * 16 + gc4 * 4) = glraw;
        __syncthreads();
        float bs[16]; float run = 0.f;
#pragma unroll
        for (int i = 0; i < 16; ++i) { const int row = seg * 16 + i; float z = bg;
            const f32x4 g0 = *(const LAS f32x4*)(GL + row * 16), g1 = *(const LAS f32x4*)(GL + row * 16 + 4), g2 = *(const LAS f32x4*)(GL + row * 16 + 8), g3 = *(const LAS f32x4*)(GL + row * 16 + 12);
            z += g0[0] * wg[0] + g0[1] * wg[1] + g0[2] * wg[2] + g0[3] * wg[3] + g1[0] * wg[4] + g1[1] * wg[5] + g1[2] * wg[6] + g1[3] * wg[7]
               + g2[0] * wg[8] + g2[1] * wg[9] + g2[2] * wg[10] + g2[3] * wg[11] + g3[0] * wg[12] + g3[1] * wg[13] + g3[2] * wg[14] + g3[3] * wg[15];
            const float ls = fminf(z, 0.f) - __logf(1.f + __expf(-fabsf(z)));
            run += ls * 0.0625f; bs[i] = run; }
        SEG[seg * 128 + c] = run;
        __syncthreads();
        { float off = 0.f;
#pragma unroll
          for (int s = 0; s < 3; ++s) off += (s < seg) ? SEG[s * 128 + c] : 0.f;
#pragma unroll
          for (int i = 0; i < 16; ++i) LA[(seg * 16 + i) * 128 + c] = bs[i] + off;
          if (seg == 3) BL[c] = bs[15] + off; }
        __syncthreads();
        {
            const f32x4 l0 = *(const LAS f32x4*)(BL + kc8 * 8), l1 = *(const LAS f32x4*)(BL + kc8 * 8 + 4);
            f32x4 ba0 = *(const LAS f32x4*)(LA + (2 * kp) * 128 + kc8 * 8), ba1 = *(const LAS f32x4*)(LA + (2 * kp) * 128 + kc8 * 8 + 4);
            f32x4 bb0 = *(const LAS f32x4*)(LA + (2 * kp + 1) * 128 + kc8 * 8), bb1 = *(const LAS f32x4*)(LA + (2 * kp + 1) * 128 + kc8 * 8 + 4);
            u32x4 qd0, kd0, qd1, kd1;
            const int kcol = (kp ^ ((kc8 & 7) << 2)) * 4;
#pragma unroll
            for (int j2 = 0; j2 < 4; ++j2) {
                const float bl_a = (j2 < 2) ? l0[2 * j2] : l1[2 * (j2 - 2)], bl_b = (j2 < 2) ? l0[2 * j2 + 1] : l1[2 * (j2 - 2) + 1];
                const float a_a = (j2 < 2) ? ba0[2 * j2] : ba1[2 * (j2 - 2)], a_b = (j2 < 2) ? ba0[2 * j2 + 1] : ba1[2 * (j2 - 2) + 1];
                const float b_a = (j2 < 2) ? bb0[2 * j2] : bb1[2 * (j2 - 2)], b_b = (j2 < 2) ? bb0[2 * j2 + 1] : bb1[2 * (j2 - 2) + 1];
                const float q0a = lo_f(qraw[0][j2]), q0b = hi_f(qraw[0][j2]), k0a = lo_f(kraw[0][j2]), k0b = hi_f(kraw[0][j2]);
                const float q1a = lo_f(qraw[1][j2]), q1b = hi_f(qraw[1][j2]), k1a = lo_f(kraw[1][j2]), k1b = hi_f(kraw[1][j2]);
                qd0[j2] = pk2(q0a * qscale * __expf(a_a), q0b * qscale * __expf(a_b)); kd0[j2] = pk2(k0a * __expf(-a_a), k0b * __expf(-a_b));
                qd1[j2] = pk2(q1a * qscale * __expf(b_a), q1b * qscale * __expf(b_b)); kd1[j2] = pk2(k1a * __expf(-b_a), k1b * __expf(-b_b));
                *(LAS unsigned*)(KUT + (kc8 * 8 + 2 * j2) * 144 + kcol) = pk2(k0a * __expf(bl_a - a_a), k1a * __expf(bl_a - b_a));
                *(LAS unsigned*)(KUT + (kc8 * 8 + 2 * j2 + 1) * 144 + kcol) = pk2(k0b * __expf(bl_b - a_b), k1b * __expf(bl_b - b_b));
            }
            *(LAS u32x4*)(QD + ((2 * kp) * 136 + kc8 * 8) * 2) = qd0; *(LAS u32x4*)(KD + ((2 * kp) * 136 + kc8 * 8) * 2) = kd0;
            *(LAS u32x4*)(QD + ((2 * kp + 1) * 136 + kc8 * 8) * 2) = qd1; *(LAS u32x4*)(KD + ((2 * kp + 1) * 136 + kc8 * 8) * 2) = kd1;
        }
        {
            const int vcol0 = (vpp ^ ((vc8 & 7) << 2)) * 4, vcol1 = ((vpp + 16) ^ ((vc8 & 7) << 2)) * 4;
#pragma unroll
            for (int j2 = 0; j2 < 4; ++j2) {
                *(LAS unsigned*)(VTs + (vc8 * 8 + 2 * j2) * 144 + vcol0) = (vraw[0][j2] & 0xffffu) | (vraw[1][j2] << 16);
                *(LAS unsigned*)(VTs + (vc8 * 8 + 2 * j2 + 1) * 144 + vcol0) = (vraw[0][j2] >> 16) | (vraw[1][j2] & 0xffff0000u);
                *(LAS unsigned*)(VTs + (vc8 * 8 + 2 * j2) * 144 + vcol1) = (vraw[2][j2] & 0xffffu) | (vraw[3][j2] << 16);
                *(LAS unsigned*)(VTs + (vc8 * 8 + 2 * j2 + 1) * 144 + vcol1) = (vraw[2][j2] >> 16) | (vraw[3][j2] & 0xffff0000u); }
        }
        __syncthreads();
        if (wid < 4) {
            const int ti = wid >> 1, tj = wid & 1;
            f32x16 acc;
#pragma unroll
            for (int q = 0; q < 16; ++q) acc[q] = 0.f;
            if (tj <= ti) {
#pragma unroll
                for (int ks = 0; ks < 8; ++ks) {
                    const bf16x8 a = *(const LAS bf16x8*)(QD + ((32 * ti + r) * 136 + ks * 16 + 8 * hf) * 2);
                    const bf16x8 bb = *(const LAS bf16x8*)(KD + ((32 * tj + r) * 136 + ks * 16 + 8 * hf) * 2);
                    acc = MFMA32(a, bb, acc); }
            }
#pragma unroll
            for (int q = 0; q < 16; ++q) { const int i = 32 * ti + crow(q, hf), j = 32 * tj + r;
                const float v = (j <= i) ? acc[q] : 0.f;
                *(LAS bf16_t*)(ATT + (i * 72 + j) * 2) = f2bf(v); }
        }
        {
#pragma unroll
            for (int i = 0; i < 2; ++i) { const int e = tid + 512 * i, row = e >> 4, c8 = e & 15;
                *(u32x4*)(QDg + (size_t)ci * 8192 + row * 128 + c8 * 8) = *(const LAS u32x4*)(QD + (row * 136 + c8 * 8) * 2); }
#pragma unroll
            for (int i = 0; i < 2; ++i) { const int e = tid + 512 * i, row = e >> 3, c8 = e & 7;
                *(u32x4*)(KUTg + (size_t)ci * 8192 + row * 64 + c8 * 8) = *(const LAS u32x4*)(KUT + row * 144 + 16 * (c8 ^ ((row >> 3) & 7))); }
            bf16_t* vtg = gla_vt_ptr(p.ws, ci);
#pragma unroll
            for (int i = 0; i < 4; ++i) { const int e = tid + 512 * i, row = e >> 3, c8 = e & 7;
                *(u32x4*)(vtg + row * 64 + c8 * 8) = *(const LAS u32x4*)(VTs + row * 144 + 16 * (c8 ^ ((row >> 3) & 7))); }
            if (tid < 32) { const f32x4 bl = *(const LAS f32x4*)(BL + tid * 4); f32x4 d; d[0] = __expf(bl[0]); d[1] = __expf(bl[1]); d[2] = __expf(bl[2]); d[3] = __expf(bl[3]);
                *(f32x4*)(DECg + (size_t)ci * 128 + tid * 4) = d; }
        }
        __syncthreads();
        {
            f32x16 acc0, acc1;
#pragma unroll
            for (int q = 0; q < 16; ++q) { acc0[q] = 0.f; acc1[q] = 0.f; }
            const int dv = 32 * wid + r, sw = (dv >> 3) & 7;
#pragma unroll
            for (int ks = 0; ks < 4; ++ks) {
                const bf16x8 a0 = *(const LAS bf16x8*)(ATT + (r * 72 + ks * 16 + 8 * hf) * 2);
                const bf16x8 a1 = *(const LAS bf16x8*)(ATT + ((32 + r) * 72 + ks * 16 + 8 * hf) * 2);
                const bf16x8 bb = *(const LAS bf16x8*)(VTs + dv * 144 + 16 * ((2 * ks + hf) ^ sw));
                acc0 = MFMA32(a0, bb, acc0); acc1 = MFMA32(a1, bb, acc1); }
#pragma unroll
            for (int q = 0; q < 16; ++q) { og[(t0 + crow(q, hf)) * D + h * 256 + dv] = f2bf(acc0[q]); og[(t0 + 32 + crow(q, hf)) * D + h * 256 + dv] = f2bf(acc1[q]); }
        }
        __syncthreads();
    }
}

DI void gla_scan_phase(LAS unsigned char* lds, const Prm& p) {
    const int tid = lthread(), wid = __builtin_amdgcn_readfirstlane(tid >> 6), lane = tid & 63, r = lane & 31, hf = lane >> 5;
    constexpr int BUF = 36352;
    bf16_t* oint = (bf16_t*)(p.ws + OFF_BIG);
    const bf16_t* QDg = (const bf16_t*)(p.ws + OFF_H); const bf16_t* KUTg = (const bf16_t*)(p.ws + OFF_H + (size_t)2048 * 16384); const float* DECg = (const float*)(p.ws + OFF_DEC);
    for (int item = lblock(); item < 256; item += gridDim.x) {
        const int bh = item >> 3, sl = item & 7;
        const int b = bh >> 2, h = bh & 3;
        const int ci0 = bh * 64;
        const int dv = 32 * sl + r;
        f32x16 S[4];
#pragma unroll
        for (int t = 0; t < 4; ++t)
#pragma unroll
            for (int q = 0; q < 16; ++q) S[t][q] = 0.f;
        u32x4 sq[2], sk[2]; f32x4 sd = {0.f, 0.f, 0.f, 0.f}; bf16x8 vf[4], vfn[4];
        const int qrow = tid >> 4, qc8 = tid & 15;
        const int krow = tid >> 3, kc8 = tid & 7;
#define SCAN_LOAD(ci_) do { const bf16_t* qg_ = QDg + (size_t)(ci_) * 8192; const bf16_t* kg_ = KUTg + (size_t)(ci_) * 8192; \
        sq[0] = *(const u32x4*)(qg_ + qrow * 128 + qc8 * 8); sq[1] = *(const u32x4*)(qg_ + (qrow + 32) * 128 + qc8 * 8); \
        sk[0] = *(const u32x4*)(kg_ + krow * 64 + kc8 * 8); sk[1] = *(const u32x4*)(kg_ + (krow + 64) * 64 + kc8 * 8); \
        if (tid < 32) sd = *(const f32x4*)(DECg + (size_t)(ci_) * 128 + tid * 4); } while (0)
#define SCAN_STORE(buf_) do { LAS unsigned char* b_ = lds + (buf_) * BUF; \
        *(LAS u32x4*)(b_ + (qrow * 136 + qc8 * 8) * 2) = sq[0]; *(LAS u32x4*)(b_ + ((qrow + 32) * 136 + qc8 * 8) * 2) = sq[1]; \
        *(LAS u32x4*)(b_ + 17408 + (krow * 72 + kc8 * 8) * 2) = sk[0]; *(LAS u32x4*)(b_ + 17408 + ((krow + 64) * 72 + kc8 * 8) * 2) = sk[1]; \
        if (tid < 32) *(LAS f32x4*)(b_ + 35840 + tid * 16) = sd; } while (0)
#define SCAN_VLOAD(dst, ci_) do { const bf16_t* vg_ = gla_vt_ptr(p.ws, (ci_)) + dv * 64 + 8 * hf; \
        _Pragma("unroll") for (int ks = 0; ks < 4; ++ks) dst[ks] = *(const bf16x8*)(vg_ + ks * 16); } while (0)
        SCAN_LOAD(ci0); if (wid == 0) SCAN_VLOAD(vf, ci0); SCAN_STORE(0);
        __syncthreads();
        for (int n = 0; n < 64; ++n) {
            const int cur = n & 1;
            const bool more = (n + 1 < 64);
            if (more) { SCAN_LOAD(ci0 + n + 1); if (wid == 0) SCAN_VLOAD(vfn, ci0 + n + 1); }
            if (wid == 0) {
            const LAS unsigned char* qb = lds + cur * BUF; const LAS unsigned char* kb = qb + 17408; const LAS float* db = (const LAS float*)(qb + 35840);
            const size_t t0 = (size_t)b * SEQ + (size_t)n * 64;
            bf16_t* op = oint + t0 * 3328 + h * 256 + dv;
            f32x16 a0, a1;
#pragma unroll
            for (int q = 0; q < 16; ++q) { a0[q] = 0.f; a1[q] = 0.f; }
#pragma unroll
            for (int t = 0; t < 4; ++t)
#pragma unroll
                for (int s = 0; s < 2; ++s) {
                    u32x4 sp;
#pragma unroll
                    for (int j2 = 0; j2 < 4; ++j2) sp[j2] = pk2(S[t][8 * s + 2 * j2], S[t][8 * s + 2 * j2 + 1]);
                    const int dk0 = 32 * t + 16 * s + 4 * hf;
                    const u32x2 l0 = *(const LAS u32x2*)(qb + (r * 136 + dk0) * 2), h0 = *(const LAS u32x2*)(qb + (r * 136 + dk0 + 8) * 2);
                    const u32x2 l1 = *(const LAS u32x2*)(qb + ((32 + r) * 136 + dk0) * 2), h1 = *(const LAS u32x2*)(qb + ((32 + r) * 136 + dk0 + 8) * 2);
                    u32x4 f0, f1; f0[0] = l0[0]; f0[1] = l0[1]; f0[2] = h0[0]; f0[3] = h0[1]; f1[0] = l1[0]; f1[1] = l1[1]; f1[2] = h1[0]; f1[3] = h1[1];
                    a0 = MFMA32(__builtin_bit_cast(bf16x8, f0), __builtin_bit_cast(bf16x8, sp), a0);
                    a1 = MFMA32(__builtin_bit_cast(bf16x8, f1), __builtin_bit_cast(bf16x8, sp), a1); }
#pragma unroll
            for (int q = 0; q < 16; ++q) { op[(size_t)crow(q, hf) * 3328] = f2bf(a0[q]); op[(size_t)(32 + crow(q, hf)) * 3328] = f2bf(a1[q]); }
#pragma unroll
            for (int t = 0; t < 4; ++t) {
#pragma unroll
                for (int g = 0; g < 4; ++g) { const f32x4 d4 = *(const LAS f32x4*)(db + 32 * t + 8 * g + 4 * hf);
                    S[t][4 * g] *= d4[0]; S[t][4 * g + 1] *= d4[1]; S[t][4 * g + 2] *= d4[2]; S[t][4 * g + 3] *= d4[3]; }
#pragma unroll
                for (int ks = 0; ks < 4; ++ks) {
                    const bf16x8 a = *(const LAS bf16x8*)(kb + ((32 * t + r) * 72 + ks * 16 + 8 * hf) * 2);
                    S[t] = MFMA32(a, vf[ks], S[t]); }
            }
            }
            if (more) { SCAN_STORE(cur ^ 1);
#pragma unroll
                for (int ks = 0; ks < 4; ++ks) vf[ks] = vfn[ks]; }
            __syncthreads();
        }
#undef SCAN_LOAD
#undef SCAN_STORE
#undef SCAN_VLOAD
    }
}

DI void attn_phase(LAS unsigned char* lds, const Prm& p) {
    const int tid = lthread(), wid = __builtin_amdgcn_readfirstlane(tid >> 6), lane = tid & 63, r = lane & 31, hf = lane >> 5;
    constexpr int KT_STRIDE = 400, KT_BYTES = 64 * KT_STRIDE, VT_STRIDE = 144, VT_BYTES = 128 * VT_STRIDE;
    LAS unsigned char* KT = lds;
    LAS unsigned char* VT = lds + 2 * KT_BYTES;
    const bf16_t* Q = (const bf16_t*)(p.ws + OFF_BIG + (size_t)T * 2048 * 2); const bf16_t* KV = (const bf16_t*)(p.ws + OFF_BIG);
    const bf16_t* KR = (const bf16_t*)(p.ws + OFF_KROPE); bf16_t* AO = (bf16_t*)(p.ws + OFF_H);
    const float* COS = (const float*)(p.ws + OFF_COS); const float* SIN = (const float*)(p.ws + OFF_SIN);
    const float SC = 0.07216878364870322f * 1.4426950408889634f;
    for (int it = lblock(); it < 1024; it += gridDim.x) {
        const int pass = it >> 8, blk = it & 255, bh = blk & 63, g = blk >> 6;
        const int qt = (pass == 0) ? g : (pass == 1) ? 7 - g : (pass == 2) ? 8 + g : 15 - g;
        const int b = bh >> 3, h = bh & 7, q0 = qt * 256;
        const size_t tok0 = (size_t)b * SEQ;
        const int qpos = q0 + 32 * wid + r;
        const size_t qrow = tok0 + qpos;
        bf16x8 qf[12];
        { const bf16_t* qp = Q + qrow * 1536 + h * 192 + 8 * hf;
#pragma unroll
          for (int ks = 0; ks < 12; ++ks) qf[ks] = *(const bf16x8*)(qp + ks * 16);
#pragma unroll
          for (int pr = 0; pr < 2; ++pr) {
              const int i0 = 16 * pr + 8 * hf;
              const f32x4 c0 = *(const f32x4*)(COS + qrow * 32 + i0), c1 = *(const f32x4*)(COS + qrow * 32 + i0 + 4);
              const f32x4 s0 = *(const f32x4*)(SIN + qrow * 32 + i0), s1 = *(const f32x4*)(SIN + qrow * 32 + i0 + 4);
              bf16x8 x1v = qf[8 + pr], x2v = qf[10 + pr], o1, o2;
#pragma unroll
              for (int j = 0; j < 8; ++j) { const float cc = (j < 4) ? c0[j & 3] : c1[j & 3], ss = (j < 4) ? s0[j & 3] : s1[j & 3];
                  const float x1 = bf2f((unsigned short)x1v[j]), x2 = bf2f((unsigned short)x2v[j]);
                  o1[j] = (short)f2bf(x1 * cc - x2 * ss); o2[j] = (short)f2bf(x1 * ss + x2 * cc); }
              qf[8 + pr] = o1; qf[10 + pr] = o2; } }
        float m = -1e30f, l = 0.f;
        f32x16 O[4];
#pragma unroll
        for (int d = 0; d < 4; ++d)
#pragma unroll
            for (int q = 0; q < 16; ++q) O[d][q] = 0.f;
        const int nkt = 4 * (qt + 1);
        u32x4 kraw[3], vraw[2];
        const int kkey = tid >> 4, kc8 = tid & 15;
        const int rkey = tid >> 3, rc8 = tid & 7;
        const int vp = tid & 31, vc8 = tid >> 5;
        const int vpp = (vp & ~6) | ((vp & 2) << 1) | ((vp & 4) >> 1);
        const int vrd = r * VT_STRIDE + 16 * hf;
const unsigned offk0 = (unsigned)(kkey * 2048 + kc8 * 8), offk1 = offk0 + 32u * 2048u, offr = (unsigned)(rkey * 64 + rc8 * 8);
        const unsigned offv0 = (unsigned)(2 * vp * 2048 + 128 + vc8 * 8), offv1 = offv0 + 2048u;
        const bf16_t* kvb0 = KV + tok0 * 2048 + h * 256; const bf16_t* krb0 = KR + tok0 * 64;
#define ATT_LOAD(kt_) do { const bf16_t* kvb_ = kvb0 + (size_t)(kt_) * 64 * 2048; const bf16_t* krb_ = krb0 + (size_t)(kt_) * 64 * 64; \
        kraw[0] = *(const u32x4*)(kvb_ + offk0); kraw[1] = *(const u32x4*)(kvb_ + offk1); \
        kraw[2] = *(const u32x4*)(krb_ + offr); \
        vraw[0] = *(const u32x4*)(kvb_ + offv0); vraw[1] = *(const u32x4*)(kvb_ + offv1); } while (0)
#define ATT_STORE(buf_) do { LAS unsigned char* kt_ = KT + (buf_) * KT_BYTES; LAS unsigned char* vt_ = VT + (buf_) * VT_BYTES; \
        *(LAS u32x4*)(kt_ + kkey * KT_STRIDE + kc8 * 16) = kraw[0]; *(LAS u32x4*)(kt_ + (kkey + 32) * KT_STRIDE + kc8 * 16) = kraw[1]; \
        *(LAS u32x4*)(kt_ + rkey * KT_STRIDE + 256 + rc8 * 16) = kraw[2]; \
        _Pragma("unroll") for (int j2 = 0; j2 < 4; ++j2) { \
            const unsigned lo_ = (vraw[0][j2] & 0xffffu) | (vraw[1][j2] << 16), hi_ = (vraw[0][j2] >> 16) | (vraw[1][j2] & 0xffff0000u); \
            *(LAS unsigned*)(vt_ + (vc8 * 8 + 2 * j2) * VT_STRIDE + 4 * vpp) = lo_; \
            *(LAS unsigned*)(vt_ + (vc8 * 8 + 2 * j2 + 1) * VT_STRIDE + 4 * vpp) = hi_; } } while (0)
        ATT_LOAD(0); ATT_STORE(0);
        __syncthreads();
        for (int kt = 0; kt < nkt; ++kt) {
            const int cur = kt & 1;
            const bool more = (kt + 1 < nkt);
            if (more) ATT_LOAD(kt + 1);
            const int kbase = kt * 64;
            if (kbase <= q0 + 32 * wid + 31) {
                const LAS unsigned char* ktb = KT + cur * KT_BYTES; const LAS unsigned char* vtb = VT + cur * VT_BYTES;
                f32x16 s0, s1;
#pragma unroll
                for (int q = 0; q < 16; ++q) { s0[q] = 0.f; s1[q] = 0.f; }
                __builtin_amdgcn_s_setprio(1);
#pragma unroll
                for (int ks = 0; ks < 12; ++ks) {
                    const bf16x8 a0 = *(const LAS bf16x8*)(ktb + r * KT_STRIDE + ks * 32 + 16 * hf);
                    const bf16x8 a1 = *(const LAS bf16x8*)(ktb + (32 + r) * KT_STRIDE + ks * 32 + 16 * hf);
                    s0 = MFMA32(a0, qf[ks], s0); s1 = MFMA32(a1, qf[ks], s1);
                    }
                __builtin_amdgcn_s_setprio(0);
                const bool diag = (kbase + 63 > q0 + 32 * wid);
                float mx = -1e30f;
#pragma unroll
                for (int q = 0; q < 16; ++q) {
                    float v0 = s0[q], v1 = s1[q];
                    if (diag) { const int key = kbase + crow(q, hf); if (key > qpos) v0 = -1e30f; if (key + 32 > qpos) v1 = -1e30f; }
                    s0[q] = v0; s1[q] = v1; mx = fmaxf(mx, fmaxf(v0, v1)); }
                mx = xmax32(mx) * SC;
                const float mn = fmaxf(m, mx), alpha = __builtin_amdgcn_exp2f(m - mn);
                const bool changed = __builtin_amdgcn_ballot_w64(mn > m) != 0ull;
                m = mn;
                float ls = 0.f;
#pragma unroll
                for (int q = 0; q < 16; ++q) { s0[q] = __builtin_amdgcn_exp2f(__builtin_fmaf(s0[q], SC, -mn)); s1[q] = __builtin_amdgcn_exp2f(__builtin_fmaf(s1[q], SC, -mn)); ls += s0[q] + s1[q]; }
                l = l * alpha + ls;
                if (changed) {
#pragma unroll
                    for (int d = 0; d < 4; ++d)
#pragma unroll
                        for (int q = 0; q < 16; ++q) O[d][q] *= alpha;
                }
                bf16x8 pb[2][2];
#pragma unroll
                for (int s = 0; s < 2; ++s) {
                    u32x4 t0, t1;
#pragma unroll
                    for (int j2 = 0; j2 < 4; ++j2) { t0[j2] = pk2(s0[8 * s + 2 * j2], s0[8 * s + 2 * j2 + 1]); t1[j2] = pk2(s1[8 * s + 2 * j2], s1[8 * s + 2 * j2 + 1]); }
                    pb[0][s] = __builtin_bit_cast(bf16x8, t0); pb[1][s] = __builtin_bit_cast(bf16x8, t1); }
#pragma unroll
                for (int d = 0; d < 4; ++d) {
#pragma unroll
                    for (int ksub = 0; ksub < 2; ++ksub)
#pragma unroll
                        for (int s = 0; s < 2; ++s) {
                            const bf16x8 av = *(const LAS bf16x8*)(vtb + vrd + d * 32 * VT_STRIDE + 32 * (2 * ksub + s));
                            O[d] = MFMA32(av, pb[ksub][s], O[d]); }
                }
            }
            if (more) ATT_STORE(cur ^ 1);
            __syncthreads();
        }
#undef ATT_LOAD
#undef ATT_STORE
        l = xsum32(l);
        const float inv = 1.f / l;
#pragma unroll
        for (int d = 0; d < 4; ++d)
#pragma unroll
            for (int g4 = 0; g4 < 4; ++g4) { u32x2 pk; pk[0] = pk2(O[d][4 * g4] * inv, O[d][4 * g4 + 1] * inv); pk[1] = pk2(O[d][4 * g4 + 2] * inv, O[d][4 * g4 + 3] * inv);
                *(u32x2*)(AO + qrow * D + h * 128 + 32 * d + 8 * g4 + 4 * hf) = pk; }
    }
}


#define XB_TMO      128
#define XB_XCNT(j)  (256  + 64 * (j))
#define XB_XSUB(j)  (1280 + 64 * (j))
#define XB_XGEN(j)  (2304 + 64 * (j))
#define XB_TOP      3328
#define XB_TOPGEN   3392
#define XCD_BAR_WORDS 3456
#define XB_SPIN_CAP (1u << 22)
DI unsigned xb_ld(unsigned* p)              { return __hip_atomic_load(p, __ATOMIC_RELAXED, __HIP_MEMORY_SCOPE_AGENT); }
DI unsigned xb_add(unsigned* p, unsigned v) { return __hip_atomic_fetch_add(p, v, __ATOMIC_RELAXED, __HIP_MEMORY_SCOPE_AGENT); }
DI unsigned xb_xcc_id() { return (unsigned)__builtin_amdgcn_s_getreg((3 << 11) | 20) & 0xFu; }
#define XB_SPIN(cond, bar) do { unsigned _sp = 0; while (cond) { __builtin_amdgcn_s_sleep(1); \
    if ((++_sp & 255u) == 0u) { if (xb_ld(&(bar)[XB_TMO])) break; if (_sp > XB_SPIN_CAP) { atomicAdd(&(bar)[XB_TMO], 1u); break; } } } } while (0)
struct XcdBarrier { unsigned* bar; unsigned x; volatile LAS unsigned* st; };
DI XcdBarrier xcd_barrier_post(unsigned* bar, volatile LAS unsigned* st) {
    XcdBarrier b; b.bar = bar; b.x = xb_xcc_id(); b.st = st;
    if (threadIdx.x == 0) (void)xb_add(&bar[XB_XCNT(b.x)], 1u);
    return b;
}
DI void xcd_barrier_complete(unsigned* bar, unsigned x, unsigned& nloc, unsigned& nx) {
    const unsigned G = gridDim.x * gridDim.y * gridDim.z;
    unsigned sum, cnt, mine, sp = 0u;
    for (;;) {
        sum = 0u; cnt = 0u; mine = 0u;
#pragma unroll
        for (unsigned j = 0; j < 16; ++j) { const unsigned c = xb_ld(&bar[XB_XCNT(j)]); sum += c; cnt += (c > 0u) ? 1u : 0u; mine = (j == x) ? c : mine; }
        if (sum == G) break;
        __builtin_amdgcn_s_sleep(1);
        if ((++sp & 255u) == 0u) { if (xb_ld(&bar[XB_TMO])) break; if (sp > XB_SPIN_CAP) { atomicAdd(&bar[XB_TMO], 1u); break; } }
    }
    nloc = mine > 0u ? mine : 1u; nx = cnt > 0u ? cnt : 1u;
}
DI void xcd_barrier(const XcdBarrier& b) {
    asm volatile("s_waitcnt vmcnt(0)" ::: "memory");
    __syncthreads();
    if (threadIdx.x == 0) {
        unsigned* bar = b.bar;
        __builtin_amdgcn_s_waitcnt(0);
        unsigned nloc = b.st[0], nx = b.st[1];
        if (nloc == 0u) { xcd_barrier_complete(bar, b.x, nloc, nx); b.st[0] = nloc; b.st[1] = nx; }
        const unsigned old = xb_add(&bar[XB_XSUB(b.x)], 1u);
        const unsigned gen = old / nloc;
        if (old + 1u == (gen + 1u) * nloc) {
            __builtin_amdgcn_fence(__ATOMIC_RELEASE, "agent");
            asm volatile("s_waitcnt vmcnt(0)" ::: "memory");
            const unsigned og = xb_add(&bar[XB_TOP], 1u);
            const unsigned tg = og / nx;
            if (og + 1u == (tg + 1u) * nx) xb_add(&bar[XB_TOPGEN], 1u);
            else XB_SPIN(xb_ld(&bar[XB_TOPGEN]) == tg, bar);
            __builtin_amdgcn_fence(__ATOMIC_ACQUIRE, "agent");
            xb_add(&bar[XB_XGEN(b.x)], 1u);
            asm volatile("s_waitcnt vmcnt(0)" ::: "memory");
        } else {
            XB_SPIN(xb_ld(&bar[XB_XGEN(b.x)]) == gen, bar);
            __builtin_amdgcn_fence(__ATOMIC_ACQUIRE, "agent");
            asm volatile("s_waitcnt vmcnt(0)" ::: "memory");
        }
    }
    __syncthreads();
}

__global__ void __launch_bounds__(NTHREADS) fwd_megakernel(Prm p) {
    extern __shared__ __attribute__((aligned(16))) unsigned char lds_raw[];
    LAS unsigned char* lds = (LAS unsigned char*)lds_raw;
    cg::grid_group grid = cg::this_grid();
    if (threadIdx.x < 4) ((LAS unsigned*)(lds + 131072))[threadIdx.x] = 0u;
    __syncthreads();
    XcdBarrier xbar = xcd_barrier_post((unsigned*)(p.ws + OFF_BAR), (volatile LAS unsigned*)(lds + 131072));
    unsigned char* ws = p.ws;
    float* mods = (float*)(ws + OFF_MODS); float* kvm = (float*)(ws + OFF_KVMODS);
    bf16_t* H = (bf16_t*)(ws + OFF_H); float* Y = (float*)(ws + OFF_Y); bf16_t* BIG = (bf16_t*)(ws + OFF_BIG);
    const int G = gridDim.x, cblk = lblock();
#pragma unroll 1
    for (int ph = p.ph_lo; ph < p.ph_hi; ++ph) {
#if DUP_MASK
      const int nrep = ((DUP_MASK >> ph) & 1u) ? 2 : 1;
#pragma unroll 1
      for (int rep = 0; rep < nrep; ++rep)
#endif
        switch (ph) {
        case PH_PRO: {
            mods_phase(lds, p);
            rope_tables(p);
            convert_w(lds, p.gla_w_in, 1024, 3088, (bf16_t*)(ws + OFF_WGIN), 3328, WM_GIN);
            convert_w(lds, p.gla_w_out, 1024, 1024, (bf16_t*)(ws + OFF_WGOUT), 1024, WM_ID);
            convert_w(lds, p.w_kv_a, 1024, 320, (bf16_t*)(ws + OFF_WKVA), 512, WM_LIM320);
            convert_w(lds, p.w_kv_b, 256, 2048, (bf16_t*)(ws + OFF_WKVB), 2048, WM_ID);
            convert_w(lds, p.w_dq, 1024, 384, (bf16_t*)(ws + OFF_WDQ), 512, WM_LIM384);
            convert_w(lds, p.w_uq, 384, 1536, (bf16_t*)(ws + OFF_WUQ), 1536, WM_ID);
            convert_w(lds, p.w_mout, 1024, 1024, (bf16_t*)(ws + OFF_WMOUT), 1024, WM_ID);
            convert_ffn(lds, p, 0, 0);
        } break;
        case PH_ROW0: case PH_ROW1: case PH_ROW2: case PH_ROW3: case PH_ROW4: case PH_ROW5: case PH_ROW6: {
            const int ps = (ph == PH_ROW0) ? -1 : (ph == PH_ROW1) ? 0 : (ph == PH_ROW2) ? 1 : (ph == PH_ROW3) ? 2 : (ph == PH_ROW4) ? 3 : (ph == PH_ROW5) ? 4 : 5;
            RowP a;
            bf16_t* XB = (bf16_t*)(ws + OFF_Y + (size_t)T * 1024 * 2);
            a.xin_f = (ph <= PH_ROW1) ? p.x : nullptr; a.xin_b = XB; a.y = nullptr; a.xout_f = (ph == PH_ROW6) ? p.out : nullptr; a.xout_b = XB;
            a.rw = 0.f; a.gate = nullptr; a.gate_bs = 9216; a.g_post = nullptr;
            a.g1 = nullptr; a.sh1 = nullptr; a.sc1 = nullptr; a.bs1 = 9216; a.h1 = nullptr; a.g2 = nullptr; a.sh2 = nullptr; a.sc2 = nullptr; a.bs2 = 2048; a.h2 = nullptr;
            if (ps >= 0) { const int l = ps / 3, s = ps % 3; a.y = (const bf16_t*)Y; a.rw = (s == 1) ? 1.f : 0.5f;
                a.gate = mods + (size_t)l * 8 * 9216 + (3 * s + 2) * 1024; a.g_post = p.norm_g + ((l * 3 + s) * 2 + 1) * 1024; }
            const int pre = ps + 1;
            if (pre < 6) { const int l = pre / 3, s = pre % 3; a.h1 = H; a.g1 = p.norm_g + ((l * 3 + s) * 2) * 1024;
                a.sh1 = mods + (size_t)l * 8 * 9216 + (3 * s) * 1024; a.sc1 = mods + (size_t)l * 8 * 9216 + (3 * s + 1) * 1024; }
            if (ph == PH_ROW3) { a.h2 = BIG; a.g2 = p.kv_g_in; a.sh2 = kvm; a.sc2 = kvm + 1024; }
            rowwise_phase(a);
            if (ph == PH_ROW1) convert_ffn(lds, p, 0, 1);
            if (ph == PH_ROW3) convert_ffn(lds, p, 1, 0);
            if (ph == PH_ROW4) convert_ffn(lds, p, 1, 1);
        } break;
        case PH_A_G1: case PH_B_G1: case PH_C_G1: case PH_D_G1: {
            if (ph == PH_C_G1) ckv_phase(p);
            pg8::Gemm g{H, (const bf16_t*)(ws + OFF_WGU), T, 5632, 1024}; pg8::StaticOrder S; S.init(T, 5632, G, cblk);
            pg8::EpiSwiglu E{BIG};
#if STAGGER_US
            {
                const unsigned long long t0 = __builtin_amdgcn_s_memrealtime();
                const unsigned long long dl = (unsigned long long)((cblk >> 3) & 3) * (STAGGER_US * 100ull);
                while (__builtin_amdgcn_s_memrealtime() - t0 < dl) __builtin_amdgcn_s_sleep(32);
            }
#endif
            pg8::gemm_phase<pg8::EpiSwiglu>(lds, g, S, E);
        } break;
        case PH_KVA: {
            pg8::Gemm g{BIG, (const bf16_t*)(ws + OFF_WKVA), T, 512, 1024}; pg8::EpiF32 E{Y, 512}; pg8::StaticOrder S; S.init(T, 512, G, cblk);
            pg8::gemm_phase<pg8::EpiF32>(lds, g, S, E);
        } break;
        case PH_GIN: case PH_UQ: case PH_A_G2: case PH_B_G2: case PH_C_G2: case PH_D_G2: case PH_GOUT: case PH_MOUT: {
            pg8::Gemm g; pg8::EpiBf16 E;
            if (ph == PH_GIN) { g = pg8::Gemm{H, (const bf16_t*)(ws + OFF_WGIN), T, 3328, 1024}; E = pg8::EpiBf16{BIG, 3328, (float*)(ws + OFF_GLOW), 12}; }
            else if (ph == PH_UQ) { g = pg8::Gemm{(const bf16_t*)(ws + OFF_H), (const bf16_t*)(ws + OFF_WUQ), T, 1536, 384}; E = pg8::EpiBf16{(bf16_t*)(ws + OFF_BIG + (size_t)T * 2048 * 2), 1536, nullptr, -1}; }
            else if (ph == PH_GOUT) { g = pg8::Gemm{H, (const bf16_t*)(ws + OFF_WGOUT), T, 1024, 1024}; E = pg8::EpiBf16{(bf16_t*)Y, 1024, nullptr, -1}; }
            else if (ph == PH_MOUT) { g = pg8::Gemm{H, (const bf16_t*)(ws + OFF_WMOUT), T, 1024, 1024}; E = pg8::EpiBf16{(bf16_t*)Y, 1024, nullptr, -1}; }
            else { g = pg8::Gemm{BIG, (const bf16_t*)(ws + OFF_WDN), T, 1024, 2816}; E = pg8::EpiBf16{(bf16_t*)Y, 1024, nullptr, -1}; }
            pg8::StaticOrder S; S.init(T, g.N, G, cblk);
            pg8::gemm_phase<pg8::EpiBf16>(lds, g, S, E);
        } break;
        case PH_GLA_CHUNK: gla_chunk_phase(lds, p); break;
        case PH_GLA_SCAN: gla_scan_phase(lds, p); break;
        case PH_GLA_GATE: gla_gate_phase(p); break;
        case PH_DQ_KVB: {
            { pg8::Gemm g{H, (const bf16_t*)(ws + OFF_WDQ), T, 512, 1024}; pg8::EpiF32 E{Y, 512}; pg8::StaticOrder S; S.init(T, 512, G, cblk);
              pg8::gemm_phase<pg8::EpiF32>(lds, g, S, E); }
            { pg8::Gemm g{(const bf16_t*)(ws + OFF_CKVN), (const bf16_t*)(ws + OFF_WKVB), T, 2048, 256}; pg8::EpiBf16 E{BIG, 2048, nullptr, -1}; pg8::StaticOrder S; S.init(T, 2048, G, cblk);
              pg8::gemm_phase<pg8::EpiBf16>(lds, g, S, E); }
        } break;
        case PH_CQ: cq_phase(p); break;
        case PH_ATTN: attn_phase(lds, p); break;
        default: break;
        }
        if (ph + 1 < p.ph_hi) { if (p.ph_hi > NPH) grid.sync(); else xcd_barrier(xbar); }
    }
}

extern "C" void kernel_launch(void* const* d_in, const int* in_sizes, int n_in, void* d_out, int out_size, void* d_ws, size_t ws_size, hipStream_t stream) {
    static int grid_blocks = 0;
    if (grid_blocks == 0) {
        if (n_in != 23 || ws_size < WS_END) { fprintf(stderr, "kernel_launch: unexpected n_in %d / ws %zu (need %zu)\n", n_in, ws_size, (size_t)WS_END); grid_blocks = -1; return; }
        int dev = 0, cus = 0, per_cu = 0;
        (void)hipGetDevice(&dev);
        (void)hipDeviceGetAttribute(&cus, hipDeviceAttributeMultiprocessorCount, dev);
        if (hipFuncSetAttribute((const void*)fwd_megakernel, hipFuncAttributeMaxDynamicSharedMemorySize, LDS_BYTES) != hipSuccess) { fprintf(stderr, "kernel_launch: hipFuncSetAttribute failed\n"); grid_blocks = -1; return; }
        if (hipOccupancyMaxActiveBlocksPerMultiprocessor(&per_cu, (const void*)fwd_megakernel, NTHREADS, LDS_BYTES) != hipSuccess || per_cu < 1) { fprintf(stderr, "kernel_launch: occupancy query says %d\n", per_cu); per_cu = 1; }
        (void)hipGetLastError();
        grid_blocks = cus * 1;
        fprintf(stderr, "kernel_launch: cus %d per_cu %d grid %d\n", cus, per_cu, grid_blocks);
    }
    if (grid_blocks < 0) return;
    Prm p{};
    p.x = (const float*)d_in[0]; p.c = (const float*)d_in[1]; p.pos = (const int*)d_in[2]; p.cond_w = (const float*)d_in[3]; p.cond_b = (const float*)d_in[4];
    p.norm_g = (const float*)d_in[5]; p.ffn_gu = (const float*)d_in[6]; p.ffn_dn = (const float*)d_in[7]; p.gla_w_in = (const float*)d_in[8];
    p.gla_w_gate_up = (const float*)d_in[9]; p.gla_b_gate = (const float*)d_in[10]; p.gla_g_out = (const float*)d_in[11]; p.gla_w_out = (const float*)d_in[12];
    p.kv_g_in = (const float*)d_in[13]; p.kv_cond_w = (const float*)d_in[14]; p.kv_cond_b = (const float*)d_in[15]; p.w_kv_a = (const float*)d_in[16];
    p.g_kv = (const float*)d_in[17]; p.w_kv_b = (const float*)d_in[18]; p.w_dq = (const float*)d_in[19]; p.g_q = (const float*)d_in[20];
    p.w_uq = (const float*)d_in[21]; p.w_mout = (const float*)d_in[22];
    p.out = (float*)d_out; p.ws = (unsigned char*)d_ws;
    (void)hipMemsetAsync((unsigned char*)d_ws + OFF_BAR, 0, 16384, stream);
#if MULTI_LAUNCH
    for (int ph = 0; ph < NPH; ++ph) {
        p.ph_lo = ph; p.ph_hi = ph + 1;
        hipLaunchKernelGGL(fwd_megakernel, dim3(grid_blocks), dim3(NTHREADS), LDS_BYTES, stream, p);
    }
#else
    p.ph_lo = 0; p.ph_hi = NPH;
    void* args[] = {&p};
    hipError_t e = hipLaunchCooperativeKernel((const void*)fwd_megakernel, dim3(grid_blocks), dim3(NTHREADS), args, LDS_BYTES, stream);
    if (e != hipSuccess) fprintf(stderr, "cooperative launch failed: %s (grid %d)\n", hipGetErrorString(e), grid_blocks);
#endif
}
```

```cpp
#include <hip/hip_runtime.h>
#include <hip/hip_cooperative_groups.h>
#include <cstdio>
namespace cg = cooperative_groups;

#define LAS __attribute__((address_space(3)))
#define DI __device__ __forceinline__
typedef unsigned short bf16_t;
typedef short bf16x8 __attribute__((ext_vector_type(8)));
typedef float f32x2 __attribute__((ext_vector_type(2)));
typedef float f32x4 __attribute__((ext_vector_type(4)));
typedef float f32x16 __attribute__((ext_vector_type(16)));
typedef unsigned u32x2 __attribute__((ext_vector_type(2)));
typedef unsigned u32x4 __attribute__((ext_vector_type(4)));
typedef __bf16 bf16v2 __attribute__((ext_vector_type(2)));

#ifndef MULTI_LAUNCH
#define MULTI_LAUNCH 0
#endif
#ifndef DUP_MASK
#define DUP_MASK 0u
#endif

constexpr int T = 32768, D = 1024, SEQ = 4096, NB = 8, DFF = 2816;
constexpr int NTHREADS = 512;
constexpr int LDS_BYTES = 131072 + 16;
constexpr float EPS = 1e-6f;
enum { PH_PRO = 0, PH_ROW0, PH_A_G1, PH_A_G2, PH_ROW1, PH_GIN, PH_GLA_CHUNK, PH_GLA_SCAN, PH_GLA_GATE, PH_GOUT, PH_ROW2, PH_B_G1, PH_B_G2, PH_ROW3,
       PH_KVA, PH_C_G1, PH_C_G2, PH_ROW4, PH_DQ_KVB, PH_CQ, PH_UQ, PH_ATTN, PH_MOUT, PH_ROW5, PH_D_G1, PH_D_G2, PH_ROW6, NPH };

constexpr size_t SZ_WGU = (size_t)5632 * 1024 * 2, SZ_WDN = (size_t)1024 * 2816 * 2, SZ_WGIN = (size_t)3328 * 1024 * 2;
constexpr size_t OFF_BAR = 0;
constexpr size_t OFF_WGU = 16384;
constexpr size_t OFF_WDN = OFF_WGU + SZ_WGU;
constexpr size_t OFF_WGIN = OFF_WDN + SZ_WDN;
constexpr size_t OFF_WGOUT = OFF_WGIN + SZ_WGIN;
constexpr size_t OFF_WKVA = OFF_WGOUT + (size_t)1024 * 1024 * 2;
constexpr size_t OFF_WKVB = OFF_WKVA + (size_t)512 * 1024 * 2;
constexpr size_t OFF_WDQ = OFF_WKVB + (size_t)2048 * 256 * 2;
constexpr size_t OFF_WUQ = OFF_WDQ + (size_t)512 * 1024 * 2;
constexpr size_t OFF_WMOUT = OFF_WUQ + (size_t)1536 * 384 * 2;
constexpr size_t OFF_MODS = OFF_WMOUT + (size_t)1024 * 1024 * 2;
constexpr size_t OFF_KVMODS = OFF_MODS + (size_t)2 * 8 * 9216 * 4;
constexpr size_t OFF_COS = OFF_KVMODS + (size_t)8 * 2048 * 4;
constexpr size_t OFF_SIN = OFF_COS + (size_t)T * 32 * 4;
constexpr size_t OFF_GLOW = OFF_SIN + (size_t)T * 32 * 4;
constexpr size_t OFF_CKVN = OFF_GLOW + (size_t)T * 16 * 4;
constexpr size_t OFF_KROPE = OFF_CKVN + (size_t)T * 256 * 2;
constexpr size_t OFF_H = OFF_KROPE + (size_t)T * 64 * 2;
constexpr size_t OFF_Y = OFF_H + (size_t)T * 1024 * 2;
constexpr size_t OFF_BIG = OFF_Y + (size_t)T * 1024 * 4;
constexpr size_t SZ_BIG = (size_t)T * 2048 * 2 + (size_t)T * 1536 * 2;
constexpr size_t OFF_VTA = OFF_BIG + (size_t)T * 3328 * 2;
constexpr size_t OFF_DEC = OFF_VTA + (size_t)1536 * 32768;
constexpr size_t WS_END = (OFF_DEC + (size_t)2048 * 512 > OFF_BIG + SZ_BIG) ? OFF_DEC + (size_t)2048 * 512 : OFF_BIG + SZ_BIG;
static_assert(WS_END <= (size_t)536870912, "workspace");
static_assert(SZ_BIG >= (size_t)T * 3328 * 2 && SZ_BIG >= (size_t)T * 2816 * 2, "big");

struct Prm {
    const float* x; const float* c; const int* pos; const float* cond_w; const float* cond_b; const float* norm_g;
    const float* ffn_gu; const float* ffn_dn; const float* gla_w_in; const float* gla_w_gate_up; const float* gla_b_gate;
    const float* gla_g_out; const float* gla_w_out; const float* kv_g_in; const float* kv_cond_w; const float* kv_cond_b;
    const float* w_kv_a; const float* g_kv; const float* w_kv_b; const float* w_dq; const float* g_q; const float* w_uq; const float* w_mout;
    float* out; unsigned char* ws; int ph_lo, ph_hi;
};

DI float bf2f(unsigned short b) { return __uint_as_float(((unsigned)b) << 16); }
DI unsigned pk2(float lo, float hi) { f32x2 v = {lo, hi}; bf16v2 b = __builtin_convertvector(v, bf16v2); return __builtin_bit_cast(unsigned, b); }
DI bf16_t f2bf(float f) { return (bf16_t)(pk2(f, 0.f) & 0xffffu); }
DI float lo_f(unsigned u) { return __uint_as_float(u << 16); }
DI float hi_f(unsigned u) { return __uint_as_float(u & 0xffff0000u); }
DI float wave_sum(float v) {
#pragma unroll
    for (int o = 32; o > 0; o >>= 1) v += __shfl_xor(v, o);
    return v;
}
DI float xmax32(float v) { const auto r = __builtin_amdgcn_permlane32_swap(__float_as_uint(v), __float_as_uint(v), false, false); return fmaxf(__uint_as_float(r[0]), __uint_as_float(r[1])); }
DI float xsum32(float v) { const auto r = __builtin_amdgcn_permlane32_swap(__float_as_uint(v), __float_as_uint(v), false, false); return __uint_as_float(r[0]) + __uint_as_float(r[1]); }
DI float silu_f(float v) { return v * __builtin_amdgcn_rcpf(1.f + __expf(-v)); }
DI int crow(int reg, int hf) { return (reg & 3) + 8 * (reg >> 2) + 4 * hf; }
DI int lthread() { int t = threadIdx.x; asm volatile("" : "+v"(t)); return t; }
DI int lblock() { int t = blockIdx.x; asm volatile("" : "+s"(t)); return t; }
#define MFMA32(a, b, c) __builtin_amdgcn_mfma_f32_32x32x16_bf16((a), (b), (c), 0, 0, 0)

namespace pg8 {
constexpr int BM = 256, BK = 64, HALF = 128, HTB = HALF * BK * 2, STAGE_BYTES = 8 * HTB, NXCD = 8, WGM = 8;
DI int lds_byte(int r, int c) { const int st = (r >> 4) * 2 + (c >> 5), rr = r & 15, cc = c & 31, ob = rr * 64 + cc * 2; return st * 1024 + (ob ^ (((ob >> 9) & 1) << 5)); }
DI void stage_rc(int b, int& R, int& C) { const int st = b / 1024, sb = b % 1024, swz = sb ^ (((sb >> 9) & 1) << 5); R = (st >> 1) * 16 + swz / 64; C = (st & 1) * 32 + (swz % 64) / 2; }
DI int perm32(int rho) { const int n = rho >> 4, i = rho & 15; return 8 * (i >> 2) + 4 * n + (i & 3); }

struct Unit { int pm, pn; };
struct Gemm { const bf16_t* A; const bf16_t* Bt; int M, N, K; };

struct StaticOrder {
    int nM, nN, nwg, G, c;
    DI void init(int M, int N, int G_, int c_) { nM = M / BM; nN = N / BM; nwg = nM * nN; G = G_; c = c_; }
    DI bool next(int i, Unit& u) const {
        const long L = (long)i * G + c; if (L >= nwg) return false;
        int wgid = (int)L; { const int q = nwg / NXCD, r = nwg % NXCD, xcd = wgid % NXCD, off = wgid / NXCD; wgid = (xcd < r ? xcd * (q + 1) : r * (q + 1) + (xcd - r) * q) + off; }
        const int nig = WGM * nN, gid = wgid / nig, fm = gid * WGM, gsz = (nM - fm) < WGM ? (nM - fm) : WGM;
        u.pm = fm + ((wgid % nig) % gsz); u.pn = (wgid % nig) / gsz; return true;
    }
};

struct EpiF32 {
    static constexpr bool PERM = false;
    float* C; int ldc;
    DI void operator()(const f32x4 (&acc)[2][2][4][2], const Unit& u, int wr, int wc, int fr, int fq) const {
        const int row0 = u.pm * BM + wr * 64 + fr, col0 = u.pn * BM + wc * 32 + 4 * fq;
#pragma unroll
        for (int ai = 0; ai < 2; ++ai)
#pragma unroll
            for (int m = 0; m < 4; ++m) { float* rowp = C + (size_t)(row0 + ai * HALF + m * 16) * ldc + col0;
#pragma unroll
                for (int bj = 0; bj < 2; ++bj)
#pragma unroll
                    for (int n = 0; n < 2; ++n) *(f32x4*)(rowp + bj * HALF + n * 16) = acc[ai][bj][m][n]; }
    }
};
struct EpiBf16 {
    static constexpr bool PERM = true;
    bf16_t* O; int ldc; float* glow; int glow_pn;
    DI void operator()(const f32x4 (&acc)[2][2][4][2], const Unit& u, int wr, int wc, int fr, int fq) const {
        const int row0 = u.pm * BM + wr * 64 + fr, col0 = u.pn * BM + wc * 32 + 8 * fq;
        const bool gl = (glow != nullptr) && (u.pn == glow_pn) && (wc == 0) && (fq < 2);
#pragma unroll
        for (int ai = 0; ai < 2; ++ai)
#pragma unroll
            for (int m = 0; m < 4; ++m) { const int row = row0 + ai * HALF + m * 16; bf16_t* rowp = O + (size_t)row * ldc + col0;
#pragma unroll
                for (int bj = 0; bj < 2; ++bj) { const f32x4 v0 = acc[ai][bj][m][0], v1 = acc[ai][bj][m][1];
                    u32x4 pk; pk[0] = pk2(v0[0], v0[1]); pk[1] = pk2(v0[2], v0[3]); pk[2] = pk2(v1[0], v1[1]); pk[3] = pk2(v1[2], v1[3]);
                    *(u32x4*)(rowp + bj * HALF) = pk;
                    if (bj == 0 && gl) { *(f32x4*)(glow + (size_t)row * 16 + 8 * fq) = v0; *(f32x4*)(glow + (size_t)row * 16 + 8 * fq + 4) = v1; } } }
    }
};
struct EpiSwiglu {
    static constexpr bool PERM = true;
    bf16_t* O;
    DI void operator()(const f32x4 (&acc)[2][2][4][2], const Unit& u, int wr, int wc, int fr, int fq) const {
        const int row0 = u.pm * BM + wr * 64 + fr, col0 = u.pn * HALF + wc * 32 + 8 * fq;
#pragma unroll
        for (int ai = 0; ai < 2; ++ai)
#pragma unroll
            for (int m = 0; m < 4; ++m) { bf16_t* rowp = O + (size_t)(row0 + ai * HALF + m * 16) * DFF + col0;
                const f32x4 g0 = acc[ai][0][m][0], g1 = acc[ai][0][m][1], u0 = acc[ai][1][m][0], u1 = acc[ai][1][m][1];
                u32x4 pk;
                pk[0] = pk2(silu_f(g0[0]) * u0[0], silu_f(g0[1]) * u0[1]); pk[1] = pk2(silu_f(g0[2]) * u0[2], silu_f(g0[3]) * u0[3]);
                pk[2] = pk2(silu_f(g1[0]) * u1[0], silu_f(g1[1]) * u1[1]); pk[3] = pk2(silu_f(g1[2]) * u1[2], silu_f(g1[3]) * u1[3]);
                *(u32x4*)rowp = pk; }
    }
};

template <class Epi>
DI void gemm_phase(LAS unsigned char* lds, const Gemm g, const StaticOrder& S, const Epi& E) {
    const int tid = lthread(), wid = __builtin_amdgcn_readfirstlane(tid >> 6), lane = tid & 63, wr = wid >> 2, wc = wid & 3, fr = lane & 15, fq = lane >> 4;
    const int K = g.K, nt = K / BK;
    unsigned voffA[2], voffB[2];
#pragma unroll
    for (int i = 0; i < 2; ++i) { int R, C; stage_rc(tid * 16 + i * 8192, R, C); const int Rb = Epi::PERM ? ((R & ~31) + perm32(R & 31)) : R;
        voffA[i] = (unsigned)(R * K + C) * 2u; voffB[i] = (unsigned)(Rb * K + C) * 2u; }
    const size_t kstep = (size_t)(BK * 2);
    const size_t hstep = (size_t)HALF * K * 2;
    const size_t tstep = 2 * hstep;
    const unsigned ldsw = (unsigned)wid * 1024u;
    const int aoff = lds_byte(wr * 64 + fr, fq * 8), boff = lds_byte(wc * 32 + fr, fq * 8);
#define PG8_SA(b, h) (((b) * 2 + (h)) * HTB)
#define PG8_SB(b, h) ((4 + (b) * 2 + (h)) * HTB)
#define PG8_STAGE(bufoff, gbase, voff) do { _Pragma("unroll") for (int _i = 0; _i < 2; ++_i) \
        __builtin_amdgcn_global_load_lds((const unsigned*)((const char*)(gbase) + (voff)[_i]), (LAS unsigned*)(lds + (bufoff) + ldsw + _i * 8192), 16, 0, 0); } while (0)
#define PG8_LDA(dst, b, h) do { _Pragma("unroll") for (int m = 0; m < 4; ++m) _Pragma("unroll") for (int k = 0; k < 2; ++k) dst[m][k] = *(const LAS bf16x8*)(lds + PG8_SA(b, h) + aoff + m * 2048 + k * 1024); } while (0)
#define PG8_LDB(dst, b, h) do { _Pragma("unroll") for (int n = 0; n < 2; ++n) _Pragma("unroll") for (int k = 0; k < 2; ++k) dst[n][k] = *(const LAS bf16x8*)(lds + PG8_SB(b, h) + boff + n * 2048 + k * 1024); } while (0)
#define PG8_MMA(ai, bj, At, Bt) do { __builtin_amdgcn_s_setprio(1); _Pragma("unroll") for (int m = 0; m < 4; ++m) _Pragma("unroll") for (int n = 0; n < 2; ++n) _Pragma("unroll") for (int k = 0; k < 2; ++k) \
        acc[ai][bj][m][n] = __builtin_amdgcn_mfma_f32_16x16x32_bf16(Bt[n][k], At[m][k], acc[ai][bj][m][n], 0, 0, 0); __builtin_amdgcn_s_setprio(0); } while (0)
#define PG8_WAIT_V(n) asm volatile("s_waitcnt vmcnt(" #n ")" ::: "memory")
#define PG8_WAIT_L(n) asm volatile("s_waitcnt lgkmcnt(" #n ")" ::: "memory")
#define PG8_BAR __builtin_amdgcn_s_barrier()
#define PG8_SCHED __builtin_amdgcn_sched_barrier(0)
    Unit cur, nxt; int ui = 0;
    if (!S.next(0, cur)) return;
    f32x4 acc[2][2][4][2];
#pragma unroll
    for (int a = 0; a < 2; ++a)
#pragma unroll
        for (int b = 0; b < 2; ++b)
#pragma unroll
            for (int m = 0; m < 4; ++m)
#pragma unroll
                for (int n = 0; n < 2; ++n) acc[a][b][m][n] = (f32x4){0.f, 0.f, 0.f, 0.f};
    bf16x8 At[4][2], B0[2][2], B1[2][2];
    const char* cA = (const char*)g.A + (size_t)cur.pm * tstep; const char* cB = (const char*)g.Bt + (size_t)cur.pn * tstep;
    PG8_STAGE(PG8_SB(0, 0), cB, voffB); PG8_STAGE(PG8_SA(0, 0), cA, voffA); PG8_STAGE(PG8_SB(0, 1), cB + hstep, voffB); PG8_STAGE(PG8_SA(0, 1), cA + hstep, voffA);
    if (wr == 1) PG8_BAR;
    PG8_WAIT_V(4); PG8_BAR;
    PG8_STAGE(PG8_SB(1, 0), cB + kstep, voffB); PG8_STAGE(PG8_SA(1, 0), cA + kstep, voffA); PG8_STAGE(PG8_SB(1, 1), cB + hstep + kstep, voffB);
    PG8_WAIT_V(6); PG8_BAR;
    for (;;) {
        const bool has_next = S.next(ui + 1, nxt);
        const char* nA = has_next ? (const char*)g.A + (size_t)nxt.pm * tstep : cA; const char* nB = has_next ? (const char*)g.Bt + (size_t)nxt.pn * tstep : cB;
        for (int t = 0; t < nt; t += 2) {
            const bool last = (t == nt - 2);
            const char* a1 = cA + (size_t)(t + 1) * kstep;
            const char* a2 = last ? nA : cA + (size_t)(t + 2) * kstep; const char* b2 = last ? nB : cB + (size_t)(t + 2) * kstep;
            const char* a3 = a2 + kstep; const char* b3 = b2 + kstep;
            PG8_LDB(B0, 0, 0); PG8_SCHED; PG8_LDA(At, 0, 0); PG8_STAGE(PG8_SA(1, 1), a1 + hstep, voffA);
            PG8_WAIT_L(8); PG8_BAR; PG8_WAIT_L(0); PG8_MMA(0, 0, At, B0); PG8_BAR; PG8_SCHED;
            PG8_LDB(B1, 0, 1); PG8_STAGE(PG8_SB(0, 0), b2, voffB);
            PG8_BAR; PG8_WAIT_L(0); PG8_MMA(0, 1, At, B1); PG8_BAR;
            PG8_LDA(At, 0, 1); PG8_STAGE(PG8_SA(0, 0), a2, voffA);
            PG8_BAR; PG8_WAIT_L(0); PG8_MMA(1, 0, At, B0); PG8_BAR; PG8_SCHED;
            PG8_STAGE(PG8_SB(0, 1), b2 + hstep, voffB);
            PG8_WAIT_V(6); PG8_BAR; PG8_MMA(1, 1, At, B1); PG8_BAR;
            PG8_LDB(B0, 1, 0); PG8_SCHED; PG8_LDA(At, 1, 0); PG8_STAGE(PG8_SA(0, 1), a2 + hstep, voffA);
            PG8_WAIT_L(8); PG8_BAR; PG8_WAIT_L(0); PG8_MMA(0, 0, At, B0); PG8_BAR; PG8_SCHED;
            PG8_LDB(B1, 1, 1); PG8_STAGE(PG8_SB(1, 0), b3, voffB);
            PG8_BAR; PG8_WAIT_L(0); PG8_MMA(0, 1, At, B1); PG8_BAR;
            PG8_LDA(At, 1, 1); PG8_STAGE(PG8_SA(1, 0), a3, voffA);
            PG8_BAR; PG8_WAIT_L(0); PG8_MMA(1, 0, At, B0); PG8_BAR; PG8_SCHED;
            PG8_STAGE(PG8_SB(1, 1), b3 + hstep, voffB);
            PG8_WAIT_V(6); PG8_BAR; PG8_MMA(1, 1, At, B1); PG8_BAR;
        }
        E(acc, cur, wr, wc, fr, fq);
        if (!has_next) break;
#pragma unroll
        for (int a = 0; a < 2; ++a)
#pragma unroll
            for (int b = 0; b < 2; ++b)
#pragma unroll
                for (int m = 0; m < 4; ++m)
#pragma unroll
                    for (int n = 0; n < 2; ++n) acc[a][b][m][n] = (f32x4){0.f, 0.f, 0.f, 0.f};
        cur = nxt; cA = nA; cB = nB; ++ui;
    }
    PG8_WAIT_V(0);
    if (wr == 0) PG8_BAR;
    PG8_BAR;
#undef PG8_SA
#undef PG8_SB
#undef PG8_STAGE
#undef PG8_LDA
#undef PG8_LDB
#undef PG8_MMA
#undef PG8_WAIT_V
#undef PG8_WAIT_L
#undef PG8_BAR
#undef PG8_SCHED
}
}

enum { WM_ID = 0, WM_GU, WM_GIN, WM_LIM320, WM_LIM384 };
DI int wmap(int mode, int r) {
    switch (mode) {
        case WM_GU: { const int t = r >> 8, w = r & 255; return w < 128 ? t * 128 + w : DFF + t * 128 + (w - 128); }
        case WM_GIN: return r < 2048 ? r : (r < 3072 ? r + 16 : (r < 3088 ? r - 1024 : -1));
        case WM_LIM320: return r < 320 ? r : -1;
        case WM_LIM384: return r < 384 ? r : -1;
        default: return r;
    }
}
DI void convert_w(LAS unsigned char* lds, const float* __restrict__ src, int K, int N, bf16_t* __restrict__ dst, int Nd, int mode) {
    LAS float* tile = (LAS float*)lds;
    const int tid = lthread(), ntk = K >> 6, ntiles = (Nd >> 6) * ntk;
    const int lk = tid >> 3, lj = (tid & 7) * 8;
    const int sj = tid >> 3, sk = (tid & 7) * 8;
    for (int t = lblock(); t < ntiles; t += gridDim.x) {
        const int r0 = (t / ntk) << 6, k0 = (t % ntk) << 6;
        const int n0 = wmap(mode, r0 + lj), n7 = wmap(mode, r0 + lj + 7);
        const float* sp = src + (size_t)(k0 + lk) * N;
        if (n0 >= 0 && n7 == n0 + 7 && ((N & 3) == 0) && ((n0 & 3) == 0)) {
            const f32x4 a = *(const f32x4*)(sp + n0), b = *(const f32x4*)(sp + n0 + 4);
            tile[lk * 65 + lj] = a[0]; tile[lk * 65 + lj + 1] = a[1]; tile[lk * 65 + lj + 2] = a[2]; tile[lk * 65 + lj + 3] = a[3];
            tile[lk * 65 + lj + 4] = b[0]; tile[lk * 65 + lj + 5] = b[1]; tile[lk * 65 + lj + 6] = b[2]; tile[lk * 65 + lj + 7] = b[3];
        } else {
#pragma unroll
            for (int j = 0; j < 8; ++j) { const int n = wmap(mode, r0 + lj + j); tile[lk * 65 + lj + j] = (n >= 0) ? sp[n] : 0.f; }
        }
        __syncthreads();
        { u32x4 pk;
#pragma unroll
          for (int j2 = 0; j2 < 4; ++j2) pk[j2] = pk2(tile[(sk + 2 * j2) * 65 + sj], tile[(sk + 2 * j2 + 1) * 65 + sj]);
          *(u32x4*)(dst + (size_t)(r0 + sj) * K + k0 + sk) = pk; }
        __syncthreads();
    }
}
DI void convert_ffn(LAS unsigned char* lds, const Prm& p, int l, int f) {
    const int idx = l * 2 + f;
    convert_w(lds, p.ffn_gu + (size_t)idx * 1024 * 5632, 1024, 5632, (bf16_t*)(p.ws + OFF_WGU), 5632, WM_GU);
    convert_w(lds, p.ffn_dn + (size_t)idx * 2816 * 1024, 2816, 1024, (bf16_t*)(p.ws + OFF_WDN), 1024, WM_ID);
}

DI void mods_phase(LAS unsigned char* lds, const Prm& p) {
    LAS float* cact = (LAS float*)lds;
    LAS float* red = (LAS float*)(lds + 32768);
    const int tid = lthread();
    for (int i = tid; i < 8192; i += NTHREADS) cact[i] = silu_f(p.c[i]);
    __syncthreads();
    float* mods = (float*)(p.ws + OFF_MODS); float* kvm = (float*)(p.ws + OFF_KVMODS);
    for (int item = lblock(); item < 320; item += gridDim.x) {
        const int col0 = item * 64;
        const float* W; int N, cc; const float* bias; float* out; int obs;
        if (col0 < 18432) { const int l = col0 / 9216; cc = col0 - l * 9216; W = p.cond_w + (size_t)l * 1024 * 9216; N = 9216; bias = p.cond_b + l * 9216; out = mods + (size_t)l * 8 * 9216; obs = 9216; }
        else { cc = col0 - 18432; W = p.kv_cond_w; N = 2048; bias = p.kv_cond_b; out = kvm; obs = 2048; }
        const int j = tid & 63, kg = tid >> 6;
        float a0 = 0.f, a1 = 0.f, a2 = 0.f, a3 = 0.f, a4 = 0.f, a5 = 0.f, a6 = 0.f, a7 = 0.f;
        const float* wp = W + (size_t)(kg * 128) * N + cc + j;
#pragma unroll 16
        for (int k = 0; k < 128; ++k) { const float w = wp[(size_t)k * N]; const int kk = kg * 128 + k;
            a0 += cact[kk] * w; a1 += cact[1024 + kk] * w; a2 += cact[2048 + kk] * w; a3 += cact[3072 + kk] * w;
            a4 += cact[4096 + kk] * w; a5 += cact[5120 + kk] * w; a6 += cact[6144 + kk] * w; a7 += cact[7168 + kk] * w; }
        red[(kg * 8 + 0) * 64 + j] = a0; red[(kg * 8 + 1) * 64 + j] = a1; red[(kg * 8 + 2) * 64 + j] = a2; red[(kg * 8 + 3) * 64 + j] = a3;
        red[(kg * 8 + 4) * 64 + j] = a4; red[(kg * 8 + 5) * 64 + j] = a5; red[(kg * 8 + 6) * 64 + j] = a6; red[(kg * 8 + 7) * 64 + j] = a7;
        __syncthreads();
        { const int b = tid >> 6; float s = bias[cc + j];
#pragma unroll
          for (int q = 0; q < 8; ++q) s += red[(q * 8 + b) * 64 + j];
          out[(size_t)b * obs + cc + j] = s; }
        __syncthreads();
    }
}
DI void rope_tables(const Prm& p) {
    float* COS = (float*)(p.ws + OFF_COS); float* SIN = (float*)(p.ws + OFF_SIN);
    const int gt = lblock() * NTHREADS + lthread(), nth = gridDim.x * NTHREADS;
    for (int idx = gt; idx < T * 32; idx += nth) {
        const int t = idx >> 5, i = idx & 31;
        const float inv = powf(10000.f, -(float)(2 * i) / 64.f);
        const float ang = (float)p.pos[t] * inv;
        COS[idx] = cosf(ang); SIN[idx] = sinf(ang);
    }
}

struct RowP {
    const float* xin_f; const bf16_t* xin_b; const bf16_t* y; float* xout_f; bf16_t* xout_b; float rw; const float* gate; int gate_bs; const float* g_post;
    const float* g1; const float* sh1; const float* sc1; int bs1; bf16_t* h1;
    const float* g2; const float* sh2; const float* sc2; int bs2; bf16_t* h2;
};
DI void rowwise_phase(const RowP& a) {
    const int tidx_ = lthread(); const int lane = tidx_ & 63, gw = lblock() * 8 + (tidx_ >> 6), nw = gridDim.x * 8;
    u32x2 xr[4], yr[4];
#pragma unroll
    for (int i = 0; i < 4; ++i) { xr[i] = (u32x2){0u, 0u}; yr[i] = (u32x2){0u, 0u}; }
#define ROW_LOAD(row_, xd, yd) do { \
        if (!a.xin_f) { _Pragma("unroll") for (int i = 0; i < 4; ++i) xd[i] = *(const u32x2*)(a.xin_b + (size_t)(row_) * D + i * 256 + lane * 4); } \
        if (a.y) { _Pragma("unroll") for (int i = 0; i < 4; ++i) yd[i] = *(const u32x2*)(a.y + (size_t)(row_) * D + i * 256 + lane * 4); } } while (0)
    if (gw < T) ROW_LOAD(gw, xr, yr);
    for (int row = gw; row < T; row += nw) {
        const int b = row >> 12;
        u32x2 xn[4], yn[4];
#pragma unroll
        for (int i = 0; i < 4; ++i) { xn[i] = (u32x2){0u, 0u}; yn[i] = (u32x2){0u, 0u}; }
        if (row + nw < T) ROW_LOAD(row + nw, xn, yn);
        f32x4 xv[4];
        if (a.xin_f) {
#pragma unroll
            for (int i = 0; i < 4; ++i) xv[i] = *(const f32x4*)(a.xin_f + (size_t)row * D + i * 256 + lane * 4);
        } else {
#pragma unroll
            for (int i = 0; i < 4; ++i) { xv[i][0] = lo_f(xr[i][0]); xv[i][1] = hi_f(xr[i][0]); xv[i][2] = lo_f(xr[i][1]); xv[i][3] = hi_f(xr[i][1]); }
        }
        if (a.y) {
            f32x4 yv[4]; float ss = 0.f;
#pragma unroll
            for (int i = 0; i < 4; ++i) {
                yv[i][0] = lo_f(yr[i][0]); yv[i][1] = hi_f(yr[i][0]); yv[i][2] = lo_f(yr[i][1]); yv[i][3] = hi_f(yr[i][1]);
                ss += yv[i][0] * yv[i][0] + yv[i][1] * yv[i][1] + yv[i][2] * yv[i][2] + yv[i][3] * yv[i][3]; }
            ss = wave_sum(ss);
            const float rstd = rsqrtf(ss * (1.f / D) + EPS) * a.rw;
#pragma unroll
            for (int i = 0; i < 4; ++i) { const int col = i * 256 + lane * 4;
                const f32x4 gt = *(const f32x4*)(a.gate + (size_t)b * a.gate_bs + col), gp = *(const f32x4*)(a.g_post + col);
                xv[i] = xv[i] + gt * (yv[i] * rstd) * gp;
                if (a.xout_f) *(f32x4*)(a.xout_f + (size_t)row * D + col) = xv[i];
                else { u32x2 pk; pk[0] = pk2(xv[i][0], xv[i][1]); pk[1] = pk2(xv[i][2], xv[i][3]); *(u32x2*)(a.xout_b + (size_t)row * D + col) = pk; } }
        }
        if (a.h1) {
            float ss = 0.f;
#pragma unroll
            for (int i = 0; i < 4; ++i) ss += xv[i][0] * xv[i][0] + xv[i][1] * xv[i][1] + xv[i][2] * xv[i][2] + xv[i][3] * xv[i][3];
            ss = wave_sum(ss);
            const float rstd = rsqrtf(ss * (1.f / D) + EPS);
#pragma unroll
            for (int i = 0; i < 4; ++i) { const int col = i * 256 + lane * 4;
                const f32x4 g = *(const f32x4*)(a.g1 + col), sc = *(const f32x4*)(a.sc1 + (size_t)b * a.bs1 + col), sh = *(const f32x4*)(a.sh1 + (size_t)b * a.bs1 + col);
                const f32x4 hv = (xv[i] * rstd) * g * (sc + 1.f) + sh;
                u32x2 pk; pk[0] = pk2(hv[0], hv[1]); pk[1] = pk2(hv[2], hv[3]);
                *(u32x2*)(a.h1 + (size_t)row * D + col) = pk; }
            if (a.h2) {
#pragma unroll
                for (int i = 0; i < 4; ++i) { const int col = i * 256 + lane * 4;
                    const f32x4 g = *(const f32x4*)(a.g2 + col), sc = *(const f32x4*)(a.sc2 + (size_t)b * a.bs2 + col), sh = *(const f32x4*)(a.sh2 + (size_t)b * a.bs2 + col);
                    const f32x4 hv = (xv[i] * rstd) * g * (sc + 1.f) + sh;
                    u32x2 pk; pk[0] = pk2(hv[0], hv[1]); pk[1] = pk2(hv[2], hv[3]);
                    *(u32x2*)(a.h2 + (size_t)row * D + col) = pk; }
            }
        }
#pragma unroll
        for (int i = 0; i < 4; ++i) { xr[i] = xn[i]; yr[i] = yn[i]; }
    }
#undef ROW_LOAD
}

DI void ckv_phase(const Prm& p) {
    const float* raw = (const float*)(p.ws + OFF_Y); bf16_t* ckvn = (bf16_t*)(p.ws + OFF_CKVN); bf16_t* krope = (bf16_t*)(p.ws + OFF_KROPE);
    const float* COS = (const float*)(p.ws + OFF_COS); const float* SIN = (const float*)(p.ws + OFF_SIN);
    const int tidx_ = lthread(); const int lane = tidx_ & 63, gw = lblock() * 8 + (tidx_ >> 6), nw = gridDim.x * 8;
    for (int row = gw; row < T; row += nw) {
        const f32x4 v = *(const f32x4*)(raw + (size_t)row * 512 + lane * 4);
        float ss = wave_sum(v[0] * v[0] + v[1] * v[1] + v[2] * v[2] + v[3] * v[3]);
        const float rstd = rsqrtf(ss * (1.f / 256.f) + EPS);
        const f32x4 g = *(const f32x4*)(p.g_kv + lane * 4);
        u32x2 pk; pk[0] = pk2(v[0] * rstd * g[0], v[1] * rstd * g[1]); pk[1] = pk2(v[2] * rstd * g[2], v[3] * rstd * g[3]);
        *(u32x2*)(ckvn + (size_t)row * 256 + lane * 4) = pk;
        if (lane < 32) {
            const float x1 = raw[(size_t)row * 512 + 256 + lane], x2 = raw[(size_t)row * 512 + 288 + lane];
            const float c = COS[(size_t)row * 32 + lane], s = SIN[(size_t)row * 32 + lane];
            krope[(size_t)row * 64 + lane] = f2bf(x1 * c - x2 * s);
            krope[(size_t)row * 64 + 32 + lane] = f2bf(x1 * s + x2 * c);
        }
    }
}
DI void cq_phase(const Prm& p) {
    const float* raw = (const float*)(p.ws + OFF_Y); bf16_t* cqn = (bf16_t*)(p.ws + OFF_H);
    const int tidx_ = lthread(); const int lane = tidx_ & 63, gw = lblock() * 8 + (tidx_ >> 6), nw = gridDim.x * 8;
    for (int row = gw; row < T; row += nw) {
        f32x2 v[3]; float ss = 0.f;
#pragma unroll
        for (int i = 0; i < 3; ++i) { v[i] = *(const f32x2*)(raw + (size_t)row * 512 + i * 128 + lane * 2); ss += v[i][0] * v[i][0] + v[i][1] * v[i][1]; }
        ss = wave_sum(ss);
        const float rstd = rsqrtf(ss * (1.f / 384.f) + EPS);
#pragma unroll
        for (int i = 0; i < 3; ++i) { const f32x2 g = *(const f32x2*)(p.g_q + i * 128 + lane * 2);
            *(unsigned*)(cqn + (size_t)row * 384 + i * 128 + lane * 2) = pk2(v[i][0] * rstd * g[0], v[i][1] * rstd * g[1]); }
    }
}
DI void gla_gate_phase(const Prm& p) {
    const bf16_t* og = (const bf16_t*)(p.ws + OFF_Y); const bf16_t* proj = (const bf16_t*)(p.ws + OFF_BIG); bf16_t* hout = (bf16_t*)(p.ws + OFF_H);
    const bf16_t* oint = (const bf16_t*)(p.ws + OFF_BIG);
    const int tidx_ = lthread(); const int lane = tidx_ & 63, gw = lblock() * 8 + (tidx_ >> 6), nw = gridDim.x * 8;
    u32x4 nx[6];
#pragma unroll
    for (int i = 0; i < 6; ++i) nx[i] = (u32x4){0u, 0u, 0u, 0u};
#define GATE_LOAD(row_) do { nx[0] = *(const u32x4*)(og + (size_t)(row_) * D + lane * 16); nx[1] = *(const u32x4*)(og + (size_t)(row_) * D + lane * 16 + 8); \
        nx[2] = *(const u32x4*)(oint + (size_t)(row_) * 3328 + lane * 16); nx[3] = *(const u32x4*)(oint + (size_t)(row_) * 3328 + lane * 16 + 8); \
        nx[4] = *(const u32x4*)(proj + (size_t)(row_) * 3328 + 2048 + lane * 16); nx[5] = *(const u32x4*)(proj + (size_t)(row_) * 3328 + 2048 + lane * 16 + 8); } while (0)
    if (gw < T) GATE_LOAD(gw);
    for (int row = gw; row < T; row += nw) {
        f32x4 v[4]; float ss = 0.f;
        const u32x4 og0 = nx[0], og1 = nx[1], oi0 = nx[2], oi1 = nx[3], r0 = nx[4], r1 = nx[5];
        if (row + nw < T) GATE_LOAD(row + nw);
#pragma unroll
        for (int i = 0; i < 4; ++i) { const unsigned ga = (i < 2) ? og0[2 * i] : og1[2 * (i - 2)], gb = (i < 2) ? og0[2 * i + 1] : og1[2 * (i - 2) + 1];
            f32x4 oi; oi[0] = lo_f(ga); oi[1] = hi_f(ga); oi[2] = lo_f(gb); oi[3] = hi_f(gb);
            const unsigned ia = (i < 2) ? oi0[2 * i] : oi1[2 * (i - 2)], ib = (i < 2) ? oi0[2 * i + 1] : oi1[2 * (i - 2) + 1];
            f32x4 oj; oj[0] = lo_f(ia); oj[1] = hi_f(ia); oj[2] = lo_f(ib); oj[3] = hi_f(ib);
            v[i] = oi + oj;
            ss += v[i][0] * v[i][0] + v[i][1] * v[i][1] + v[i][2] * v[i][2] + v[i][3] * v[i][3]; }
#pragma unroll
        for (int o = 8; o > 0; o >>= 1) ss += __shfl_xor(ss, o);
        const float rstd = rsqrtf(ss * (1.f / 256.f) + EPS);
        const int gc = (lane & 15) * 16;
        u32x4 o0, o1;
#pragma unroll
        for (int i = 0; i < 4; ++i) {
            const f32x4 g = *(const f32x4*)(p.gla_g_out + gc + i * 4);
            const unsigned ra = (i < 2) ? r0[2 * i] : r1[2 * (i - 2)], rb = (i < 2) ? r0[2 * i + 1] : r1[2 * (i - 2) + 1];
            const float e0 = v[i][0] * rstd * g[0] * silu_f(lo_f(ra)), e1 = v[i][1] * rstd * g[1] * silu_f(hi_f(ra));
            const float e2 = v[i][2] * rstd * g[2] * silu_f(lo_f(rb)), e3 = v[i][3] * rstd * g[3] * silu_f(hi_f(rb));
            if (i < 2) { o0[2 * i] = pk2(e0, e1); o0[2 * i + 1] = pk2(e2, e3); } else { o1[2 * (i - 2)] = pk2(e0, e1); o1[2 * (i - 2) + 1] = pk2(e2, e3); }
        }
        *(u32x4*)(hout + (size_t)row * D + lane * 16) = o0; *(u32x4*)(hout + (size_t)row * D + lane * 16 + 8) = o1;
    }
#undef GATE_LOAD
}

DI bf16_t* gla_vt_ptr(unsigned char* ws, int ci) { return (bf16_t*)(ci < 1536 ? ws + OFF_VTA + (size_t)ci * 32768 : ws + OFF_CKVN + (size_t)(ci - 1536) * 32768); }
DI void gla_chunk_phase(LAS unsigned char* lds, const Prm& p) {
    const int tid = lthread(), wid = __builtin_amdgcn_readfirstlane(tid >> 6), lane = tid & 63, r = lane & 31, hf = lane >> 5;
    LAS float* GL = (LAS float*)(lds);
    LAS float* LA = (LAS float*)(lds + 4096);
    LAS unsigned char* ATT = lds + 4096;
    LAS float* SEG = (LAS float*)(lds + 36864);
    LAS float* BL = (LAS float*)(lds + 38912);
    LAS unsigned char* QD = lds + 39424;
    LAS unsigned char* KD = lds + 56832;
    LAS unsigned char* KUT = lds + 74240;
    LAS unsigned char* VTs = lds + 92672;
    const bf16_t* proj = (const bf16_t*)(p.ws + OFF_BIG); const float* glow = (const float*)(p.ws + OFF_GLOW); bf16_t* og = (bf16_t*)(p.ws + OFF_Y);
    bf16_t* QDg = (bf16_t*)(p.ws + OFF_H); bf16_t* KUTg = (bf16_t*)(p.ws + OFF_H + (size_t)2048 * 16384); float* DECg = (float*)(p.ws + OFF_DEC);
    const float qscale = 0.08838834764831845f;
    const int seg = tid >> 7, c = tid & 127;
    const int kp = tid >> 4, kc8 = tid & 15;
    const int vpp = tid >> 5, vc8 = tid & 31;
    const int grow = tid >> 2, gc4 = tid & 3;
    for (int ci = lblock(); ci < 2048; ci += gridDim.x) {
        const int b = ci >> 8, h = (ci >> 6) & 3, n = ci & 63;
        const size_t t0 = (size_t)b * SEQ + (size_t)n * 64;
        float wg[16];
#pragma unroll
        for (int q = 0; q < 16; ++q) wg[q] = p.gla_w_gate_up[q * 512 + h * 128 + c];
        const float bg = p.gla_b_gate[h * 128 + c];
        u32x4 qraw[2], kraw[2], vraw[4]; f32x4 glraw = {0.f, 0.f, 0.f, 0.f};
#pragma unroll
        for (int i = 0; i < 2; ++i) { const bf16_t* rp = proj + (t0 + 2 * kp + i) * 3328 + h * 128 + kc8 * 8; qraw[i] = *(const u32x4*)rp; kraw[i] = *(const u32x4*)(rp + 512); }
#pragma unroll
        for (int i = 0; i < 4; ++i) vraw[i] = *(const u32x4*)(proj + (t0 + 2 * vpp + (i & 1) + 32 * (i >> 1)) * 3328 + 1024 + h * 256 + vc8 * 8);
        if (tid < 256) glraw = *(const f32x4*)(glow + (t0 + grow) * 16 + gc4 * 4);
        if (tid < 256) *(LAS f32x4*)(GL + grow * 16 + gc4 * 4) = glraw;
        __syncthreads();
        float bs[16]; float run = 0.f;
#pragma unroll
        for (int i = 0; i < 16; ++i) { const int row = seg * 16 + i; float z = bg;
            const f32x4 g0 = *(const LAS f32x4*)(GL + row * 16), g1 = *(const LAS f32x4*)(GL + row * 16 + 4), g2 = *(const LAS f32x4*)(GL + row * 16 + 8), g3 = *(const LAS f32x4*)(GL + row * 16 + 12);
            z += g0[0] * wg[0] + g0[1] * wg[1] + g0[2] * wg[2] + g0[3] * wg[3] + g1[0] * wg[4] + g1[1] * wg[5] + g1[2] * wg[6] + g1[3] * wg[7]
               + g2[0] * wg[8] + g2[1] * wg[9] + g2[2] * wg[10] + g2[3] * wg[11] + g3[0] * wg[12] + g3[1] * wg[13] + g3[2] * wg[14] + g3[3] * wg[15];
            const float ls = fminf(z, 0.f) - __logf(1.f + __expf(-fabsf(z)));
            run += ls * 0.0625f; bs[i] = run; }
        SEG[seg * 128 + c] = run;
        __syncthreads();
        { float off = 0.f;
#pragma unroll
          for (int s = 0; s < 3; ++s) off += (s < seg) ? SEG[s * 128 + c] : 0.f;
#pragma unroll
          for (int i = 0; i < 16; ++i) LA[(seg * 16 + i) * 128 + c] = bs[i] + off;
          if (seg == 3) BL[c] = bs[15] + off; }
        __syncthreads();
        {
            const f32x4 l0 = *(const LAS f32x4*)(BL + kc8 * 8), l1 = *(const LAS f32x4*)(BL + kc8 * 8 + 4);
            f32x4 ba0 = *(const LAS f32x4*)(LA + (2 * kp) * 128 + kc8 * 8), ba1 = *(const LAS f32x4*)(LA + (2 * kp) * 128 + kc8 * 8 + 4);
            f32x4 bb0 = *(const LAS f32x4*)(LA + (2 * kp + 1) * 128 + kc8 * 8), bb1 = *(const LAS f32x4*)(LA + (2 * kp + 1) * 128 + kc8 * 8 + 4);
            u32x4 qd0, kd0, qd1, kd1;
            const int kcol = (kp ^ ((kc8 & 7) << 2)) * 4;
#pragma unroll
            for (int j2 = 0; j2 < 4; ++j2) {
                const float bl_a = (j2 < 2) ? l0[2 * j2] : l1[2 * (j2 - 2)], bl_b = (j2 < 2) ? l0[2 * j2 + 1] : l1[2 * (j2 - 2) + 1];
                const float a_a = (j2 < 2) ? ba0[2 * j2] : ba1[2 * (j2 - 2)], a_b = (j2 < 2) ? ba0[2 * j2 + 1] : ba1[2 * (j2 - 2) + 1];
                const float b_a = (j2 < 2) ? bb0[2 * j2] : bb1[2 * (j2 - 2)], b_b = (j2 < 2) ? bb0[2 * j2 + 1] : bb1[2 * (j2 - 2) + 1];
                const float q0a = lo_f(qraw[0][j2]), q0b = hi_f(qraw[0][j2]), k0a = lo_f(kraw[0][j2]), k0b = hi_f(kraw[0][j2]);
                const float q1a = lo_f(qraw[1][j2]), q1b = hi_f(qraw[1][j2]), k1a = lo_f(kraw[1][j2]), k1b = hi_f(kraw[1][j2]);
                qd0[j2] = pk2(q0a * qscale * __expf(a_a), q0b * qscale * __expf(a_b)); kd0[j2] = pk2(k0a * __expf(-a_a), k0b * __expf(-a_b));
                qd1[j2] = pk2(q1a * qscale * __expf(b_a), q1b * qscale * __expf(b_b)); kd1[j2] = pk2(k1a * __expf(-b_a), k1b * __expf(-b_b));
                *(LAS unsigned*)(KUT + (kc8 * 8 + 2 * j2) * 144 + kcol) = pk2(k0a * __expf(bl_a - a_a), k1a * __expf(bl_a - b_a));
                *(LAS unsigned*)(KUT + (kc8 * 8 + 2 * j2 + 1) * 144 + kcol) = pk2(k0b * __expf(bl_b - a_b), k1b * __expf(bl_b - b_b));
            }
            *(LAS u32x4*)(QD + ((2 * kp) * 136 + kc8 * 8) * 2) = qd0; *(LAS u32x4*)(KD + ((2 * kp) * 136 + kc8 * 8) * 2) = kd0;
            *(LAS u32x4*)(QD + ((2 * kp + 1) * 136 + kc8 * 8) * 2) = qd1; *(LAS u32x4*)(KD + ((2 * kp + 1) * 136 + kc8 * 8) * 2) = kd1;
        }
        {
            const int vcol0 = (vpp ^ ((vc8 & 7) << 2)) * 4, vcol1 = ((vpp + 16) ^ ((vc8 & 7) << 2)) * 4;
#pragma unroll
            for (int j2 = 0; j2 < 4; ++j2) {
                *(LAS unsigned*)(VTs + (vc8 * 8 + 2 * j2) * 144 + vcol0) = (vraw[0][j2] & 0xffffu) | (vraw[1][j2] << 16);
                *(LAS unsigned*)(VTs + (vc8 * 8 + 2 * j2 + 1) * 144 + vcol0) = (vraw[0][j2] >> 16) | (vraw[1][j2] & 0xffff0000u);
                *(LAS unsigned*)(VTs + (vc8 * 8 + 2 * j2) * 144 + vcol1) = (vraw[2][j2] & 0xffffu) | (vraw[3][j2] << 16);
                *(LAS unsigned*)(VTs + (vc8 * 8 + 2 * j2 + 1) * 144 + vcol1) = (vraw[2][j2] >> 16) | (vraw[3][j2] & 0xffff0000u); }
        }
        __syncthreads();
        if (wid < 4) {
            const int ti = wid >> 1, tj = wid & 1;
            f32x16 acc;
#pragma unroll
            for (int q = 0; q < 16; ++q) acc[q] = 0.f;
            if (tj <= ti) {
#pragma unroll
                for (int ks = 0; ks < 8; ++ks) {
                    const bf16x8 a = *(const LAS bf16x8*)(QD + ((32 * ti + r) * 136 + ks * 16 + 8 * hf) * 2);
                    const bf16x8 bb = *(const LAS bf16x8*)(KD + ((32 * tj + r) * 136 + ks * 16 + 8 * hf) * 2);
                    acc = MFMA32(a, bb, acc); }
            }
#pragma unroll
            for (int q = 0; q < 16; ++q) { const int i = 32 * ti + crow(q, hf), j = 32 * tj + r;
                const float v = (j <= i) ? acc[q] : 0.f;
                *(LAS bf16_t*)(ATT + (i * 72 + j) * 2) = f2bf(v); }
        }
        {
#pragma unroll
            for (int i = 0; i < 2; ++i) { const int e = tid + 512 * i, row = e >> 4, c8 = e & 15;
                *(u32x4*)(QDg + (size_t)ci * 8192 + row * 128 + c8 * 8) = *(const LAS u32x4*)(QD + (row * 136 + c8 * 8) * 2); }
#pragma unroll
            for (int i = 0; i < 2; ++i) { const int e = tid + 512 * i, row = e >> 3, c8 = e & 7;
                *(u32x4*)(KUTg + (size_t)ci * 8192 + row * 64 + c8 * 8) = *(const LAS u32x4*)(KUT + row * 144 + 16 * (c8 ^ ((row >> 3) & 7))); }
            bf16_t* vtg = gla_vt_ptr(p.ws, ci);
#pragma unroll
            for (int i = 0; i < 4; ++i) { const int e = tid + 512 * i, row = e >> 3, c8 = e & 7;
                *(u32x4*)(vtg + row * 64 + c8 * 8) = *(const LAS u32x4*)(VTs + row * 144 + 16 * (c8 ^ ((row >> 3) & 7))); }
            if (tid < 32) { const f32x4 bl = *(const LAS f32x4*)(BL + tid * 4); f32x4 d; d[0] = __expf(bl[0]); d[1] = __expf(bl[1]); d[2] = __expf(bl[2]); d[3] = __expf(bl[3]);
                *(f32x4*)(DECg + (size_t)ci * 128 + tid * 4) = d; }
        }
        __syncthreads();
        {
            f32x16 acc0, acc1;
#pragma unroll
            for (int q = 0; q < 16; ++q) { acc0[q] = 0.f; acc1[q] = 0.f; }
            const int dv = 32 * wid + r, sw = (dv >> 3) & 7;
#pragma unroll
            for (int ks = 0; ks < 4; ++ks) {
                const bf16x8 a0 = *(const LAS bf16x8*)(ATT + (r * 72 + ks * 16 + 8 * hf) * 2);
                const bf16x8 a1 = *(const LAS bf16x8*)(ATT + ((32 + r) * 72 + ks * 16 + 8 * hf) * 2);
                const bf16x8 bb = *(const LAS bf16x8*)(VTs + dv * 144 + 16 * ((2 * ks + hf) ^ sw));
                acc0 = MFMA32(a0, bb, acc0); acc1 = MFMA32(a1, bb, acc1); }
#pragma unroll
            for (int q = 0; q < 16; ++q) { og[(t0 + crow(q, hf)) * D + h * 256 + dv] = f2bf(acc0[q]); og[(t0 + 32 + crow(q, hf)) * D + h * 256 + dv] = f2bf(acc1[q]); }
        }
        __syncthreads();
    }
}

DI void gla_scan_phase(LAS unsigned char* lds, const Prm& p) {
    const int tid = lthread(), wid = __builtin_amdgcn_readfirstlane(tid >> 6), lane = tid & 63, r = lane & 31, hf = lane >> 5;
    constexpr int BUF = 36352;
    bf16_t* oint = (bf16_t*)(p.ws + OFF_BIG);
    const bf16_t* QDg = (const bf16_t*)(p.ws + OFF_H); const bf16_t* KUTg = (const bf16_t*)(p.ws + OFF_H + (size_t)2048 * 16384); const float* DECg = (const float*)(p.ws + OFF_DEC);
    for (int item = lblock(); item < 256; item += gridDim.x) {
        const int bh = item >> 3, sl = item & 7;
        const int b = bh >> 2, h = bh & 3;
        const int ci0 = bh * 64;
        const int dv = 32 * sl + r;
        f32x16 S[4];
#pragma unroll
        for (int t = 0; t < 4; ++t)
#pragma unroll
            for (int q = 0; q < 16; ++q) S[t][q] = 0.f;
        u32x4 sq[2], sk[2]; f32x4 sd = {0.f, 0.f, 0.f, 0.f}; bf16x8 vf[4], vfn[4];
        const int qrow = tid >> 4, qc8 = tid & 15;
        const int krow = tid >> 3, kc8 = tid & 7;
#define SCAN_LOAD(ci_) do { const bf16_t* qg_ = QDg + (size_t)(ci_) * 8192; const bf16_t* kg_ = KUTg + (size_t)(ci_) * 8192; \
        sq[0] = *(const u32x4*)(qg_ + qrow * 128 + qc8 * 8); sq[1] = *(const u32x4*)(qg_ + (qrow + 32) * 128 + qc8 * 8); \
        sk[0] = *(const u32x4*)(kg_ + krow * 64 + kc8 * 8); sk[1] = *(const u32x4*)(kg_ + (krow + 64) * 64 + kc8 * 8); \
        if (tid < 32) sd = *(const f32x4*)(DECg + (size_t)(ci_) * 128 + tid * 4); } while (0)
#define SCAN_STORE(buf_) do { LAS unsigned char* b_ = lds + (buf_) * BUF; \
        *(LAS u32x4*)(b_ + (qrow * 136 + qc8 * 8) * 2) = sq[0]; *(LAS u32x4*)(b_ + ((qrow + 32) * 136 + qc8 * 8) * 2) = sq[1]; \
        *(LAS u32x4*)(b_ + 17408 + (krow * 72 + kc8 * 8) * 2) = sk[0]; *(LAS u32x4*)(b_ + 17408 + ((krow + 64) * 72 + kc8 * 8) * 2) = sk[1]; \
        if (tid < 32) *(LAS f32x4*)(b_ + 35840 + tid * 16) = sd; } while (0)
#define SCAN_VLOAD(dst, ci_) do { const bf16_t* vg_ = gla_vt_ptr(p.ws, (ci_)) + dv * 64 + 8 * hf; \
        _Pragma("unroll") for (int ks = 0; ks < 4; ++ks) dst[ks] = *(const bf16x8*)(vg_ + ks * 16); } while (0)
        SCAN_LOAD(ci0); if (wid == 0) SCAN_VLOAD(vf, ci0); SCAN_STORE(0);
        __syncthreads();
        for (int n = 0; n < 64; ++n) {
            const int cur = n & 1;
            const bool more = (n + 1 < 64);
            if (more) { SCAN_LOAD(ci0 + n + 1); if (wid == 0) SCAN_VLOAD(vfn, ci0 + n + 1); }
            if (wid == 0) {
            const LAS unsigned char* qb = lds + cur * BUF; const LAS unsigned char* kb = qb + 17408; const LAS float* db = (const LAS float*)(qb + 35840);
            const size_t t0 = (size_t)b * SEQ + (size_t)n * 64;
            bf16_t* op = oint + t0 * 3328 + h * 256 + dv;
            f32x16 a0, a1;
#pragma unroll
            for (int q = 0; q < 16; ++q) { a0[q] = 0.f; a1[q] = 0.f; }
#pragma unroll
            for (int t = 0; t < 4; ++t)
#pragma unroll
                for (int s = 0; s < 2; ++s) {
                    u32x4 sp;
#pragma unroll
                    for (int j2 = 0; j2 < 4; ++j2) sp[j2] = pk2(S[t][8 * s + 2 * j2], S[t][8 * s + 2 * j2 + 1]);
                    const int dk0 = 32 * t + 16 * s + 4 * hf;
                    const u32x2 l0 = *(const LAS u32x2*)(qb + (r * 136 + dk0) * 2), h0 = *(const LAS u32x2*)(qb + (r * 136 + dk0 + 8) * 2);
                    const u32x2 l1 = *(const LAS u32x2*)(qb + ((32 + r) * 136 + dk0) * 2), h1 = *(const LAS u32x2*)(qb + ((32 + r) * 136 + dk0 + 8) * 2);
                    u32x4 f0, f1; f0[0] = l0[0]; f0[1] = l0[1]; f0[2] = h0[0]; f0[3] = h0[1]; f1[0] = l1[0]; f1[1] = l1[1]; f1[2] = h1[0]; f1[3] = h1[1];
                    a0 = MFMA32(__builtin_bit_cast(bf16x8, f0), __builtin_bit_cast(bf16x8, sp), a0);
                    a1 = MFMA32(__builtin_bit_cast(bf16x8, f1), __builtin_bit_cast(bf16x8, sp), a1); }
#pragma unroll
            for (int q = 0; q < 16; ++q) { op[(size_t)crow(q, hf) * 3328] = f2bf(a0[q]); op[(size_t)(32 + crow(q, hf)) * 3328] = f2bf(a1[q]); }
#pragma unroll
            for (int t = 0; t < 4; ++t) {
#pragma unroll
                for (int g = 0; g < 4; ++g) { const f32x4 d4 = *(const LAS f32x4*)(db + 32 * t + 8 * g + 4 * hf);
                    S[t][4 * g] *= d4[0]; S[t][4 * g + 1] *= d4[1]; S[t][4 * g + 2] *= d4[2]; S[t][4 * g + 3] *= d4[3]; }
#pragma unroll
                for (int ks = 0; ks < 4; ++ks) {
                    const bf16x8 a = *(const LAS bf16x8*)(kb + ((32 * t + r) * 72 + ks * 16 + 8 * hf) * 2);
                    S[t] = MFMA32(a, vf[ks], S[t]); }
            }
            }
            if (more) { SCAN_STORE(cur ^ 1);
#pragma unroll
                for (int ks = 0; ks < 4; ++ks) vf[ks] = vfn[ks]; }
            __syncthreads();
        }
#undef SCAN_LOAD
#undef SCAN_STORE
#undef SCAN_VLOAD
    }
}

DI void attn_phase(LAS unsigned char* lds, const Prm& p) {
    const int tid = lthread(), wid = __builtin_amdgcn_readfirstlane(tid >> 6), lane = tid & 63, r = lane & 31, hf = lane >> 5;
    constexpr int KT_STRIDE = 400, KT_BYTES = 64 * KT_STRIDE, VT_STRIDE = 144, VT_BYTES = 128 * VT_STRIDE;
    LAS unsigned char* KT = lds;
    LAS unsigned char* VT = lds + 2 * KT_BYTES;
    const bf16_t* Q = (const bf16_t*)(p.ws + OFF_BIG + (size_t)T * 2048 * 2); const bf16_t* KV = (const bf16_t*)(p.ws + OFF_BIG);
    const bf16_t* KR = (const bf16_t*)(p.ws + OFF_KROPE); bf16_t* AO = (bf16_t*)(p.ws + OFF_H);
    const float* COS = (const float*)(p.ws + OFF_COS); const float* SIN = (const float*)(p.ws + OFF_SIN);
    const float SC = 0.07216878364870322f * 1.4426950408889634f;
    for (int it = lblock(); it < 1024; it += gridDim.x) {
        const int pass = it >> 8, blk = it & 255, bh = blk & 63, g = blk >> 6;
        const int qt = (pass == 0) ? g : (pass == 1) ? 7 - g : (pass == 2) ? 8 + g : 15 - g;
        const int b = bh >> 3, h = bh & 7, q0 = qt * 256;
        const size_t tok0 = (size_t)b * SEQ;
        const int qpos = q0 + 32 * wid + r;
        const size_t qrow = tok0 + qpos;
        bf16x8 qf[12];
        { const bf16_t* qp = Q + qrow * 1536 + h * 192 + 8 * hf;
#pragma unroll
          for (int ks = 0; ks < 12; ++ks) qf[ks] = *(const bf16x8*)(qp + ks * 16);
#pragma unroll
          for (int pr = 0; pr < 2; ++pr) {
              const int i0 = 16 * pr + 8 * hf;
              const f32x4 c0 = *(const f32x4*)(COS + qrow * 32 + i0), c1 = *(const f32x4*)(COS + qrow * 32 + i0 + 4);
              const f32x4 s0 = *(const f32x4*)(SIN + qrow * 32 + i0), s1 = *(const f32x4*)(SIN + qrow * 32 + i0 + 4);
              bf16x8 x1v = qf[8 + pr], x2v = qf[10 + pr], o1, o2;
#pragma unroll
              for (int j = 0; j < 8; ++j) { const float cc = (j < 4) ? c0[j & 3] : c1[j & 3], ss = (j < 4) ? s0[j & 3] : s1[j & 3];
                  const float x1 = bf2f((unsigned short)x1v[j]), x2 = bf2f((unsigned short)x2v[j]);
                  o1[j] = (short)f2bf(x1 * cc - x2 * ss); o2[j] = (short)f2bf(x1 * ss + x2 * cc); }
              qf[8 + pr] = o1; qf[10 + pr] = o2; } }
        float m = -1e30f, l = 0.f;
        f32x16 O[4];
#pragma unroll
        for (int d = 0; d < 4; ++d)
#pragma unroll
            for (int q = 0; q < 16; ++q) O[d][q] = 0.f;
        const int nkt = 4 * (qt + 1);
        u32x4 kraw[3], vraw[2];
        const int kkey = tid >> 4, kc8 = tid & 15;
        const int rkey = tid >> 3, rc8 = tid & 7;
        const int vp = tid & 31, vc8 = tid >> 5;
        const int vpp = (vp & ~6) | ((vp & 2) << 1) | ((vp & 4) >> 1);
        const int vrd = r * VT_STRIDE + 16 * hf;
const unsigned offk0 = (unsigned)(kkey * 2048 + kc8 * 8), offk1 = offk0 + 32u * 2048u, offr = (unsigned)(rkey * 64 + rc8 * 8);
        const unsigned offv0 = (unsigned)(2 * vp * 2048 + 128 + vc8 * 8), offv1 = offv0 + 2048u;
        const bf16_t* kvb0 = KV + tok0 * 2048 + h * 256; const bf16_t* krb0 = KR + tok0 * 64;
#define ATT_LOAD(kt_) do { const bf16_t* kvb_ = kvb0 + (size_t)(kt_) * 64 * 2048; const bf16_t* krb_ = krb0 + (size_t)(kt_) * 64 * 64; \
        kraw[0] = *(const u32x4*)(kvb_ + offk0); kraw[1] = *(const u32x4*)(kvb_ + offk1); \
        kraw[2] = *(const u32x4*)(krb_ + offr); \
        vraw[0] = *(const u32x4*)(kvb_ + offv0); vraw[1] = *(const u32x4*)(kvb_ + offv1); } while (0)
#define ATT_STORE(buf_) do { LAS unsigned char* kt_ = KT + (buf_) * KT_BYTES; LAS unsigned char* vt_ = VT + (buf_) * VT_BYTES; \
        *(LAS u32x4*)(kt_ + kkey * KT_STRIDE + kc8 * 16) = kraw[0]; *(LAS u32x4*)(kt_ + (kkey + 32) * KT_STRIDE + kc8 * 16) = kraw[1]; \
        *(LAS u32x4*)(kt_ + rkey * KT_STRIDE + 256 + rc8 * 16) = kraw[2]; \
        _Pragma("unroll") for (int j2 = 0; j2 < 4; ++j2) { \
            const unsigned lo_ = (vraw[0][j2] & 0xffffu) | (vraw[1][j2] << 16), hi_ = (vraw[0][j2] >> 16) | (vraw[1][j2] & 0xffff0000u); \
            *(LAS unsigned*)(vt_ + (vc8 * 8 + 2 * j2) * VT_STRIDE + 4 * vpp) = lo_; \
            *(LAS unsigned*)(vt_ + (vc8 * 8 + 2 * j2 + 1) * VT_STRIDE + 4 * vpp) = hi_; } } while (0)
        ATT_LOAD(0); ATT_STORE(0);
        __syncthreads();
        for (int kt = 0; kt < nkt; ++kt) {
            const int cur = kt & 1;
            const bool more = (kt + 1 < nkt);
            if (more) ATT_LOAD(kt + 1);
            const int kbase = kt * 64;
            if (kbase <= q0 + 32 * wid + 31) {
                const LAS unsigned char* ktb = KT + cur * KT_BYTES; const LAS unsigned char* vtb = VT + cur * VT_BYTES;
                f32x16 s0, s1;
#pragma unroll
                for (int q = 0; q < 16; ++q) { s0[q] = 0.f; s1[q] = 0.f; }
                __builtin_amdgcn_s_setprio(1);
#pragma unroll
                for (int ks = 0; ks < 12; ++ks) {
                    const bf16x8 a0 = *(const LAS bf16x8*)(ktb + r * KT_STRIDE + ks * 32 + 16 * hf);
                    const bf16x8 a1 = *(const LAS bf16x8*)(ktb + (32 + r) * KT_STRIDE + ks * 32 + 16 * hf);
                    s0 = MFMA32(a0, qf[ks], s0); s1 = MFMA32(a1, qf[ks], s1);
                    }
                __builtin_amdgcn_s_setprio(0);
                const bool diag = (kbase + 63 > q0 + 32 * wid);
                float mx = -1e30f;
#pragma unroll
                for (int q = 0; q < 16; ++q) {
                    float v0 = s0[q], v1 = s1[q];
                    if (diag) { const int key = kbase + crow(q, hf); if (key > qpos) v0 = -1e30f; if (key + 32 > qpos) v1 = -1e30f; }
                    s0[q] = v0; s1[q] = v1; mx = fmaxf(mx, fmaxf(v0, v1)); }
                mx = xmax32(mx) * SC;
                const float mn = fmaxf(m, mx), alpha = __builtin_amdgcn_exp2f(m - mn);
                const bool changed = __builtin_amdgcn_ballot_w64(mn > m) != 0ull;
                m = mn;
                float ls = 0.f;
#pragma unroll
                for (int q = 0; q < 16; ++q) { s0[q] = __builtin_amdgcn_exp2f(__builtin_fmaf(s0[q], SC, -mn)); s1[q] = __builtin_amdgcn_exp2f(__builtin_fmaf(s1[q], SC, -mn)); ls += s0[q] + s1[q]; }
                l = l * alpha + ls;
                if (changed) {
#pragma unroll
                    for (int d = 0; d < 4; ++d)
#pragma unroll
                        for (int q = 0; q < 16; ++q) O[d][q] *= alpha;
                }
                bf16x8 pb[2][2];
#pragma unroll
                for (int s = 0; s < 2; ++s) {
                    u32x4 t0, t1;
#pragma unroll
                    for (int j2 = 0; j2 < 4; ++j2) { t0[j2] = pk2(s0[8 * s + 2 * j2], s0[8 * s + 2 * j2 + 1]); t1[j2] = pk2(s1[8 * s + 2 * j2], s1[8 * s + 2 * j2 + 1]); }
                    pb[0][s] = __builtin_bit_cast(bf16x8, t0); pb[1][s] = __builtin_bit_cast(bf16x8, t1); }
#pragma unroll
                for (int d = 0; d < 4; ++d) {
#pragma unroll
                    for (int ksub = 0; ksub < 2; ++ksub)
#pragma unroll
                        for (int s = 0; s < 2; ++s) {
                            const bf16x8 av = *(const LAS bf16x8*)(vtb + vrd + d * 32 * VT_STRIDE + 32 * (2 * ksub + s));
                            O[d] = MFMA32(av, pb[ksub][s], O[d]); }
                }
            }
            if (more) ATT_STORE(cur ^ 1);
            __syncthreads();
        }
#undef ATT_LOAD
#undef ATT_STORE
        l = xsum32(l);
        const float inv = 1.f / l;
#pragma unroll
        for (int d = 0; d < 4; ++d)
#pragma unroll
            for (int g4 = 0; g4 < 4; ++g4) { u32x2 pk; pk[0] = pk2(O[d][4 * g4] * inv, O[d][4 * g4 + 1] * inv); pk[1] = pk2(O[d][4 * g4 + 2] * inv, O[d][4 * g4 + 3] * inv);
                *(u32x2*)(AO + qrow * D + h * 128 + 32 * d + 8 * g4 + 4 * hf) = pk; }
    }
}


#define XB_TMO      128
#define XB_XCNT(j)  (256  + 64 * (j))
#define XB_XSUB(j)  (1280 + 64 * (j))
#define XB_XGEN(j)  (2304 + 64 * (j))
#define XB_TOP      3328
#define XB_TOPGEN   3392
#define XCD_BAR_WORDS 3456
#define XB_SPIN_CAP (1u << 22)
DI unsigned xb_ld(unsigned* p)              { return __hip_atomic_load(p, __ATOMIC_RELAXED, __HIP_MEMORY_SCOPE_AGENT); }
DI unsigned xb_add(unsigned* p, unsigned v) { return __hip_atomic_fetch_add(p, v, __ATOMIC_RELAXED, __HIP_MEMORY_SCOPE_AGENT); }
DI unsigned xb_xcc_id() { return (unsigned)__builtin_amdgcn_s_getreg((3 << 11) | 20) & 0xFu; }
#define XB_SPIN(cond, bar) do { unsigned _sp = 0; while (cond) { __builtin_amdgcn_s_sleep(1); \
    if ((++_sp & 255u) == 0u) { if (xb_ld(&(bar)[XB_TMO])) break; if (_sp > XB_SPIN_CAP) { atomicAdd(&(bar)[XB_TMO], 1u); break; } } } } while (0)
struct XcdBarrier { unsigned* bar; unsigned x; volatile LAS unsigned* st; };
DI XcdBarrier xcd_barrier_post(unsigned* bar, volatile LAS unsigned* st) {
    XcdBarrier b; b.bar = bar; b.x = xb_xcc_id(); b.st = st;
    if (threadIdx.x == 0) (void)xb_add(&bar[XB_XCNT(b.x)], 1u);
    return b;
}
DI void xcd_barrier_complete(unsigned* bar, unsigned x, unsigned& nloc, unsigned& nx) {
    const unsigned G = gridDim.x * gridDim.y * gridDim.z;
    unsigned sum, cnt, mine, sp = 0u;
    for (;;) {
        sum = 0u; cnt = 0u; mine = 0u;
#pragma unroll
        for (unsigned j = 0; j < 16; ++j) { const unsigned c = xb_ld(&bar[XB_XCNT(j)]); sum += c; cnt += (c > 0u) ? 1u : 0u; mine = (j == x) ? c : mine; }
        if (sum == G) break;
        __builtin_amdgcn_s_sleep(1);
        if ((++sp & 255u) == 0u) { if (xb_ld(&bar[XB_TMO])) break; if (sp > XB_SPIN_CAP) { atomicAdd(&bar[XB_TMO], 1u); break; } }
    }
    nloc = mine > 0u ? mine : 1u; nx = cnt > 0u ? cnt : 1u;
}
DI void xcd_barrier(const XcdBarrier& b) {
    asm volatile("s_waitcnt vmcnt(0)" ::: "memory");
    __syncthreads();
    if (threadIdx.x == 0) {
        unsigned* bar = b.bar;
        __builtin_amdgcn_s_waitcnt(0);
        unsigned nloc = b.st[0], nx = b.st[1];
        if (nloc == 0u) { xcd_barrier_complete(bar, b.x, nloc, nx); b.st[0] = nloc; b.st[1] = nx; }
        const unsigned old = xb_add(&bar[XB_XSUB(b.x)], 1u);
        const unsigned gen = old / nloc;
        if (old + 1u == (gen + 1u) * nloc) {
            __builtin_amdgcn_fence(__ATOMIC_RELEASE, "agent");
            asm volatile("s_waitcnt vmcnt(0)" ::: "memory");
            const unsigned og = xb_add(&bar[XB_TOP], 1u);
            const unsigned tg = og / nx;
            if (og + 1u == (tg + 1u) * nx) xb_add(&bar[XB_TOPGEN], 1u);
            else XB_SPIN(xb_ld(&bar[XB_TOPGEN]) == tg, bar);
            __builtin_amdgcn_fence(__ATOMIC_ACQUIRE, "agent");
            xb_add(&bar[XB_XGEN(b.x)], 1u);
            asm volatile("s_waitcnt vmcnt(0)" ::: "memory");
        } else {
            XB_SPIN(xb_ld(&bar[XB_XGEN(b.x)]) == gen, bar);
            __builtin_amdgcn_fence(__ATOMIC_ACQUIRE, "agent");
            asm volatile("s_waitcnt vmcnt(0)" ::: "memory");
        }
    }
    __syncthreads();
}

__global__ void __launch_bounds__(NTHREADS) fwd_megakernel(Prm p) {
    extern __shared__ __attribute__((aligned(16))) unsigned char lds_raw[];
    LAS unsigned char* lds = (LAS unsigned char*)lds_raw;
    cg::grid_group grid = cg::this_grid();
    if (threadIdx.x < 4) ((LAS unsigned*)(lds + 131072))[threadIdx.x] = 0u;
    __syncthreads();
    XcdBarrier xbar = xcd_barrier_post((unsigned*)(p.ws + OFF_BAR), (volatile LAS unsigned*)(lds + 131072));
    unsigned char* ws = p.ws;
    float* mods = (float*)(ws + OFF_MODS); float* kvm = (float*)(ws + OFF_KVMODS);
    bf16_t* H = (bf16_t*)(ws + OFF_H); float* Y = (float*)(ws + OFF_Y); bf16_t* BIG = (bf16_t*)(ws + OFF_BIG);
    const int G = gridDim.x, cblk = lblock();
#pragma unroll 1
    for (int ph = p.ph_lo; ph < p.ph_hi; ++ph) {
#if DUP_MASK
      const int nrep = ((DUP_MASK >> ph) & 1u) ? 2 : 1;
#pragma unroll 1
      for (int rep = 0; rep < nrep; ++rep)
#endif
        switch (ph) {
        case PH_PRO: {
            mods_phase(lds, p);
            rope_tables(p);
            convert_w(lds, p.gla_w_in, 1024, 3088, (bf16_t*)(ws + OFF_WGIN), 3328, WM_GIN);
            convert_w(lds, p.gla_w_out, 1024, 1024, (bf16_t*)(ws + OFF_WGOUT), 1024, WM_ID);
            convert_w(lds, p.w_kv_a, 1024, 320, (bf16_t*)(ws + OFF_WKVA), 512, WM_LIM320);
            convert_w(lds, p.w_kv_b, 256, 2048, (bf16_t*)(ws + OFF_WKVB), 2048, WM_ID);
            convert_w(lds, p.w_dq, 1024, 384, (bf16_t*)(ws + OFF_WDQ), 512, WM_LIM384);
            convert_w(lds, p.w_uq, 384, 1536, (bf16_t*)(ws + OFF_WUQ), 1536, WM_ID);
            convert_w(lds, p.w_mout, 1024, 1024, (bf16_t*)(ws + OFF_WMOUT), 1024, WM_ID);
            convert_ffn(lds, p, 0, 0);
        } break;
        case PH_ROW0: case PH_ROW1: case PH_ROW2: case PH_ROW3: case PH_ROW4: case PH_ROW5: case PH_ROW6: {
            const int ps = (ph == PH_ROW0) ? -1 : (ph == PH_ROW1) ? 0 : (ph == PH_ROW2) ? 1 : (ph == PH_ROW3) ? 2 : (ph == PH_ROW4) ? 3 : (ph == PH_ROW5) ? 4 : 5;
            RowP a;
            bf16_t* XB = (bf16_t*)(ws + OFF_Y + (size_t)T * 1024 * 2);
            a.xin_f = (ph <= PH_ROW1) ? p.x : nullptr; a.xin_b = XB; a.y = nullptr; a.xout_f = (ph == PH_ROW6) ? p.out : nullptr; a.xout_b = XB;
            a.rw = 0.f; a.gate = nullptr; a.gate_bs = 9216; a.g_post = nullptr;
            a.g1 = nullptr; a.sh1 = nullptr; a.sc1 = nullptr; a.bs1 = 9216; a.h1 = nullptr; a.g2 = nullptr; a.sh2 = nullptr; a.sc2 = nullptr; a.bs2 = 2048; a.h2 = nullptr;
            if (ps >= 0) { const int l = ps / 3, s = ps % 3; a.y = (const bf16_t*)Y; a.rw = (s == 1) ? 1.f : 0.5f;
                a.gate = mods + (size_t)l * 8 * 9216 + (3 * s + 2) * 1024; a.g_post = p.norm_g + ((l * 3 + s) * 2 + 1) * 1024; }
            const int pre = ps + 1;
            if (pre < 6) { const int l = pre / 3, s = pre % 3; a.h1 = H; a.g1 = p.norm_g + ((l * 3 + s) * 2) * 1024;
                a.sh1 = mods + (size_t)l * 8 * 9216 + (3 * s) * 1024; a.sc1 = mods + (size_t)l * 8 * 9216 + (3 * s + 1) * 1024; }
            if (ph == PH_ROW3) { a.h2 = BIG; a.g2 = p.kv_g_in; a.sh2 = kvm; a.sc2 = kvm + 1024; }
            rowwise_phase(a);
            if (ph == PH_ROW1) convert_ffn(lds, p, 0, 1);
            if (ph == PH_ROW3) convert_ffn(lds, p, 1, 0);
            if (ph == PH_ROW4) convert_ffn(lds, p, 1, 1);
        } break;
        case PH_A_G1: case PH_B_G1: case PH_C_G1: case PH_D_G1: {
            if (ph == PH_C_G1) ckv_phase(p);
            pg8::Gemm g{H, (const bf16_t*)(ws + OFF_WGU), T, 5632, 1024}; pg8::StaticOrder S; S.init(T, 5632, G, cblk);
            pg8::EpiSwiglu E{BIG};
            pg8::gemm_phase<pg8::EpiSwiglu>(lds, g, S, E);
        } break;
        case PH_KVA: {
            pg8::Gemm g{BIG, (const bf16_t*)(ws + OFF_WKVA), T, 512, 1024}; pg8::EpiF32 E{Y, 512}; pg8::StaticOrder S; S.init(T, 512, G, cblk);
            pg8::gemm_phase<pg8::EpiF32>(lds, g, S, E);
        } break;
        case PH_GIN: case PH_UQ: case PH_A_G2: case PH_B_G2: case PH_C_G2: case PH_D_G2: case PH_GOUT: case PH_MOUT: {
            pg8::Gemm g; pg8::EpiBf16 E;
            if (ph == PH_GIN) { g = pg8::Gemm{H, (const bf16_t*)(ws + OFF_WGIN), T, 3328, 1024}; E = pg8::EpiBf16{BIG, 3328, (float*)(ws + OFF_GLOW), 12}; }
            else if (ph == PH_UQ) { g = pg8::Gemm{(const bf16_t*)(ws + OFF_H), (const bf16_t*)(ws + OFF_WUQ), T, 1536, 384}; E = pg8::EpiBf16{(bf16_t*)(ws + OFF_BIG + (size_t)T * 2048 * 2), 1536, nullptr, -1}; }
            else if (ph == PH_GOUT) { g = pg8::Gemm{H, (const bf16_t*)(ws + OFF_WGOUT), T, 1024, 1024}; E = pg8::EpiBf16{(bf16_t*)Y, 1024, nullptr, -1}; }
            else if (ph == PH_MOUT) { g = pg8::Gemm{H, (const bf16_t*)(ws + OFF_WMOUT), T, 1024, 1024}; E = pg8::EpiBf16{(bf16_t*)Y, 1024, nullptr, -1}; }
            else { g = pg8::Gemm{BIG, (const bf16_t*)(ws + OFF_WDN), T, 1024, 2816}; E = pg8::EpiBf16{(bf16_t*)Y, 1024, nullptr, -1}; }
            pg8::StaticOrder S; S.init(T, g.N, G, cblk);
            pg8::gemm_phase<pg8::EpiBf16>(lds, g, S, E);
        } break;
        case PH_GLA_CHUNK: gla_chunk_phase(lds, p); break;
        case PH_GLA_SCAN: gla_scan_phase(lds, p); break;
        case PH_GLA_GATE: gla_gate_phase(p); break;
        case PH_DQ_KVB: {
            { pg8::Gemm g{H, (const bf16_t*)(ws + OFF_WDQ), T, 512, 1024}; pg8::EpiF32 E{Y, 512}; pg8::StaticOrder S; S.init(T, 512, G, cblk);
              pg8::gemm_phase<pg8::EpiF32>(lds, g, S, E); }
            { pg8::Gemm g{(const bf16_t*)(ws + OFF_CKVN), (const bf16_t*)(ws + OFF_WKVB), T, 2048, 256}; pg8::EpiBf16 E{BIG, 2048, nullptr, -1}; pg8::StaticOrder S; S.init(T, 2048, G, cblk);
              pg8::gemm_phase<pg8::EpiBf16>(lds, g, S, E); }
        } break;
        case PH_CQ: cq_phase(p); break;
        case PH_ATTN: attn_phase(lds, p); break;
        default: break;
        }
        if (ph + 1 < p.ph_hi) { if (p.ph_hi > NPH) grid.sync(); else xcd_barrier(xbar); }
    }
}

extern "C" void kernel_launch(void* const* d_in, const int* in_sizes, int n_in, void* d_out, int out_size, void* d_ws, size_t ws_size, hipStream_t stream) {
    static int grid_blocks = 0;
    if (grid_blocks == 0) {
        if (n_in != 23 || ws_size < WS_END) { fprintf(stderr, "kernel_launch: unexpected n_in %d / ws %zu (need %zu)\n", n_in, ws_size, (size_t)WS_END); grid_blocks = -1; return; }
        int dev = 0, cus = 0, per_cu = 0;
        (void)hipGetDevice(&dev);
        (void)hipDeviceGetAttribute(&cus, hipDeviceAttributeMultiprocessorCount, dev);
        if (hipFuncSetAttribute((const void*)fwd_megakernel, hipFuncAttributeMaxDynamicSharedMemorySize, LDS_BYTES) != hipSuccess) { fprintf(stderr, "kernel_launch: hipFuncSetAttribute failed\n"); grid_blocks = -1; return; }
        if (hipOccupancyMaxActiveBlocksPerMultiprocessor(&per_cu, (const void*)fwd_megakernel, NTHREADS, LDS_BYTES) != hipSuccess || per_cu < 1) { fprintf(stderr, "kernel_launch: occupancy query says %d\n", per_cu); per_cu = 1; }
        (void)hipGetLastError();
        grid_blocks = cus * 1;
        fprintf(stderr, "kernel_launch: cus %d per_cu %d grid %d\n", cus, per_cu, grid_blocks);
    }
    if (grid_blocks < 0) return;
    Prm p{};
    p.x = (const float*)d_in[0]; p.c = (const float*)d_in[1]; p.pos = (const int*)d_in[2]; p.cond_w = (const float*)d_in[3]; p.cond_b = (const float*)d_in[4];
    p.norm_g = (const float*)d_in[5]; p.ffn_gu = (const float*)d_in[6]; p.ffn_dn = (const float*)d_in[7]; p.gla_w_in = (const float*)d_in[8];
    p.gla_w_gate_up = (const float*)d_in[9]; p.gla_b_gate = (const float*)d_in[10]; p.gla_g_out = (const float*)d_in[11]; p.gla_w_out = (const float*)d_in[12];
    p.kv_g_in = (const float*)d_in[13]; p.kv_cond_w = (const float*)d_in[14]; p.kv_cond_b = (const float*)d_in[15]; p.w_kv_a = (const float*)d_in[16];
    p.g_kv = (const float*)d_in[17]; p.w_kv_b = (const float*)d_in[18]; p.w_dq = (const float*)d_in[19]; p.g_q = (const float*)d_in[20];
    p.w_uq = (const float*)d_in[21]; p.w_mout = (const float*)d_in[22];
    p.out = (float*)d_out; p.ws = (unsigned char*)d_ws;
    (void)hipMemsetAsync((unsigned char*)d_ws + OFF_BAR, 0, 16384, stream);
#if MULTI_LAUNCH
    for (int ph = 0; ph < NPH; ++ph) {
        p.ph_lo = ph; p.ph_hi = ph + 1;
        hipLaunchKernelGGL(fwd_megakernel, dim3(grid_blocks), dim3(NTHREADS), LDS_BYTES, stream, p);
    }
#else
    p.ph_lo = 0; p.ph_hi = NPH;
    void* args[] = {&p};
    hipError_t e = hipLaunchCooperativeKernel((const void*)fwd_megakernel, dim3(grid_blocks), dim3(NTHREADS), args, LDS_BYTES, stream);
    if (e != hipSuccess) fprintf(stderr, "cooperative launch failed: %s (grid %d)\n", hipGetErrorString(e), grid_blocks);
#endif
}
```
